# Optimizing an MI355X kernel written in HIP

```python
import jax, jax.numpy as jnp
from jax import lax
import numpy as np

D_MODEL = 1024
BATCH = 8
SEQ = 4096
DEPTH = 1

CHUNK = 64
EPS = 1e-6

GLA_HEADS = 4
GLA_DK = 128
GLA_DV = 256
GLA_RANK = 16
GLA_TAU = 16.0
GLA_QK = GLA_HEADS * GLA_DK
GLA_V = GLA_HEADS * GLA_DV

SWA_HEADS = 16
SWA_KV_HEADS = 4
SWA_GROUP = SWA_HEADS // SWA_KV_HEADS
SWA_HD = 64
WINDOW = 128
WIN_CHUNKS = WINDOW // CHUNK
SWA_Q = SWA_HEADS * SWA_HD
SWA_KV = SWA_KV_HEADS * SWA_HD

D_FF = 4 * D_MODEL

IN_SIZES = (GLA_QK, GLA_QK, GLA_V, GLA_V, GLA_RANK, SWA_Q, SWA_KV, SWA_KV, D_MODEL, D_MODEL)
D_IN = sum(IN_SIZES)

kernel_name = "hybrid_gla_swa_gated_block"


def rmsnorm(x, g):
    xf = x.astype(jnp.float32)
    y = xf * lax.rsqrt(jnp.mean(xf * xf, axis=-1, keepdims=True) + EPS)
    return (y * g.astype(jnp.float32)).astype(x.dtype)


def gla_branch(q, k, v, g, a_lr, w_alpha2, b_alpha, gla_norm):
    f32 = jnp.float32
    B, T, _ = q.shape
    NC = T // CHUNK
    kshape = (B, NC, CHUNK, GLA_HEADS, GLA_DK)
    log_alpha = jax.nn.log_sigmoid((a_lr.astype(f32) @ w_alpha2.astype(f32)) + b_alpha.astype(f32)) / GLA_TAU
    cum = jnp.cumsum(log_alpha.reshape(kshape), axis=2)
    qf = q.astype(f32).reshape(kshape) * (GLA_DK ** -0.5)
    kf = k.astype(f32).reshape(kshape)
    vf = v.astype(f32).reshape(B, NC, CHUNK, GLA_HEADS, GLA_DV)
    q_dec = qf * jnp.exp(cum)
    k_dec = kf * jnp.exp(-cum)
    total = cum[:, :, -1]
    k_to_end = kf * jnp.exp(total[:, :, None] - cum)
    scores = jnp.einsum('bnthk,bnshk->bnhts', q_dec, k_dec)
    causal = jnp.tril(jnp.ones((CHUNK, CHUNK), dtype=bool))
    scores = jnp.where(causal, scores, 0.0)
    o_intra = jnp.einsum('bnhts,bnshv->bnthv', scores, vf)
    chunk_kv = jnp.einsum('bnshk,bnshv->bnhkv', k_to_end, vf)

    def step(state, inp):
        decay, kv = inp
        return state * jnp.exp(decay)[..., None] + kv, state

    init = jnp.zeros((B, GLA_HEADS, GLA_DK, GLA_DV), f32)
    _, states = lax.scan(step, init, (jnp.moveaxis(total, 1, 0), jnp.moveaxis(chunk_kv, 1, 0)))
    states = jnp.moveaxis(states, 0, 1)
    o = o_intra + jnp.einsum('bnthk,bnhkv->bnthv', q_dec, states)
    o = o * lax.rsqrt(jnp.mean(o * o, axis=-1, keepdims=True) + EPS) * gla_norm.astype(f32)
    o = o.reshape(B, T, GLA_V) * jax.nn.silu(g.astype(f32))
    return o.astype(q.dtype)


def swa_branch(q, k, v, q_norm, k_norm, sinks):
    f32 = jnp.float32
    B, T, _ = q.shape
    NC = T // CHUNK
    S = (WIN_CHUNKS + 1) * CHUNK
    qh = rmsnorm(q.reshape(B, T, SWA_HEADS, SWA_HD), q_norm)
    kh = rmsnorm(k.reshape(B, T, SWA_KV_HEADS, SWA_HD), k_norm)
    vh = v.reshape(B, T, SWA_KV_HEADS, SWA_HD)
    pad = ((0, 0), (WIN_CHUNKS * CHUNK, 0), (0, 0), (0, 0))
    kc = jnp.pad(kh, pad).reshape(B, NC + WIN_CHUNKS, CHUNK, SWA_KV_HEADS, SWA_HD)
    vc = jnp.pad(vh, pad).reshape(B, NC + WIN_CHUNKS, CHUNK, SWA_KV_HEADS, SWA_HD)
    k_band = jnp.concatenate([kc[:, j:j + NC] for j in range(WIN_CHUNKS + 1)], axis=2)
    v_band = jnp.concatenate([vc[:, j:j + NC] for j in range(WIN_CHUNKS + 1)], axis=2)
    qg = qh.reshape(B, NC, CHUNK, SWA_KV_HEADS, SWA_GROUP, SWA_HD)
    scores = jnp.einsum('bnqkgd,bnskd->bnkgqs', qg, k_band).astype(f32) * (SWA_HD ** -0.5)
    slopes = (2.0 ** (-8.0 * jnp.arange(1, SWA_HEADS + 1, dtype=f32) / SWA_HEADS)).reshape(SWA_KV_HEADS, SWA_GROUP, 1, 1)
    dist = jnp.abs(jnp.arange(CHUNK)[:, None] + WIN_CHUNKS * CHUNK - jnp.arange(S)[None, :]).astype(f32)
    scores = scores - slopes * dist
    key_chunk = jnp.arange(NC)[:, None] - WIN_CHUNKS + (jnp.arange(S) // CHUNK)[None, :]
    valid = key_chunk >= 0
    scores = jnp.where(valid[None, :, None, None, None, :], scores, -1e30)
    sink = sinks.astype(f32).reshape(SWA_KV_HEADS, SWA_GROUP, 1, 1)
    m = jnp.maximum(jnp.max(scores, axis=-1, keepdims=True), sink)
    p = jnp.exp(scores - m)
    probs = p / (jnp.sum(p, axis=-1, keepdims=True) + jnp.exp(sink - m))
    o = jnp.einsum('bnkgqs,bnskd->bnqkgd', probs, v_band.astype(f32))
    return o.reshape(B, T, SWA_Q).astype(q.dtype)


def setup_inputs(seed: int = 0) -> dict:
    key = jax.random.key(seed)
    ks = jax.random.split(key, 16)
    f32 = jnp.float32
    L = DEPTH

    def nrm(k, shape, scale):
        return jax.random.normal(k, shape, f32) * scale

    return {
        "x": jax.random.normal(ks[0], (BATCH, SEQ, D_MODEL), f32),
        "norm_mix": 1.0 + nrm(ks[1], (L, D_MODEL), 0.02),
        "w_in": nrm(ks[2], (L, D_MODEL, D_IN), D_MODEL ** -0.5),
        "w_alpha2": nrm(ks[3], (L, GLA_RANK, GLA_QK), GLA_RANK ** -0.5),
        "b_alpha": nrm(ks[4], (L, GLA_QK), 0.1),
        "gla_norm": 1.0 + nrm(ks[5], (L, GLA_DV), 0.02),
        "swa_q_norm": 1.0 + nrm(ks[6], (L, SWA_HD), 0.02),
        "swa_k_norm": 1.0 + nrm(ks[7], (L, SWA_HD), 0.02),
        "swa_sinks": nrm(ks[8], (L, SWA_HEADS), 0.5),
        "w_branch_gla": nrm(ks[9], (L, GLA_V, D_MODEL), GLA_V ** -0.5),
        "w_branch_swa": nrm(ks[10], (L, SWA_Q, D_MODEL), SWA_Q ** -0.5),
        "w_out": nrm(ks[11], (L, D_MODEL, D_MODEL), D_MODEL ** -0.5),
        "norm_mlp": 1.0 + nrm(ks[12], (L, D_MODEL), 0.02),
        "w_up": nrm(ks[13], (L, D_MODEL, D_FF), D_MODEL ** -0.5),
        "w_down": nrm(ks[14], (L, D_FF, D_MODEL), D_FF ** -0.5),
    }


def reference(x, norm_mix, w_in, w_alpha2, b_alpha, gla_norm, swa_q_norm, swa_k_norm, swa_sinks,
              w_branch_gla, w_branch_swa, w_out, norm_mlp, w_up, w_down):
    h = x
    split_at = np.cumsum(IN_SIZES)[:-1].tolist()
    for l in range(DEPTH):
        hn = rmsnorm(h, norm_mix[l])
        proj = hn @ w_in[l]
        (gq, gk, gv, gg, ga, sq, sk, sv, gate_a, gate_b) = jnp.split(proj, split_at, axis=-1)
        y_gla = gla_branch(gq, gk, gv, gg, ga, w_alpha2[l], b_alpha[l], gla_norm[l]) @ w_branch_gla[l]
        y_swa = swa_branch(sq, sk, sv, swa_q_norm[l], swa_k_norm[l], swa_sinks[l]) @ w_branch_swa[l]
        merged = jax.nn.sigmoid(gate_a) * y_gla + jax.nn.sigmoid(gate_b) * y_swa
        h = h + (merged @ w_out[l]).astype(h.dtype)
        hm = rmsnorm(h, norm_mlp[l])
        u = jnp.square(jax.nn.relu(hm @ w_up[l]))
        h = h + (u @ w_down[l]).astype(h.dtype)
    return h
```

```cpp
#include <hip/hip_runtime.h>
#include <hip/hip_cooperative_groups.h>
#include <cstdio>
#include <cstdint>
namespace cg = cooperative_groups;

constexpr int M_TOK = 32768, DM = 1024, SEQ_T = 4096, NPROJ = 6656, DFF = 4096;
constexpr size_t MiB = 1u << 20;
constexpr size_t WS_SSQ = 0;
constexpr size_t WS_BAR = 1 * MiB, BAR_BYTES = 16384;
constexpr size_t WS_WIN = 2 * MiB, WS_WBG = 16 * MiB, WS_WBS = 18 * MiB, WS_WOUT = 20 * MiB, WS_WUP = 22 * MiB, WS_WDN = 30 * MiB;
constexpr size_t WS_ALR = 38 * MiB;
constexpr size_t WS_QK = 40 * MiB, WS_GV = 104 * MiB, WS_GG = 168 * MiB, WS_SQ = 232 * MiB;
constexpr size_t WS_SKV = 296 * MiB;
constexpr size_t WS_GA = 328 * MiB, WS_GB = 392 * MiB;
constexpr size_t WS_MERGED = 40 * MiB;
constexpr size_t WS_H1B = 104 * MiB;
constexpr size_t WS_U = 168 * MiB;
constexpr size_t WS_GLAL = 456 * MiB, WS_GLAD = 488 * MiB;
constexpr size_t WS_END = 489 * MiB;
constexpr int LDS_BYTES = 147456;
#ifndef REP_P0
#define REP_P0 1
#endif
#ifndef REP_P1
#define REP_P1 1
#endif
#ifndef REP_PA
#define REP_PA 1
#endif
#ifndef REP_SWA
#define REP_SWA 1
#endif
#ifndef REP_P2A
#define REP_P2A 1
#endif
#ifndef REP_P2B
#define REP_P2B 1
#endif
#ifndef PH_MASK
#define PH_MASK 0x1ff
#endif
#define LAS __attribute__((address_space(3)))
namespace pg8 {
#define PG8_LAS __attribute__((address_space(3)))
typedef unsigned short bf16_t;
typedef short bf16x8 __attribute__((ext_vector_type(8)));
typedef float f32x4 __attribute__((ext_vector_type(4)));
typedef unsigned u32x4 __attribute__((ext_vector_type(4)));
constexpr int BM = 256, BK = 64, HALF = 128, HTB = HALF * BK * 2  , STAGE_BYTES = 8 * HTB, NXCD = 8, WGM = 8;

__host__ __device__ __forceinline__ int lds_byte(int r, int c) { const int st = (r >> 4) * 2 + (c >> 5), rr = r & 15, cc = c & 31, ob = rr * 64 + cc * 2; return st * 1024 + (ob ^ (((ob >> 9) & 1) << 5)); }
__host__ __device__ __forceinline__ void stage_rc(int b, int& R, int& C) { const int st = b / 1024, sb = b % 1024, swz = sb ^ (((sb >> 9) & 1) << 5); R = (st >> 1) * 16 + swz / 64; C = (st & 1) * 32 + (swz % 64) / 2; }
__host__ __device__ __forceinline__ int perm32(int rho) { const int n = rho >> 4, i = rho & 15; return 8 * (i >> 2) + 4 * n + (i & 3); }

struct Unit { int pm, pn; };
struct Gemm { const bf16_t* A; const bf16_t* Bt; int M, N, K; };

struct StaticOrder {
    int nM, nN, nwg, G, c;
    __host__ __device__ void init(int M, int N, int G_, int c_) { nM = M / BM; nN = N / BM; nwg = nM * nN; G = G_; c = c_; }
    __host__ __device__ bool next(int i, Unit& u) const {
        const long L = (long)i * G + c; if (L >= nwg) return false;
        int wgid = (int)L; { const int q = nwg / NXCD, r = nwg % NXCD, xcd = wgid % NXCD, off = wgid / NXCD; wgid = (xcd < r ? xcd * (q + 1) : r * (q + 1) + (xcd - r) * q) + off; }
        const int nig = WGM * nN, gid = wgid / nig, fm = gid * WGM, gsz = (nM - fm) < WGM ? (nM - fm) : WGM;
        u.pm = fm + ((wgid % nig) % gsz); u.pn = (wgid % nig) / gsz; return true;
    }
    __device__ __forceinline__ void a_ready(const Unit&) const {}
    __device__ __forceinline__ void done(const Unit&) const {}
};
__device__ __forceinline__ unsigned cvt_pk_bf16(float lo, float hi) { unsigned r; asm volatile("v_cvt_pk_bf16_f32 %0, %1, %2" : "=v"(r) : "v"(lo), "v"(hi)); return r; }
typedef float f32x2c __attribute__((ext_vector_type(2))); typedef __bf16 bf16x2c __attribute__((ext_vector_type(2)));
__device__ __forceinline__ unsigned cvt_pk_bf16_v(float lo, float hi) { const f32x2c v = {lo, hi}; const bf16x2c b = __builtin_convertvector(v, bf16x2c); return __builtin_bit_cast(unsigned, b); }
__device__ __forceinline__ float bflo(unsigned w) { return __uint_as_float(w << 16); }
__device__ __forceinline__ float bfhi(unsigned w) { return __uint_as_float(w & 0xffff0000u); }
__device__ __forceinline__ void unpack8(const u32x4 w, float (&f)[8]) { f[0] = bflo(w.x); f[1] = bfhi(w.x); f[2] = bflo(w.y); f[3] = bfhi(w.y); f[4] = bflo(w.z); f[5] = bfhi(w.z); f[6] = bflo(w.w); f[7] = bfhi(w.w); }
__device__ __forceinline__ u32x4 pack8(const float (&f)[8]) { u32x4 w; w.x = cvt_pk_bf16(f[0], f[1]); w.y = cvt_pk_bf16(f[2], f[3]); w.z = cvt_pk_bf16(f[4], f[5]); w.w = cvt_pk_bf16(f[6], f[7]); return w; }
__device__ __forceinline__ float sigm(float x) { return __builtin_amdgcn_rcpf(1.f + __builtin_amdgcn_exp2f(-1.4426950408889634f * x)); }

struct EpiProj {
    static constexpr bool PERM = true, AFTER_DRAIN = false;
    unsigned char* ws;
    __device__ __forceinline__ void operator()(const f32x4 (&acc)[2][2][4][2], const Unit& u, int wr, int wc, int fr, int fq) const {
        const int pn = u.pn; const int row0 = u.pm * BM + wr * 64 + fr;
        size_t off; int ldc = 1024, colt, act = 0;
        if (pn < 16) { off = WS_QK + (size_t)(pn >> 2) * (64 * MiB); colt = (pn & 3) * 256; if ((pn >> 2) == 2) act = 2; }
        else if (pn < 18) { off = WS_SKV; ldc = 512; colt = (pn - 16) * 256; }
        else if (pn < 22) { off = WS_GA; colt = (pn - 18) * 256; act = 1; }
        else { off = WS_GB; colt = (pn - 22) * 256; act = 1; }
        bf16_t* base = (bf16_t*)(ws + off);
        const int col0 = colt + wc * 32 + 8 * fq;
#pragma unroll
        for (int ai = 0; ai < 2; ++ai)
#pragma unroll
            for (int m = 0; m < 4; ++m) { bf16_t* rowp = base + (size_t)(row0 + ai * HALF + m * 16) * ldc + col0;
#pragma unroll
                for (int bj = 0; bj < 2; ++bj) { const f32x4 v0 = acc[ai][bj][m][0], v1 = acc[ai][bj][m][1];
                    float f[8] = {v0[0], v0[1], v0[2], v0[3], v1[0], v1[1], v1[2], v1[3]};
                    if (act == 1) {
#pragma unroll
                        for (int e = 0; e < 8; ++e) f[e] = sigm(f[e]);
                    } else if (act == 2) {
#pragma unroll
                        for (int e = 0; e < 8; ++e) f[e] = f[e] * sigm(f[e]);
                    }
                    *(u32x4*)(rowp + bj * HALF) = pack8(f); } }
    }
};
template <bool FIRST> struct EpiGate {
    static constexpr bool PERM = true, AFTER_DRAIN = false;
    const bf16_t* gate; bf16_t* merged;
    __device__ __forceinline__ void operator()(const f32x4 (&acc)[2][2][4][2], const Unit& u, int wr, int wc, int fr, int fq) const {
        const int row0 = u.pm * BM + wr * 64 + fr, col0 = u.pn * BM + wc * 32 + 8 * fq;
#pragma unroll
        for (int ai = 0; ai < 2; ++ai)
#pragma unroll
            for (int m = 0; m < 4; ++m) { const size_t idx = (size_t)(row0 + ai * HALF + m * 16) * 1024 + col0;
#pragma unroll
                for (int bj = 0; bj < 2; ++bj) { const f32x4 v0 = acc[ai][bj][m][0], v1 = acc[ai][bj][m][1];
                    float f[8] = {v0[0], v0[1], v0[2], v0[3], v1[0], v1[1], v1[2], v1[3]}; float g[8];
                    unpack8(*(const u32x4*)(gate + idx + bj * HALF), g);
#pragma unroll
                    for (int e = 0; e < 8; ++e) f[e] *= g[e];
                    if (!FIRST) { float p[8]; unpack8(*(const u32x4*)(merged + idx + bj * HALF), p);
#pragma unroll
                        for (int e = 0; e < 8; ++e) f[e] += p[e]; }
                    *(u32x4*)(merged + idx + bj * HALF) = pack8(f); } }
    }
};
struct EpiRes {
    static constexpr bool PERM = true, AFTER_DRAIN = false;
    const float* x; float* h1; bf16_t* h1b; float* ssq;
    __device__ __forceinline__ void operator()(const f32x4 (&acc)[2][2][4][2], const Unit& u, int wr, int wc, int fr, int fq) const {
        const int row0 = u.pm * BM + wr * 64 + fr, col0 = u.pn * BM + wc * 32 + 8 * fq;
#pragma unroll
        for (int ai = 0; ai < 2; ++ai)
#pragma unroll
            for (int m = 0; m < 4; ++m) { const int row = row0 + ai * HALF + m * 16; const size_t idx = (size_t)row * 1024 + col0; float ss = 0.f;
#pragma unroll
                for (int bj = 0; bj < 2; ++bj) { const f32x4 x0 = *(const f32x4*)(x + idx + bj * HALF), x1 = *(const f32x4*)(x + idx + bj * HALF + 4);
                    const f32x4 h0 = x0 + acc[ai][bj][m][0], h1v = x1 + acc[ai][bj][m][1];
                    *(f32x4*)(h1 + idx + bj * HALF) = h0; *(f32x4*)(h1 + idx + bj * HALF + 4) = h1v;
                    float f[8] = {h0[0], h0[1], h0[2], h0[3], h1v[0], h1v[1], h1v[2], h1v[3]};
#pragma unroll
                    for (int e = 0; e < 8; ++e) ss += f[e] * f[e];
                    *(u32x4*)(h1b + idx + bj * HALF) = pack8(f); }
                ss += __shfl_xor(ss, 16); ss += __shfl_xor(ss, 32);
                if (fq == 0) atomicAdd(ssq + row, ss); }
    }
};
struct EpiUp {
    static constexpr bool PERM = true, AFTER_DRAIN = false;
    const float* ssq; bf16_t* U;
    __device__ __forceinline__ void operator()(const f32x4 (&acc)[2][2][4][2], const Unit& u, int wr, int wc, int fr, int fq) const {
        const int row0 = u.pm * BM + wr * 64 + fr, col0 = u.pn * BM + wc * 32 + 8 * fq;
#pragma unroll
        for (int ai = 0; ai < 2; ++ai)
#pragma unroll
            for (int m = 0; m < 4; ++m) { const int row = row0 + ai * HALF + m * 16; const float rs = __builtin_amdgcn_rsqf(ssq[row] * (1.0f / 1024.0f) + 1e-6f); bf16_t* rowp = U + (size_t)row * 4096 + col0;
#pragma unroll
                for (int bj = 0; bj < 2; ++bj) { const f32x4 v0 = acc[ai][bj][m][0], v1 = acc[ai][bj][m][1];
                    float f[8] = {v0[0], v0[1], v0[2], v0[3], v1[0], v1[1], v1[2], v1[3]};
#pragma unroll
                    for (int e = 0; e < 8; ++e) { const float r = fmaxf(f[e] * rs, 0.f); f[e] = r * r; }
                    *(u32x4*)(rowp + bj * HALF) = pack8(f); } }
    }
};
struct EpiDown {
    static constexpr bool PERM = true, AFTER_DRAIN = false;
    float* out;
    __device__ __forceinline__ void operator()(const f32x4 (&acc)[2][2][4][2], const Unit& u, int wr, int wc, int fr, int fq) const {
        const int row0 = u.pm * BM + wr * 64 + fr, col0 = u.pn * BM + wc * 32 + 8 * fq;
#pragma unroll
        for (int ai = 0; ai < 2; ++ai)
#pragma unroll
            for (int m = 0; m < 4; ++m) { float* rowp = out + (size_t)(row0 + ai * HALF + m * 16) * 1024 + col0;
#pragma unroll
                for (int bj = 0; bj < 2; ++bj) { const f32x4 a0 = *(const f32x4*)(rowp + bj * HALF), a1 = *(const f32x4*)(rowp + bj * HALF + 4);
                    *(f32x4*)(rowp + bj * HALF) = a0 + acc[ai][bj][m][0]; *(f32x4*)(rowp + bj * HALF + 4) = a1 + acc[ai][bj][m][1]; } }
    }
};
template <class Epi, class Sched, bool ALIGN_EPI = false, bool SP2 = false>
__device__ __forceinline__ void gemm_phase(PG8_LAS unsigned char* lds, const Gemm g, const Sched& S, const Epi& E) {
    int tid_ = threadIdx.x; asm volatile("" : "+v"(tid_));
    const int tid = tid_, wid = __builtin_amdgcn_readfirstlane(tid >> 6), lane = tid & 63, wr = wid >> 2, wc = wid & 3, fr = lane & 15, fq = lane >> 4;
    const int K = g.K, nt = K / BK;
    unsigned voffA[2], voffB[2];
#pragma unroll
    for (int i = 0; i < 2; ++i) { int R, C; stage_rc(tid * 16 + i * 8192, R, C); const int Rb = Epi::PERM ? ((R & ~31) + perm32(R & 31)) : R;
        voffA[i] = (unsigned)(R * K + C) * 2u; voffB[i] = (unsigned)(Rb * K + C) * 2u; }
    const size_t kstep = (size_t)(BK * 2);
    const size_t hstep = (size_t)HALF * K * 2;
    const size_t tstep = 2 * hstep;
    const unsigned ldsw = (unsigned)wid * 1024u;
    const int aoff = lds_byte(wr * 64 + fr, fq * 8), boff = lds_byte(wc * 32 + fr, fq * 8);
#define PG8_SA(b, h) (((b) * 2 + (h)) * HTB)
#define PG8_SB(b, h) ((4 + (b) * 2 + (h)) * HTB)
#define PG8_STAGE(bufoff, gbase, voff) do { _Pragma("unroll") for (int _i = 0; _i < 2; ++_i) \
        __builtin_amdgcn_global_load_lds((const unsigned*)((const char*)(gbase) + (voff)[_i]), (PG8_LAS unsigned*)(lds + (bufoff) + ldsw + _i * 8192), 16, 0, 0); } while (0)
#define PG8_LDA(dst, b, h) do { _Pragma("unroll") for (int m = 0; m < 4; ++m) _Pragma("unroll") for (int k = 0; k < 2; ++k) dst[m][k] = *(const PG8_LAS bf16x8*)(lds + PG8_SA(b, h) + aoff + m * 2048 + k * 1024); } while (0)
#define PG8_LDB(dst, b, h) do { _Pragma("unroll") for (int n = 0; n < 2; ++n) _Pragma("unroll") for (int k = 0; k < 2; ++k) dst[n][k] = *(const PG8_LAS bf16x8*)(lds + PG8_SB(b, h) + boff + n * 2048 + k * 1024); } while (0)
#define PG8_MMA(ai, bj, At, Bt) do { __builtin_amdgcn_s_setprio(1); _Pragma("unroll") for (int m = 0; m < 4; ++m) _Pragma("unroll") for (int n = 0; n < 2; ++n) _Pragma("unroll") for (int k = 0; k < 2; ++k) \
        acc[ai][bj][m][n] = __builtin_amdgcn_mfma_f32_16x16x32_bf16(Bt[n][k], At[m][k], acc[ai][bj][m][n], 0, 0, 0); __builtin_amdgcn_s_setprio(0); } while (0)
#define PG8_WAIT_V(n) asm volatile("s_waitcnt vmcnt(" #n ")" ::: "memory")
#define PG8_WAIT_L(n) asm volatile("s_waitcnt lgkmcnt(" #n ")" ::: "memory")
#define PG8_BAR __builtin_amdgcn_s_barrier()
#define PG8_SCHED __builtin_amdgcn_sched_barrier(0)
    Unit cur, nxt; int ui = 0;
    if (!S.next(0, cur)) return;
    f32x4 acc[2][2][4][2];
#pragma unroll
    for (int a = 0; a < 2; ++a)
#pragma unroll
        for (int b = 0; b < 2; ++b)
#pragma unroll
            for (int m = 0; m < 4; ++m)
#pragma unroll
                for (int n = 0; n < 2; ++n) acc[a][b][m][n] = (f32x4){0.f, 0.f, 0.f, 0.f};
    bf16x8 At[4][2], B0[2][2], B1[2][2];
    const char* cA = (const char*)g.A + (size_t)cur.pm * tstep; const char* cB = (const char*)g.Bt + (size_t)cur.pn * tstep;
    S.a_ready(cur);
    if constexpr (SP2) {
        PG8_STAGE(PG8_SB(0, 0), cB, voffB); PG8_STAGE(PG8_SB(0, 1), cB + hstep, voffB); PG8_STAGE(PG8_SA(0, 0), cA, voffA); PG8_STAGE(PG8_SA(0, 1), cA + hstep, voffA);
        if (wr == 1) PG8_BAR;
        PG8_WAIT_V(2); PG8_BAR;
        PG8_STAGE(PG8_SB(1, 0), cB + kstep, voffB); PG8_STAGE(PG8_SA(1, 0), cA + kstep, voffA); PG8_STAGE(PG8_SB(1, 1), cB + hstep + kstep, voffB);
        PG8_WAIT_V(6); PG8_BAR;
    } else {
        PG8_STAGE(PG8_SB(0, 0), cB, voffB); PG8_STAGE(PG8_SA(0, 0), cA, voffA); PG8_STAGE(PG8_SB(0, 1), cB + hstep, voffB); PG8_STAGE(PG8_SA(0, 1), cA + hstep, voffA);
        if (wr == 1) PG8_BAR;
        PG8_WAIT_V(4); PG8_BAR;
        PG8_STAGE(PG8_SB(1, 0), cB + kstep, voffB); PG8_STAGE(PG8_SA(1, 0), cA + kstep, voffA); PG8_STAGE(PG8_SB(1, 1), cB + hstep + kstep, voffB);
        PG8_WAIT_V(6); PG8_BAR;
    }
    for (;;) {
        const bool has_next = S.next(ui + 1, nxt);
        const char* nA = has_next ? (const char*)g.A + (size_t)nxt.pm * tstep : cA; const char* nB = has_next ? (const char*)g.Bt + (size_t)nxt.pn * tstep : cB;
        for (int t = 0; t < nt; t += 2) {
            const bool last = (t == nt - 2);
            const char* a1 = cA + (size_t)(t + 1) * kstep;
            const char* a2 = last ? nA : cA + (size_t)(t + 2) * kstep; const char* b2 = last ? nB : cB + (size_t)(t + 2) * kstep;
            const char* a3 = a2 + kstep; const char* b3 = b2 + kstep;
            if (last && has_next) S.a_ready(nxt);
            if constexpr (SP2) {
            PG8_LDB(B0, 0, 0); PG8_LDB(B1, 0, 1); PG8_SCHED; PG8_LDA(At, 0, 0); PG8_STAGE(PG8_SA(1, 1), a1 + hstep, voffA);
            PG8_WAIT_V(8); PG8_WAIT_L(0); PG8_BAR; PG8_MMA(0, 0, At, B0); PG8_MMA(0, 1, At, B1); PG8_BAR; PG8_SCHED;
            PG8_LDA(At, 0, 1); PG8_STAGE(PG8_SB(0, 0), b2, voffB); PG8_STAGE(PG8_SB(0, 1), b2 + hstep, voffB); PG8_STAGE(PG8_SA(0, 0), a2, voffA);
            PG8_WAIT_V(8); PG8_WAIT_L(0); PG8_BAR; PG8_MMA(1, 0, At, B0); PG8_MMA(1, 1, At, B1); PG8_BAR; PG8_SCHED;
            PG8_LDB(B0, 1, 0); PG8_LDB(B1, 1, 1); PG8_SCHED; PG8_LDA(At, 1, 0); PG8_STAGE(PG8_SA(0, 1), a2 + hstep, voffA);
            PG8_WAIT_V(8); PG8_WAIT_L(0); PG8_BAR; PG8_MMA(0, 0, At, B0); PG8_MMA(0, 1, At, B1); PG8_BAR; PG8_SCHED;
            PG8_LDA(At, 1, 1); PG8_STAGE(PG8_SB(1, 0), b3, voffB); PG8_STAGE(PG8_SB(1, 1), b3 + hstep, voffB); PG8_STAGE(PG8_SA(1, 0), a3, voffA);
            PG8_WAIT_V(8); PG8_WAIT_L(0); PG8_BAR; PG8_MMA(1, 0, At, B0); PG8_MMA(1, 1, At, B1); PG8_BAR; PG8_SCHED;
            } else {
            PG8_LDB(B0, 0, 0); PG8_SCHED; PG8_LDA(At, 0, 0); PG8_STAGE(PG8_SA(1, 1), a1 + hstep, voffA);
            PG8_WAIT_L(8); PG8_BAR; PG8_WAIT_L(0); PG8_MMA(0, 0, At, B0); PG8_BAR; PG8_SCHED;
            PG8_LDB(B1, 0, 1); PG8_STAGE(PG8_SB(0, 0), b2, voffB);
            PG8_BAR; PG8_WAIT_L(0); PG8_MMA(0, 1, At, B1); PG8_BAR;
            PG8_LDA(At, 0, 1); PG8_STAGE(PG8_SA(0, 0), a2, voffA);
            PG8_BAR; PG8_WAIT_L(0); PG8_MMA(1, 0, At, B0); PG8_BAR; PG8_SCHED;
            PG8_STAGE(PG8_SB(0, 1), b2 + hstep, voffB);
            PG8_WAIT_V(6); PG8_BAR; PG8_MMA(1, 1, At, B1); PG8_BAR;
            PG8_LDB(B0, 1, 0); PG8_SCHED; PG8_LDA(At, 1, 0); PG8_STAGE(PG8_SA(0, 1), a2 + hstep, voffA);
            PG8_WAIT_L(8); PG8_BAR; PG8_WAIT_L(0); PG8_MMA(0, 0, At, B0); PG8_BAR; PG8_SCHED;
            PG8_LDB(B1, 1, 1); PG8_STAGE(PG8_SB(1, 0), b3, voffB);
            PG8_BAR; PG8_WAIT_L(0); PG8_MMA(0, 1, At, B1); PG8_BAR;
            PG8_LDA(At, 1, 1); PG8_STAGE(PG8_SA(1, 0), a3, voffA);
            PG8_BAR; PG8_WAIT_L(0); PG8_MMA(1, 0, At, B0); PG8_BAR; PG8_SCHED;
            PG8_STAGE(PG8_SB(1, 1), b3 + hstep, voffB);
            PG8_WAIT_V(6); PG8_BAR; PG8_MMA(1, 1, At, B1); PG8_BAR;
            }
        }
        if constexpr (ALIGN_EPI) { if (wr == 0) PG8_BAR; }
        if constexpr (!Epi::AFTER_DRAIN) { E(acc, cur, wr, wc, fr, fq); S.done(cur); }
        if (!has_next) break;
#pragma unroll
        for (int a = 0; a < 2; ++a)
#pragma unroll
            for (int b = 0; b < 2; ++b)
#pragma unroll
                for (int m = 0; m < 4; ++m)
#pragma unroll
                    for (int n = 0; n < 2; ++n) acc[a][b][m][n] = (f32x4){0.f, 0.f, 0.f, 0.f};
        cur = nxt; cA = nA; cB = nB; ++ui;
        if constexpr (ALIGN_EPI) { if (wr == 1) PG8_BAR; }
    }
    PG8_WAIT_V(0);
    if constexpr (!ALIGN_EPI) { if (wr == 0) PG8_BAR; }
    PG8_BAR;
    if constexpr (Epi::AFTER_DRAIN) { E.fused(acc, cur, wr, wc, fr, fq, lds, wid, lane); S.done(cur); }
#undef PG8_SA
#undef PG8_SB
#undef PG8_STAGE
#undef PG8_LDA
#undef PG8_LDB
#undef PG8_MMA
#undef PG8_WAIT_V
#undef PG8_WAIT_L
#undef PG8_BAR
#undef PG8_SCHED
}
}

using pg8::bf16_t; using pg8::bf16x8; using pg8::f32x4; using pg8::u32x4; using pg8::unpack8; using pg8::pack8;
typedef unsigned u32x2 __attribute__((ext_vector_type(2)));
#define MFMA16(a, b, c) __builtin_amdgcn_mfma_f32_16x16x32_bf16((a), (b), (c), 0, 0, 0)
__device__ __forceinline__ unsigned pk2(float lo, float hi) { return pg8::cvt_pk_bf16(lo, hi); }
__device__ __forceinline__ unsigned pk2v(float lo, float hi) { return pg8::cvt_pk_bf16_v(lo, hi); }
__device__ __forceinline__ u32x4 pack8v(const float (&f)[8]) { u32x4 w; w.x = pk2v(f[0], f[1]); w.y = pk2v(f[2], f[3]); w.z = pk2v(f[4], f[5]); w.w = pk2v(f[6], f[7]); return w; }
__device__ __forceinline__ float wave_sum(float v) {
#pragma unroll
    for (int o = 1; o < 64; o <<= 1) v += __shfl_xor(v, o);
    return v;
}
#define LDS_WAIT() asm volatile("s_waitcnt lgkmcnt(0)" ::: "memory")
template <int CTRL> __device__ __forceinline__ float dpp_mov(float v) { return __builtin_bit_cast(float, __builtin_amdgcn_update_dpp(0, __builtin_bit_cast(int, v), CTRL, 0xf, 0xf, true)); }
__device__ __forceinline__ float sum8_dpp(float v) { v += dpp_mov<0xB1>(v); v += dpp_mov<0x4E>(v); v += dpp_mov<0x141>(v); return v; }
__device__ __forceinline__ float max8_dpp(float v) { v = fmaxf(v, dpp_mov<0xB1>(v)); v = fmaxf(v, dpp_mov<0x4E>(v)); v = fmaxf(v, dpp_mov<0x141>(v)); return v; }
__device__ __forceinline__ float sum16_dpp(float v) { v = sum8_dpp(v); v += dpp_mov<0x140>(v); return v; }

__device__ __forceinline__ void transpose_item(const float* __restrict__ W, int ldw, int K, bf16_t* WT, int dst_row0, int src_col0, int nvalid, const float* __restrict__ kscale, int k0, LAS float* scr, int lane) {
    const int c4 = lane & 7, kr = lane >> 3;
    f32x4 v[8];
#pragma unroll
    for (int i = 0; i < 8; ++i) { v[i] = (f32x4){0.f, 0.f, 0.f, 0.f};
        if (4 * c4 < nvalid) v[i] = *(const f32x4*)(W + (size_t)(k0 + kr + 8 * i) * ldw + src_col0 + 4 * c4); }
    if (kscale) {
#pragma unroll
        for (int i = 0; i < 8; ++i) v[i] = v[i] * kscale[k0 + kr + 8 * i];
    }
#pragma unroll
    for (int i = 0; i < 8; ++i) { LAS float* d = scr + (kr + 8 * i) * 33 + 4 * c4; d[0] = v[i].x; d[1] = v[i].y; d[2] = v[i].z; d[3] = v[i].w; }
    LDS_WAIT(); asm volatile("" ::: "memory");
    const int ch = lane & 7;
#pragma unroll
    for (int j = 0; j < 4; ++j) { const int n = (lane >> 3) + 8 * j; const LAS float* s = scr + (8 * ch) * 33 + n;
        u32x4 o; o.x = pk2(s[0 * 33], s[1 * 33]); o.y = pk2(s[2 * 33], s[3 * 33]); o.z = pk2(s[4 * 33], s[5 * 33]); o.w = pk2(s[6 * 33], s[7 * 33]);
        *(u32x4*)(WT + (size_t)(dst_row0 + n) * K + k0 + 8 * ch) = o; }
    LDS_WAIT(); asm volatile("" ::: "memory");
}
struct Ptrs {
    const float *x, *norm_mix, *w_in, *w_alpha2, *b_alpha, *gla_norm, *swa_qn, *swa_kn, *sinks, *w_bg, *w_bs, *w_out, *norm_mlp, *w_up, *w_down;
    float* out; unsigned char* ws;
};
constexpr int P0_I_SQ = 16 * 32, P0_I_UP = 16 * 128, P0_I_DN = 64 * 32, P0_REST_ITEMS = 3 * P0_I_SQ + P0_I_UP + P0_I_DN;
__device__ __forceinline__ void transpose_rest_item(const Ptrs& P, int r, LAS float* scr, int lane) {
    if (r < P0_I_SQ) { transpose_item(P.w_bg, 1024, 1024, (bf16_t*)(P.ws + WS_WBG), 32 * (r % 32), 32 * (r % 32), 32, nullptr, 64 * (r / 32), scr, lane); return; } r -= P0_I_SQ;
    if (r < P0_I_SQ) { transpose_item(P.w_bs, 1024, 1024, (bf16_t*)(P.ws + WS_WBS), 32 * (r % 32), 32 * (r % 32), 32, nullptr, 64 * (r / 32), scr, lane); return; } r -= P0_I_SQ;
    if (r < P0_I_SQ) { transpose_item(P.w_out, 1024, 1024, (bf16_t*)(P.ws + WS_WOUT), 32 * (r % 32), 32 * (r % 32), 32, nullptr, 64 * (r / 32), scr, lane); return; } r -= P0_I_SQ;
    if (r < P0_I_UP) { transpose_item(P.w_up, 4096, 1024, (bf16_t*)(P.ws + WS_WUP), 32 * (r % 128), 32 * (r % 128), 32, P.norm_mlp, 64 * (r / 128), scr, lane); return; } r -= P0_I_UP;
    transpose_item(P.w_down, 1024, 4096, (bf16_t*)(P.ws + WS_WDN), 32 * (r % 32), 32 * (r % 32), 32, nullptr, 64 * (r / 32), scr, lane);
}
__device__ __forceinline__ void p0_prologue(const Ptrs& P, LAS unsigned char* lds, int tid, int G, int blk) {
    const int lane = tid & 63, wave = tid >> 6;
    LAS float* scr = (LAS float*)(lds + wave * 12288);
    const int gw = blk * 8 + wave, NGW = G * 8;
    LAS bf16_t* WA = (LAS bf16_t*)(lds + 98304);
    for (int idx = tid; idx < 4096; idx += 512) { const int k = idx >> 2, c = (idx & 3) * 4; const f32x4 w = *(const f32x4*)(P.w_in + (size_t)k * 6672 + 3072 + c); const unsigned p0 = pk2(w.x, w.y), p1 = pk2(w.z, w.w);
        WA[(c + 0) * 1032 + k] = (bf16_t)(p0 & 0xffffu); WA[(c + 1) * 1032 + k] = (bf16_t)(p0 >> 16); WA[(c + 2) * 1032 + k] = (bf16_t)(p1 & 0xffffu); WA[(c + 3) * 1032 + k] = (bf16_t)(p1 >> 16); }
    __syncthreads();
    constexpr int I_IN = 16 * (NPROJ / 32);
    const int nitems = (G == 256) ? I_IN : I_IN + P0_REST_ITEMS;
    for (int it = gw; it < nitems; it += NGW) {
        if (it < I_IN) { const int nblk = NPROJ / 32, kb = it / nblk, nb = it % nblk, d = 32 * nb; int src, nv;
            if (d < 3072) { src = d; nv = 32; } else { src = d + 16; nv = 32; }
            transpose_item(P.w_in, 6672, 1024, (bf16_t*)(P.ws + WS_WIN), d, src, nv, nullptr, 64 * kb, scr, lane); continue; }
        transpose_rest_item(P, it - I_IN, scr, lane);
    }
    bf16_t* hn = (bf16_t*)P.out; float* alr = (float*)(P.ws + WS_ALR);
    LAS bf16_t* SR = (LAS bf16_t*)scr;
    const int fr = lane & 15, fq = lane >> 4;
    f32x4 gm[4];
#pragma unroll
    for (int j = 0; j < 4; ++j) gm[j] = *(const f32x4*)(P.norm_mix + 4 * lane + 256 * j);
    for (int m0 = gw * 4; m0 < M_TOK; m0 += NGW * 4) {
        f32x4 v[4][4];
#pragma unroll
        for (int r = 0; r < 4; ++r) { const f32x4* xr = (const f32x4*)(P.x + (size_t)(m0 + r) * DM) + lane;
#pragma unroll
            for (int j = 0; j < 4; ++j) v[r][j] = xr[64 * j]; }
#pragma unroll
        for (int r = 0; r < 4; ++r) { float s = 0.f;
#pragma unroll
            for (int j = 0; j < 4; ++j) s += (v[r][j].x * v[r][j].x + v[r][j].y * v[r][j].y) + (v[r][j].z * v[r][j].z + v[r][j].w * v[r][j].w);
            const float rs = __builtin_amdgcn_rsqf(wave_sum(s) * (1.0f / DM) + 1e-6f);
            unsigned long long* o8 = (unsigned long long*)(hn + (size_t)(m0 + r) * DM) + lane;
#pragma unroll
            for (int j = 0; j < 4; ++j) { const f32x4 y = v[r][j] * rs * gm[j]; const unsigned long long pk = (unsigned long long)pk2(y.x, y.y) | ((unsigned long long)pk2(y.z, y.w) << 32);
                o8[64 * j] = pk; *(LAS unsigned long long*)(SR + r * 1032 + 4 * lane + 256 * j) = pk; } }
        LDS_WAIT(); asm volatile("" ::: "memory");
        f32x4 ac0 = (f32x4){0.f, 0.f, 0.f, 0.f}, ac1 = ac0;
#pragma unroll 8
        for (int ks = 0; ks < 32; ks += 2) {
            const bf16x8 a0 = *(const LAS bf16x8*)(SR + (fr & 3) * 1032 + ks * 32 + fq * 8), b0 = *(const LAS bf16x8*)(WA + fr * 1032 + ks * 32 + fq * 8);
            const bf16x8 a1 = *(const LAS bf16x8*)(SR + (fr & 3) * 1032 + ks * 32 + 32 + fq * 8), b1 = *(const LAS bf16x8*)(WA + fr * 1032 + ks * 32 + 32 + fq * 8);
            ac0 = MFMA16(a0, b0, ac0); ac1 = MFMA16(a1, b1, ac1); }
        ac0 = ac0 + ac1;
        if (fq == 0) {
#pragma unroll
            for (int i = 0; i < 4; ++i) alr[(size_t)(m0 + i) * 16 + fr] = ac0[i]; }
        LDS_WAIT(); asm volatile("" ::: "memory");
    }
    float* ssq = (float*)(P.ws + WS_SSQ);
    for (int i = blk * 512 + tid; i < M_TOK; i += G * 512) ssq[i] = 0.f;
}

constexpr int SW_QN = 0, SW_KN = 36864, SW_VT = 64512, SW_OT = 90112;
struct SwaRegs { u32x4 q[4], k[3], v[3]; };
__device__ __forceinline__ void swa_load(SwaRegs& R, int b, int n, int kh, const bf16_t* __restrict__ SQ, const bf16_t* __restrict__ SKV, int tid) {
    asm volatile("" : "+v"(tid));
    const int lane = tid & 63, wave = tid >> 6, dq = tid & 7;
    const bf16_t* qb = SQ + ((size_t)b * SEQ_T + (size_t)n * 64) * 1024 + kh * 256;
    const bf16_t* kb = SKV + (size_t)b * SEQ_T * 512 + kh * 64;
    const int p0 = n * 64 - 128;
#pragma unroll
    for (int i = 0; i < 4; ++i) { const unsigned o = (unsigned)tid + 512u * i; R.q[i] = *(const u32x4*)(qb + ((o >> 5) * 1024u + (o & 31u) * 8u)); }
#pragma unroll
    for (int i = 0; i < 3; ++i) { const int j = (int)(((unsigned)tid + 512u * i) >> 3); const int pos = p0 + j;
        R.k[i] = (u32x4){0u, 0u, 0u, 0u};
        if (pos >= 0) R.k[i] = *(const u32x4*)(kb + ((unsigned)pos * 512u + (unsigned)dq * 8u)); }
#pragma unroll
    for (int i = 0; i < 3; ++i) { const int j = (lane >> 3) + 8 * wave + 64 * i; const int pos = p0 + j;
        R.v[i] = (u32x4){0u, 0u, 0u, 0u};
        if (pos >= 0) R.v[i] = *(const u32x4*)(kb + ((unsigned)pos * 512u + 256u + (unsigned)dq * 8u)); }
}
__device__ __forceinline__ float swa_stage(const SwaRegs& R, const float* __restrict__ qn, const float* __restrict__ kn, LAS unsigned char* lds, int tid) {
    asm volatile("" : "+v"(tid));
    const int lane = tid & 63, wave = tid >> 6, dq = tid & 7;
    LAS bf16_t* Qn = (LAS bf16_t*)(lds + SW_QN); LAS bf16_t* Kn = (LAS bf16_t*)(lds + SW_KN); LAS bf16_t* Vt = (LAS bf16_t*)(lds + SW_VT);
    float gqmax, gkmax;
    {
        float g8[8]; { const f32x4 a = *(const f32x4*)(qn + dq * 8), c = *(const f32x4*)(qn + dq * 8 + 4); g8[0] = a.x; g8[1] = a.y; g8[2] = a.z; g8[3] = a.w; g8[4] = c.x; g8[5] = c.y; g8[6] = c.z; g8[7] = c.w; }
#pragma unroll
        for (int i = 0; i < 4; ++i) { const int o = tid + 512 * i, t = o >> 5, oc = o & 31, g = oc >> 3;
            float f[8]; unpack8(R.q[i], f);
            float ss = 0.f;
#pragma unroll
            for (int e = 0; e < 8; ++e) ss += f[e] * f[e];
            ss = sum8_dpp(ss);
            const float rs = __builtin_amdgcn_rsqf(ss * (1.0f / 64.0f) + 1e-6f) * (0.125f * 1.4426950408889634f);
#pragma unroll
            for (int e = 0; e < 8; ++e) f[e] = f[e] * rs * g8[e];
            *(LAS u32x4*)(Qn + (g * 64 + t) * 72 + dq * 8) = pack8(f); __builtin_amdgcn_sched_barrier(0); }
        float m = 0.f;
#pragma unroll
        for (int e = 0; e < 8; ++e) m = fmaxf(m, fabsf(g8[e]));
        gqmax = max8_dpp(m);
    }
    {
        float g8[8]; { const f32x4 a = *(const f32x4*)(kn + dq * 8), c = *(const f32x4*)(kn + dq * 8 + 4); g8[0] = a.x; g8[1] = a.y; g8[2] = a.z; g8[3] = a.w; g8[4] = c.x; g8[5] = c.y; g8[6] = c.z; g8[7] = c.w; }
#pragma unroll
        for (int i = 0; i < 3; ++i) { const int o = tid + 512 * i, j = o >> 3;
            float f[8]; unpack8(R.k[i], f);
            float ss = 0.f;
#pragma unroll
            for (int e = 0; e < 8; ++e) ss += f[e] * f[e];
            ss = sum8_dpp(ss);
            const float rs = __builtin_amdgcn_rsqf(ss * (1.0f / 64.0f) + 1e-6f);
#pragma unroll
            for (int e = 0; e < 8; ++e) f[e] = f[e] * rs * g8[e];
            *(LAS u32x4*)(Kn + j * 72 + dq * 8) = pack8(f); __builtin_amdgcn_sched_barrier(0); }
        float m = 0.f;
#pragma unroll
        for (int e = 0; e < 8; ++e) m = fmaxf(m, fabsf(g8[e]));
        gkmax = max8_dpp(m);
    }
#pragma unroll
    for (int i = 0; i < 3; ++i) { const int j = (lane >> 3) + 8 * wave + 64 * i; const u32x4 w = R.v[i];
        LAS bf16_t* vp = Vt + (dq * 8) * 200 + (j ^ (dq << 3));
        vp[0 * 200] = (bf16_t)(w.x & 0xffffu); vp[1 * 200] = (bf16_t)(w.x >> 16); vp[2 * 200] = (bf16_t)(w.y & 0xffffu); vp[3 * 200] = (bf16_t)(w.y >> 16);
        vp[4 * 200] = (bf16_t)(w.z & 0xffffu); vp[5 * 200] = (bf16_t)(w.z >> 16); vp[6 * 200] = (bf16_t)(w.w & 0xffffu); vp[7 * 200] = (bf16_t)(w.w >> 16); }
    return 8.0f * 1.4426950408889634f * gqmax * gkmax;
}
__device__ __forceinline__ void swa_compute(float M2, int b, int n, int kh, bf16_t* __restrict__ OS, const float* __restrict__ sinks, LAS unsigned char* lds, int tid) {
    asm volatile("" : "+v"(tid));
    const int lane = tid & 63, wave = tid >> 6, fr = lane & 15, fq = lane >> 4;
    LAS bf16_t* Qn = (LAS bf16_t*)(lds + SW_QN); LAS bf16_t* Kn = (LAS bf16_t*)(lds + SW_KN); LAS bf16_t* Vt = (LAS bf16_t*)(lds + SW_VT);
    const int g = wave >> 1, qh = wave & 1;
    const int hh = kh * 4 + g; const float slope = exp2f(-0.5f * (float)(hh + 1)) * 1.4426950408889634f; const float sink = sinks[hh] * 1.4426950408889634f;
    bf16x8 bq[2][2]; float fb[2];
#pragma unroll
    for (int qt = 0; qt < 2; ++qt) { const int qrow = qh * 32 + qt * 16 + fr; fb[qt] = (float)(128 + qrow - 4 * fq);
#pragma unroll
        for (int ks = 0; ks < 2; ++ks) bq[qt][ks] = *(const LAS bf16x8*)(Qn + (g * 64 + qrow) * 72 + ks * 32 + fq * 8); }
    float l[2] = {0.f, 0.f};
    f32x4 oa[4][2];
#pragma unroll
    for (int dt = 0; dt < 4; ++dt)
#pragma unroll
        for (int qt = 0; qt < 2; ++qt) oa[dt][qt] = (f32x4){0.f, 0.f, 0.f, 0.f};
    const int kg0 = n >= 2 ? 0 : 2 - n;
#pragma unroll 1
    for (int kg = kg0; kg < 3; ++kg) {
        float ini[2];
#pragma unroll
        for (int qt = 0; qt < 2; ++qt) ini[qt] = kg < 2 ? -M2 - slope * (fb[qt] - (float)(kg * 64)) : -M2;
        f32x4 sc[4][2];
#pragma unroll
        for (int k4 = 0; k4 < 4; ++k4) { const LAS bf16_t* kr = Kn + (kg * 64 + k4 * 16 + fr) * 72 + fq * 8;
            const bf16x8 ak0 = *(const LAS bf16x8*)(kr), ak1 = *(const LAS bf16x8*)(kr + 32);
#pragma unroll
            for (int qt = 0; qt < 2; ++qt) { f32x4 a = (f32x4){ini[qt], ini[qt], ini[qt], ini[qt]}; a = MFMA16(ak0, bq[qt][0], a); a = MFMA16(ak1, bq[qt][1], a); sc[k4][qt] = a; } }
        if (kg < 2) {
#pragma unroll
            for (int k4 = 0; k4 < 4; ++k4)
#pragma unroll
                for (int qt = 0; qt < 2; ++qt)
#pragma unroll
                    for (int i = 0; i < 4; ++i) sc[k4][qt][i] = fmaf(slope, (float)(k4 * 16 + i), sc[k4][qt][i]);
        } else {
#pragma unroll
            for (int k4 = 0; k4 < 4; ++k4)
#pragma unroll
                for (int qt = 0; qt < 2; ++qt)
#pragma unroll
                    for (int i = 0; i < 4; ++i) sc[k4][qt][i] = sc[k4][qt][i] - slope * fabsf((fb[qt] - 128.0f) - (float)(k4 * 16 + i));
        }
#pragma unroll
        for (int k4 = 0; k4 < 4; ++k4)
#pragma unroll
            for (int qt = 0; qt < 2; ++qt)
#pragma unroll
                for (int i = 0; i < 4; ++i) { const float p = __builtin_amdgcn_exp2f(sc[k4][qt][i]); sc[k4][qt][i] = p; l[qt] += p; }
#pragma unroll
        for (int s2 = 0; s2 < 2; ++s2) {
            bf16x8 bp[2];
#pragma unroll
            for (int qt = 0; qt < 2; ++qt) { u32x4 pw; pw.x = pk2v(sc[2 * s2][qt][0], sc[2 * s2][qt][1]); pw.y = pk2v(sc[2 * s2][qt][2], sc[2 * s2][qt][3]);
                pw.z = pk2v(sc[2 * s2 + 1][qt][0], sc[2 * s2 + 1][qt][1]); pw.w = pk2v(sc[2 * s2 + 1][qt][2], sc[2 * s2 + 1][qt][3]); bp[qt] = __builtin_bit_cast(bf16x8, pw); }
#pragma unroll
            for (int dt = 0; dt < 4; ++dt) { const int d = dt * 16 + fr, swz = ((d >> 3) & 7) << 3; const LAS bf16_t* vr = Vt + d * 200; const int j0 = kg * 64 + 32 * s2 + 4 * fq;
                const u32x2 lo = *(const LAS u32x2*)(vr + (j0 ^ swz)), hi = *(const LAS u32x2*)(vr + ((j0 + 16) ^ swz));
                u32x4 w; w.x = lo.x; w.y = lo.y; w.z = hi.x; w.w = hi.y; const bf16x8 av = __builtin_bit_cast(bf16x8, w);
#pragma unroll
                for (int qt = 0; qt < 2; ++qt) oa[dt][qt] = MFMA16(av, bp[qt], oa[dt][qt]); }
        }
    }
    const float esink = __builtin_amdgcn_exp2f(sink - M2);
#pragma unroll
    for (int qt = 0; qt < 2; ++qt) { float ls = l[qt]; ls += __shfl_xor(ls, 16); ls += __shfl_xor(ls, 32); const float inv = __builtin_amdgcn_rcpf(ls + esink);
        LAS bf16_t* op = (LAS bf16_t*)(lds + SW_OT) + (qh * 32 + qt * 16 + fr) * 264 + g * 64 + 4 * fq;
#pragma unroll
        for (int dt = 0; dt < 4; ++dt) { const f32x4 v = oa[dt][qt] * inv; u32x2 w; w.x = pk2(v[0], v[1]); w.y = pk2(v[2], v[3]); *(LAS u32x2*)(op + dt * 16) = w; } }
}
__device__ __forceinline__ void swa_store(int b, int n, int kh, bf16_t* __restrict__ OS, LAS unsigned char* lds, int tid) {
    asm volatile("" : "+v"(tid));
    const LAS bf16_t* OT = (const LAS bf16_t*)(lds + SW_OT);
    bf16_t* ob = OS + ((size_t)b * SEQ_T + (size_t)n * 64) * 1024 + kh * 256;
#pragma unroll
    for (int i = 0; i < 4; ++i) { const unsigned o = (unsigned)tid + 512u * i, t = o >> 5, oc = o & 31u; *(u32x4*)(ob + (t * 1024u + oc * 8u)) = *(const LAS u32x4*)(OT + t * 264u + oc * 8u); }
}

constexpr int GL_CUM = 0, GL_QD = 34816, GL_KD = 52224, GL_KT = 69632, GL_VT = 88064, GL_P = 124928, GL_SSQ = 134144, GL_DEC = 136192, GL_QT = 137216, GL_ALR = 139264, GL_END = 143360;
static_assert(GL_END <= LDS_BYTES, "GLA LDS map");
constexpr int GLA_NSEG = 8, GLA_SEGC = 64 / GLA_NSEG;
template <bool FULL>
__device__ __forceinline__ void gla_seg(int b, int h, int seg, const bf16_t* __restrict__ QK, const bf16_t* __restrict__ GV, const bf16_t* __restrict__ GG, const float* __restrict__ ALR,
                                        const float* __restrict__ w2, const float* __restrict__ balpha, const float* __restrict__ gnorm, bf16_t* __restrict__ OG,
                                        float* __restrict__ Lws, float* __restrict__ Dws, LAS unsigned char* lds, int tid) {
    asm volatile("" : "+v"(tid));
    const int lane = tid & 63, wave = tid >> 6, fr = lane & 15, fq = lane >> 4;
    LAS float* CUM = (LAS float*)(lds + GL_CUM); LAS bf16_t* OB = (LAS bf16_t*)(lds + GL_QD);
    LAS bf16_t* QD = (LAS bf16_t*)(lds + GL_QD); LAS bf16_t* KD = (LAS bf16_t*)(lds + GL_KD); LAS bf16_t* KT = (LAS bf16_t*)(lds + GL_KT); LAS bf16_t* VT = (LAS bf16_t*)(lds + GL_VT);
    LAS bf16_t* PB = (LAS bf16_t*)(lds + GL_P); LAS float* SSQ = (LAS float*)(lds + GL_SSQ); LAS float* DEC = (LAS float*)(lds + GL_DEC); LAS float* QT = (LAS float*)(lds + GL_QT);
    LAS float* ALRS = (LAS float*)(lds + GL_ALR);
    const int lt = (lane >> 3) + 8 * wave, lo = lane & 7, lsw = lt ^ (lo << 3);
    const int seq = b * 4 + h;
    f32x4 S[8][2];
#pragma unroll
    for (int a = 0; a < 8; ++a)
#pragma unroll
        for (int c = 0; c < 2; ++c) S[a][c] = (f32x4){0.f, 0.f, 0.f, 0.f};
    if (FULL) {
        const float* Lb0 = Lws + (size_t)(seq * GLA_NSEG) * 32768 + (size_t)wave * 4096 + lane * 4; const float* Db0 = Dws + (seq * GLA_NSEG) * 128;
        f32x4 La[16], Lb[16];
#define GLA_LOADL(DST, J) do { _Pragma("unroll") for (int q_ = 0; q_ < 16; ++q_) DST[q_] = *(const f32x4*)(Lb0 + (size_t)(J) * 32768 + q_ * 256); } while (0)
#define GLA_FOLD(SRC, J) do { _Pragma("unroll") for (int dkt = 0; dkt < 8; ++dkt) { const f32x4 dc = *(const f32x4*)(Db0 + (J) * 128 + dkt * 16 + 4 * fq); \
            _Pragma("unroll") for (int dvt = 0; dvt < 2; ++dvt) S[dkt][dvt] = S[dkt][dvt] * dc + SRC[dkt * 2 + dvt]; } } while (0)
        if (seg > 0) GLA_LOADL(La, 0);
#pragma unroll 1
        for (int j = 0; j < seg; j += 2) {
            if (j + 1 < seg) GLA_LOADL(Lb, j + 1);
            GLA_FOLD(La, j);
            if (j + 1 < seg) { if (j + 2 < seg) GLA_LOADL(La, j + 2); GLA_FOLD(Lb, j + 1); }
        }
#undef GLA_LOADL
#undef GLA_FOLD
    }
    const int dkc = wave * 16 + fr;
    bf16x8 w2f; { float w[8];
#pragma unroll
        for (int j = 0; j < 8; ++j) w[j] = w2[((fq & 1) * 8 + j) * 512 + h * 128 + dkc];
        w2f = __builtin_bit_cast(bf16x8, pack8v(w)); }
    const float bz = balpha[h * 128 + dkc];
    const size_t tokb = (size_t)b * SEQ_T + (size_t)seg * (GLA_SEGC * 64);
    if (tid < 256) *(LAS f32x4*)(ALRS + tid * 4) = *(const f32x4*)(ALR + tokb * 16 + tid * 4);
    float segtot = 0.f;
    u32x4 qw[2], kw[2], vw[4];
#define GLA_LOAD_QKV(T0) do { _Pragma("unroll") for (int i_ = 0; i_ < 2; ++i_) { const int oc_ = lo + 8 * i_; \
            kw[i_] = *(const u32x4*)(QK + ((T0) + lt) * 1024 + 512 + h * 128 + oc_ * 8); } \
        _Pragma("unroll") for (int i_ = 0; i_ < 4; ++i_) { const int oc_ = lo + 8 * i_; vw[i_] = *(const u32x4*)(GV + ((T0) + lt) * 1024 + h * 256 + oc_ * 8); } } while (0)
    __syncthreads();
#pragma unroll 1
    for (int c = 0; c < GLA_SEGC; ++c) {
        const size_t tok0 = tokb + (size_t)c * 64;
        GLA_LOAD_QKV(tok0);
        if (FULL) {
#pragma unroll
            for (int i = 0; i < 2; ++i) qw[i] = *(const u32x4*)(QK + (tok0 + lt) * 1024 + h * 128 + (lo + 8 * i) * 8); }
        {
            float carry = 0.f;
#pragma unroll
            for (int tt = 0; tt < 4; ++tt) {
                const LAS f32x4* ar = (const LAS f32x4*)(ALRS + (tt * 16 + fr) * 16 + (fq & 1) * 8); const f32x4 x0 = ar[0], x1 = ar[1];
                float x[8] = {x0.x, x0.y, x0.z, x0.w, x1.x, x1.y, x1.z, x1.w}, xh[8];
                unpack8(pack8v(x), xh);
                if (fq >= 2) {
#pragma unroll
                    for (int e = 0; e < 8; ++e) x[e] -= xh[e];
                }
                const bf16x8 af = __builtin_bit_cast(bf16x8, pack8v(x));
                const f32x4 z4 = MFMA16(af, w2f, ((f32x4){0.f, 0.f, 0.f, 0.f}));
                float v[4];
#pragma unroll
                for (int i = 0; i < 4; ++i) { const float z = z4[i] + bz;
                    v[i] = (fminf(z, 0.f) - 0.6931471805599453f * __builtin_amdgcn_logf(1.0f + __builtin_amdgcn_exp2f(-1.4426950408889634f * fabsf(z)))) * (1.0f / 16.0f); }
                v[1] += v[0]; v[2] += v[1]; v[3] += v[2];
                const float tot4 = v[3];
                const float p1 = __shfl_up(tot4, 16); float sc = tot4 + (fq >= 1 ? p1 : 0.f);
                const float p2 = __shfl_up(sc, 32); sc += (fq >= 2 ? p2 : 0.f);
                const float base = carry + (sc - tot4);
#pragma unroll
                for (int i = 0; i < 4; ++i) CUM[(tt * 16 + 4 * fq + i) * 132 + dkc] = v[i] + base;
                carry += __shfl(sc, 48 + fr);
            }
            if (fq == 0) DEC[dkc] = __builtin_amdgcn_exp2f(1.4426950408889634f * carry);
            segtot += carry;
        }
        __syncthreads();
        if (c + 1 < GLA_SEGC && tid < 256) *(LAS f32x4*)(ALRS + tid * 4) = *(const f32x4*)(ALR + (tok0 + 64) * 16 + tid * 4);
#pragma unroll
        for (int i = 0; i < 2; ++i) { const int oc = lo + 8 * i, t = lt;
            float k8[8]; unpack8(kw[i], k8);
            const f32x4 c0 = *(const LAS f32x4*)(CUM + t * 132 + oc * 8), c1 = *(const LAS f32x4*)(CUM + t * 132 + oc * 8 + 4);
            const f32x4 d0 = *(const LAS f32x4*)(DEC + oc * 8), d1 = *(const LAS f32x4*)(DEC + oc * 8 + 4);
            const float cm[8] = {c0.x, c0.y, c0.z, c0.w, c1.x, c1.y, c1.z, c1.w}; const float dc[8] = {d0.x, d0.y, d0.z, d0.w, d1.x, d1.y, d1.z, d1.w};
            float kd[8], ke[8];
#pragma unroll
            for (int e = 0; e < 8; ++e) { const float em = __builtin_amdgcn_exp2f(-1.4426950408889634f * cm[e]); kd[e] = k8[e] * em; ke[e] = kd[e] * dc[e]; }
            if (FULL) { float q8[8], qd[8]; unpack8(qw[i], q8);
#pragma unroll
                for (int e = 0; e < 8; ++e) qd[e] = q8[e] * __builtin_amdgcn_exp2f(1.4426950408889634f * cm[e]) * 0.08838834764831845f;
                *(LAS u32x4*)(QD + t * 136 + oc * 8) = pack8(qd); *(LAS u32x4*)(KD + t * 136 + oc * 8) = pack8(kd); }
            const u32x4 kp8 = pack8(ke); LAS bf16_t* kp = KT + (oc * 8) * 72 + lsw;
            kp[0 * 72] = (bf16_t)(kp8.x & 0xffffu); kp[1 * 72] = (bf16_t)(kp8.x >> 16); kp[2 * 72] = (bf16_t)(kp8.y & 0xffffu); kp[3 * 72] = (bf16_t)(kp8.y >> 16);
            kp[4 * 72] = (bf16_t)(kp8.z & 0xffffu); kp[5 * 72] = (bf16_t)(kp8.z >> 16); kp[6 * 72] = (bf16_t)(kp8.w & 0xffffu); kp[7 * 72] = (bf16_t)(kp8.w >> 16); }
#pragma unroll
        for (int i = 0; i < 4; ++i) { const int oc = lo + 8 * i; const u32x4 w = vw[i]; LAS bf16_t* vp = VT + (oc * 8) * 72 + lsw;
            vp[0 * 72] = (bf16_t)(w.x & 0xffffu); vp[1 * 72] = (bf16_t)(w.x >> 16); vp[2 * 72] = (bf16_t)(w.y & 0xffffu); vp[3 * 72] = (bf16_t)(w.y >> 16);
            vp[4 * 72] = (bf16_t)(w.z & 0xffffu); vp[5 * 72] = (bf16_t)(w.z >> 16); vp[6 * 72] = (bf16_t)(w.w & 0xffffu); vp[7 * 72] = (bf16_t)(w.w >> 16); }
        __syncthreads();
        f32x4 o[4][2];
        u32x4 gw[4];
        if (FULL) {
            {
                const int tt = wave >> 1;
#pragma unroll
                for (int u2 = 0; u2 < 2; ++u2) { const int st = (wave & 1) * 2 + u2; f32x4 a = (f32x4){0.f, 0.f, 0.f, 0.f};
                    if (st <= tt) {
#pragma unroll
                        for (int ks = 0; ks < 4; ++ks) { const bf16x8 ak = *(const LAS bf16x8*)(KD + (st * 16 + fr) * 136 + ks * 32 + fq * 8), bq = *(const LAS bf16x8*)(QD + (tt * 16 + fr) * 136 + ks * 32 + fq * 8);
                            a = MFMA16(ak, bq, a); }
                    }
                    const int t = tt * 16 + fr, s0 = st * 16 + 4 * fq;
                    const float p0 = (s0 + 0 <= t) ? a[0] : 0.f, p1 = (s0 + 1 <= t) ? a[1] : 0.f, p2 = (s0 + 2 <= t) ? a[2] : 0.f, p3 = (s0 + 3 <= t) ? a[3] : 0.f;
                    u32x2 w; w.x = pk2(p0, p1); w.y = pk2(p2, p3); *(LAS u32x2*)(PB + t * 72 + s0) = w; }
            }
#pragma unroll
            for (int a = 0; a < 4; ++a)
#pragma unroll
                for (int d = 0; d < 2; ++d) o[a][d] = (f32x4){0.f, 0.f, 0.f, 0.f};
#pragma unroll
            for (int ks = 0; ks < 4; ++ks) {
                bf16x8 bs[2];
#pragma unroll
                for (int dvt = 0; dvt < 2; ++dvt) { u32x4 w; w.x = pk2v(S[2 * ks][dvt][0], S[2 * ks][dvt][1]); w.y = pk2v(S[2 * ks][dvt][2], S[2 * ks][dvt][3]);
                    w.z = pk2v(S[2 * ks + 1][dvt][0], S[2 * ks + 1][dvt][1]); w.w = pk2v(S[2 * ks + 1][dvt][2], S[2 * ks + 1][dvt][3]); bs[dvt] = __builtin_bit_cast(bf16x8, w); }
#pragma unroll
                for (int tt = 0; tt < 4; ++tt) { const LAS bf16_t* qp = QD + (tt * 16 + fr) * 136 + 32 * ks + 4 * fq;
                    const u32x2 lo = *(const LAS u32x2*)(qp), hi = *(const LAS u32x2*)(qp + 16);
                    u32x4 w; w.x = lo.x; w.y = lo.y; w.z = hi.x; w.w = hi.y; const bf16x8 aq = __builtin_bit_cast(bf16x8, w);
#pragma unroll
                    for (int dvt = 0; dvt < 2; ++dvt) o[tt][dvt] = MFMA16(aq, bs[dvt], o[tt][dvt]); }
            }
        }
        bf16x8 bv[2][2];
#pragma unroll
        for (int dvt = 0; dvt < 2; ++dvt)
#pragma unroll
            for (int ks = 0; ks < 2; ++ks) { const int dv = wave * 32 + dvt * 16 + fr; bv[dvt][ks] = *(const LAS bf16x8*)(VT + dv * 72 + ((ks * 32 + fq * 8) ^ (((dv >> 3) & 7) << 3))); }
#pragma unroll
        for (int dkt = 0; dkt < 8; ++dkt) { const f32x4 dc = *(const LAS f32x4*)(DEC + dkt * 16 + 4 * fq);
#pragma unroll
            for (int dvt = 0; dvt < 2; ++dvt) S[dkt][dvt] = S[dkt][dvt] * dc;
#pragma unroll
            for (int ks = 0; ks < 2; ++ks) { const int dkr = dkt * 16 + fr; const bf16x8 ak = *(const LAS bf16x8*)(KT + dkr * 72 + ((ks * 32 + fq * 8) ^ (((dkr >> 3) & 7) << 3)));
#pragma unroll
                for (int dvt = 0; dvt < 2; ++dvt) S[dkt][dvt] = MFMA16(ak, bv[dvt][ks], S[dkt][dvt]); } }
        if (FULL) {
#pragma unroll
            for (int i = 0; i < 4; ++i) { const int oid = tid + 512 * i, t = oid >> 5, oc = oid & 31; gw[i] = *(const u32x4*)(GG + (tok0 + t) * 1024 + h * 256 + oc * 8); }
        }
        __syncthreads();
        if (FULL) {
#pragma unroll
            for (int ks = 0; ks < 2; ++ks)
#pragma unroll
                for (int tt = 0; tt < 4; ++tt) { if (ks == 1 && tt < 2) continue;
                    const bf16x8 ap = *(const LAS bf16x8*)(PB + (tt * 16 + fr) * 72 + ks * 32 + fq * 8);
#pragma unroll
                    for (int dvt = 0; dvt < 2; ++dvt) o[tt][dvt] = MFMA16(ap, bv[dvt][ks], o[tt][dvt]); }
#pragma unroll
            for (int tt = 0; tt < 4; ++tt)
#pragma unroll
                for (int i = 0; i < 4; ++i) { const int t = tt * 16 + 4 * fq + i; const float v0 = o[tt][0][i], v1 = o[tt][1][i];
                    const unsigned w = pk2(v0, v1);
                    OB[t * 272 + wave * 32 + fr] = (bf16_t)(w & 0xffffu); OB[t * 272 + wave * 32 + 16 + fr] = (bf16_t)(w >> 16);
                    const float q = sum16_dpp(v0 * v0 + v1 * v1);
                    if (fr == 0) SSQ[wave * 64 + t] = q; }
            __syncthreads();
#pragma unroll
            for (int i = 0; i < 4; ++i) { const int oid = tid + 512 * i, t = oid >> 5, oc = oid & 31;
                float ss = 0.f;
#pragma unroll
                for (int w = 0; w < 8; ++w) ss += SSQ[w * 64 + t];
                const float rs = __builtin_amdgcn_rsqf(ss * (1.0f / 256.0f) + 1e-6f);
                float ov[8], gv[8]; unpack8(*(const LAS u32x4*)(OB + t * 272 + oc * 8), ov); unpack8(gw[i], gv);
                const f32x4 n0 = *(const f32x4*)(gnorm + oc * 8), n1 = *(const f32x4*)(gnorm + oc * 8 + 4); const float gn[8] = {n0.x, n0.y, n0.z, n0.w, n1.x, n1.y, n1.z, n1.w};
#pragma unroll
                for (int e = 0; e < 8; ++e) ov[e] = ov[e] * rs * gn[e] * gv[e];
                *(u32x4*)(OG + (tok0 + t) * 1024 + h * 256 + oc * 8) = pack8(ov); }
        }
    }
    if (!FULL) {
        float* Lj = Lws + (size_t)(seq * GLA_NSEG + seg) * 32768 + (size_t)wave * 4096 + lane * 4;
#pragma unroll
        for (int dkt = 0; dkt < 8; ++dkt)
#pragma unroll
            for (int dvt = 0; dvt < 2; ++dvt) *(f32x4*)(Lj + (dkt * 2 + dvt) * 256) = S[dkt][dvt];
        if (fq == 0) Dws[(seq * GLA_NSEG + seg) * 128 + dkc] = __builtin_amdgcn_exp2f(1.4426950408889634f * segtot);
    }
#undef GLA_LOAD_QKV
}

#define XB_TMO      128
#define XB_XCNT(j)  (256  + 64 * (j))
#define XB_XSUB(j)  (1280 + 64 * (j))
#define XB_XGEN(j)  (2304 + 64 * (j))
#define XB_TOP      3328
#define XB_TOPGEN   3392
#define XCD_BAR_WORDS 3456
#define XB_SPIN_CAP (1u << 18)

__device__ __forceinline__ unsigned xb_ld(unsigned* p)              { return __hip_atomic_load(p, __ATOMIC_RELAXED, __HIP_MEMORY_SCOPE_AGENT); }
__device__ __forceinline__ unsigned xb_add(unsigned* p, unsigned v) { return __hip_atomic_fetch_add(p, v, __ATOMIC_RELAXED, __HIP_MEMORY_SCOPE_AGENT); }
__device__ __forceinline__ unsigned xb_xcc_id() { return (unsigned)__builtin_amdgcn_s_getreg((3 << 11) | 20) & 0xFu; }
#define XB_SPIN(cond, bar) do { unsigned _sp = 0; while (cond) { __builtin_amdgcn_s_sleep(1); \
    if ((++_sp & 255u) == 0u) { if (xb_ld(&(bar)[XB_TMO])) break; if (_sp > XB_SPIN_CAP) { atomicAdd(&(bar)[XB_TMO], 1u); break; } } } } while (0)

struct XcdBarrier {
    unsigned* bar; unsigned x;
    volatile LAS unsigned* st;
};

__device__ __forceinline__ XcdBarrier xcd_barrier_post(unsigned* bar, volatile LAS unsigned* st) {
    XcdBarrier b; b.bar = bar; b.x = xb_xcc_id(); b.st = st;
    if (threadIdx.x == 0) (void)xb_add(&bar[XB_XCNT(b.x)], 1u);
    return b;
}
__device__ __forceinline__ void xcd_barrier_complete(unsigned* bar, unsigned x, unsigned& nloc, unsigned& nx) {
    const unsigned G = gridDim.x * gridDim.y * gridDim.z;
    unsigned sum, cnt, mine, sp = 0u;
    for (;;) {
        sum = 0u; cnt = 0u; mine = 0u;
#pragma unroll
        for (unsigned j = 0; j < 16; ++j) { const unsigned c = xb_ld(&bar[XB_XCNT(j)]); sum += c; cnt += (c > 0u) ? 1u : 0u; mine = (j == x) ? c : mine; }
        if (sum == G) break;
        __builtin_amdgcn_s_sleep(1);
        if ((++sp & 255u) == 0u) { if (xb_ld(&bar[XB_TMO])) break; if (sp > XB_SPIN_CAP) { atomicAdd(&bar[XB_TMO], 1u); break; } }
    }
    nloc = mine > 0u ? mine : 1u; nx = cnt > 0u ? cnt : 1u;
}

__device__ __forceinline__ void xcd_barrier(const XcdBarrier& b) {
    asm volatile("s_waitcnt vmcnt(0)" ::: "memory");
    __syncthreads();
    if (threadIdx.x == 0) {
        unsigned* bar = b.bar;
        __builtin_amdgcn_s_waitcnt(0);
        unsigned nloc = b.st[0], nx = b.st[1];
        if (nloc == 0u) { xcd_barrier_complete(bar, b.x, nloc, nx); b.st[0] = nloc; b.st[1] = nx; }
        const unsigned old = xb_add(&bar[XB_XSUB(b.x)], 1u);
        const unsigned gen = old / nloc;
        if (old + 1u == (gen + 1u) * nloc) {
            __builtin_amdgcn_fence(__ATOMIC_RELEASE, "agent");
            asm volatile("s_waitcnt vmcnt(0)" ::: "memory");
            const unsigned og = xb_add(&bar[XB_TOP], 1u);
            const unsigned tg = og / nx;
            if (og + 1u == (tg + 1u) * nx) xb_add(&bar[XB_TOPGEN], 1u);
            else XB_SPIN(xb_ld(&bar[XB_TOPGEN]) == tg, bar);
            __builtin_amdgcn_fence(__ATOMIC_ACQUIRE, "agent");
            xb_add(&bar[XB_XGEN(b.x)], 1u);
            asm volatile("s_waitcnt vmcnt(0)" ::: "memory");
        } else {
            XB_SPIN(xb_ld(&bar[XB_XGEN(b.x)]) == gen, bar);
            __builtin_amdgcn_fence(__ATOMIC_ACQUIRE, "agent");
            asm volatile("s_waitcnt vmcnt(0)" ::: "memory");
        }
    }
    __syncthreads();
}


struct Args { const float* in[15]; float* out; unsigned char* ws; };
__global__ void __launch_bounds__(512) mk_fwd(Args a) {
    extern __shared__ __attribute__((aligned(16))) unsigned char lds_raw[];
    cg::grid_group grid = cg::this_grid();
    LAS unsigned char* lds = (LAS unsigned char*)lds_raw;
    const int tid = threadIdx.x, G = gridDim.x, blk = blockIdx.x;
    Ptrs P; P.x = a.in[0]; P.norm_mix = a.in[1]; P.w_in = a.in[2]; P.w_alpha2 = a.in[3]; P.b_alpha = a.in[4]; P.gla_norm = a.in[5]; P.swa_qn = a.in[6]; P.swa_kn = a.in[7]; P.sinks = a.in[8];
    P.w_bg = a.in[9]; P.w_bs = a.in[10]; P.w_out = a.in[11]; P.norm_mlp = a.in[12]; P.w_up = a.in[13]; P.w_down = a.in[14]; P.out = a.out; P.ws = a.ws;
    unsigned char* ws = a.ws;
    bf16_t* OGLA = (bf16_t*)a.out; bf16_t* OSWA = (bf16_t*)a.out + (size_t)M_TOK * 1024;
    float* SSQ = (float*)(ws + WS_SSQ); float* ALR = (float*)(ws + WS_ALR);

    volatile LAS unsigned* xst = (volatile LAS unsigned*)(lds + LDS_BYTES - 16);
    if (tid < 4) xst[tid] = 0u;
    __syncthreads();
    const XcdBarrier xbar = xcd_barrier_post((unsigned*)(ws + WS_BAR), xst);
    const bool use_cg = G > 1024;
#define GRID_BAR() xcd_barrier(xbar)
    if (PH_MASK & 1) for (int rep = 0; rep < REP_P0; ++rep) p0_prologue(P, lds, tid, G, blk);
    if (use_cg) grid.sync(); else xcd_barrier(xbar);
    if (PH_MASK & 2) {
        pg8::Gemm g{(const bf16_t*)a.out, (const bf16_t*)(ws + WS_WIN), M_TOK, NPROJ, 1024}; pg8::StaticOrder S; S.init(M_TOK, NPROJ, G, blk);
        pg8::EpiProj E{ws};
        for (int rep = 0; rep < REP_P1; ++rep)
        pg8::gemm_phase<pg8::EpiProj, pg8::StaticOrder, true, true>(lds, g, S, E);
    }
    GRID_BAR();
    {
        const bf16_t* QKp = (const bf16_t*)(ws + WS_QK); const bf16_t* GVp = (const bf16_t*)(ws + WS_GV); const bf16_t* GGp = (const bf16_t*)(ws + WS_GG);
        float* Lws = (float*)(ws + WS_GLAL); float* Dws = (float*)(ws + WS_GLAD);
        constexpr int NA = 32 * (GLA_NSEG - 1);
        for (int rep = 0; rep < REP_P2A; ++rep) {
        for (int rpa = 0; rpa < REP_PA; ++rpa)
        if (PH_MASK & 64) for (int it = blk; it < NA; it += G) { const int seq = it / (GLA_NSEG - 1), seg = it % (GLA_NSEG - 1);
            gla_seg<false>(seq >> 2, seq & 3, seg, QKp, GVp, GGp, ALR, P.w_alpha2, P.b_alpha, P.gla_norm, OGLA, Lws, Dws, lds, tid); }
        for (int rsw = 0; rsw < REP_SWA; ++rsw)
        if (PH_MASK & 128) {
            int u0, u1, ustep;
            if (G == 256) { if (blk >= NA) { u0 = (blk - NA) * 12; u1 = u0 + 12; } else if (blk < 96) { u0 = 384 + blk * 8; u1 = u0 + 8; } else { u0 = 1152 + (blk - 96) * 7; u1 = u0 + 7; } ustep = 1; }
            else { u0 = blk; u1 = 2048; ustep = G; }
            int tl = tid; asm volatile("" : "+v"(tl));
            const bf16_t* SQp = (const bf16_t*)(ws + WS_SQ); const bf16_t* SKVp = (const bf16_t*)(ws + WS_SKV);
            SwaRegs R;
            if (u0 < u1) swa_load(R, u0 >> 8, u0 & 63, (u0 >> 6) & 3, SQp, SKVp, tl);
#pragma unroll 1
            for (int u = u0; u < u1; u += ustep) { const int n = u & 63, kh = (u >> 6) & 3, b = u >> 8;
                const float M2 = swa_stage(R, P.swa_qn, P.swa_kn, lds, tl);
                __syncthreads();
                const int un = u + ustep;
                if (un < u1) swa_load(R, un >> 8, un & 63, (un >> 6) & 3, SQp, SKVp, tl);
                swa_compute(M2, b, n, kh, OSWA, P.sinks, lds, tl);
                __syncthreads();
                swa_store(b, n, kh, OSWA, lds, tl); }
            if (G == 256 && blk >= 96 && blk < NA && rsw == 0) {
                __syncthreads();
                const int wv = tl >> 6; LAS float* scr = (LAS float*)(lds + wv * 12288);
                for (int q = wv; q < 44; q += 8) transpose_rest_item(P, (blk - 96) * 44 + q, scr, tl & 63);
            }
        }
        }
        GRID_BAR();
        for (int rep = 0; rep < REP_P2B; ++rep)
        if (PH_MASK & 64) for (int it = blk; it < 32 * GLA_NSEG; it += G) { const int seq = it / GLA_NSEG, seg = it % GLA_NSEG;
            gla_seg<true>(seq >> 2, seq & 3, seg, QKp, GVp, GGp, ALR, P.w_alpha2, P.b_alpha, P.gla_norm, OGLA, Lws, Dws, lds, tid); }
    }
    GRID_BAR();
    if (PH_MASK & 8) {
        pg8::StaticOrder S; S.init(M_TOK, 1024, G, blk);
        { pg8::Gemm g{OGLA, (const bf16_t*)(ws + WS_WBG), M_TOK, 1024, 1024}; pg8::EpiGate<true> E{(const bf16_t*)(ws + WS_GA), (bf16_t*)(ws + WS_MERGED)};
          pg8::gemm_phase<pg8::EpiGate<true>, pg8::StaticOrder, true, true>(lds, g, S, E); }
        { pg8::Gemm g{OSWA, (const bf16_t*)(ws + WS_WBS), M_TOK, 1024, 1024}; pg8::EpiGate<false> E{(const bf16_t*)(ws + WS_GB), (bf16_t*)(ws + WS_MERGED)};
          pg8::gemm_phase<pg8::EpiGate<false>, pg8::StaticOrder, true, true>(lds, g, S, E); }
    }
    GRID_BAR();
    if (PH_MASK & 16) {
        pg8::Gemm g{(const bf16_t*)(ws + WS_MERGED), (const bf16_t*)(ws + WS_WOUT), M_TOK, 1024, 1024}; pg8::StaticOrder S; S.init(M_TOK, 1024, G, blk);
        pg8::EpiRes E{P.x, a.out, (bf16_t*)(ws + WS_H1B), SSQ};
        pg8::gemm_phase<pg8::EpiRes, pg8::StaticOrder, true, true>(lds, g, S, E);
    }
    GRID_BAR();
    if (PH_MASK & 32) {
        pg8::Gemm g{(const bf16_t*)(ws + WS_H1B), (const bf16_t*)(ws + WS_WUP), M_TOK, DFF, 1024}; pg8::StaticOrder S; S.init(M_TOK, DFF, G, blk);
        pg8::EpiUp E{SSQ, (bf16_t*)(ws + WS_U)};
        pg8::gemm_phase<pg8::EpiUp, pg8::StaticOrder, true, true>(lds, g, S, E);
    }
    GRID_BAR();
    if (PH_MASK & 256) {
        pg8::Gemm g{(const bf16_t*)(ws + WS_U), (const bf16_t*)(ws + WS_WDN), M_TOK, 1024, DFF}; pg8::StaticOrder S; S.init(M_TOK, 1024, G, blk);
        pg8::EpiDown E{a.out};
        pg8::gemm_phase<pg8::EpiDown, pg8::StaticOrder, true, true>(lds, g, S, E);
    }
}

extern "C" void kernel_launch(void* const* d_in, const int* in_sizes, int n_in, void* d_out, int out_size, void* d_ws, size_t ws_size, hipStream_t stream) {
    static int grid = 0;
    if (grid == 0) {
        if (n_in != 15 || out_size != M_TOK * DM || ws_size < WS_END) { fprintf(stderr, "kernel_launch: unexpected shapes (n_in %d out %d ws %zu)\n", n_in, out_size, ws_size); grid = -1; return; }
        int dev = 0, cus = 0, per_cu = 0;
        hipGetDevice(&dev); hipDeviceGetAttribute(&cus, hipDeviceAttributeMultiprocessorCount, dev);
        if (hipFuncSetAttribute((const void*)mk_fwd, hipFuncAttributeMaxDynamicSharedMemorySize, LDS_BYTES) != hipSuccess) { fprintf(stderr, "kernel_launch: hipFuncSetAttribute failed\n"); grid = -1; return; }
        if (hipOccupancyMaxActiveBlocksPerMultiprocessor(&per_cu, (const void*)mk_fwd, 512, LDS_BYTES) != hipSuccess || per_cu < 1) { fprintf(stderr, "kernel_launch: occupancy query says %d\n", per_cu); per_cu = 1; }
        (void)hipGetLastError();
        grid = cus > 1024 ? 1024 : cus;
        if (grid < 64) { fprintf(stderr, "kernel_launch: only %d CUs\n", cus); grid = -1; return; }
    }
    if (grid < 0) return;
    if (hipMemsetAsync((char*)d_ws + WS_BAR, 0, BAR_BYTES, stream) != hipSuccess) { fprintf(stderr, "kernel_launch: hipMemsetAsync failed\n"); return; }
    Args a{};
    for (int i = 0; i < 15; ++i) a.in[i] = (const float*)d_in[i];
    a.out = (float*)d_out; a.ws = (unsigned char*)d_ws;
    void* args[] = {&a};
    hipError_t e = hipLaunchCooperativeKernel((const void*)mk_fwd, dim3(grid), dim3(512), args, LDS_BYTES, stream);
    if (e != hipSuccess) fprintf(stderr, "kernel_launch: cooperative launch failed: %s (grid %d)\n", hipGetErrorString(e), grid);
}
```

```cpp
#include <hip/hip_runtime.h>
#include <hip/hip_cooperative_groups.h>
#include <cstdio>
#include <cstdint>
namespace cg = cooperative_groups;

constexpr int M_TOK = 32768, DM = 1024, SEQ_T = 4096, NPROJ = 6656, DFF = 4096;
constexpr size_t MiB = 1u << 20;
constexpr size_t WS_SSQ = 0;
constexpr size_t WS_BAR = 1 * MiB, BAR_BYTES = 16384;
constexpr size_t WS_WIN = 2 * MiB, WS_WBG = 16 * MiB, WS_WBS = 18 * MiB, WS_WOUT = 20 * MiB, WS_WUP = 22 * MiB, WS_WDN = 30 * MiB;
constexpr size_t WS_ALR = 38 * MiB;
constexpr size_t WS_QK = 40 * MiB, WS_GV = 104 * MiB, WS_GG = 168 * MiB, WS_SQ = 232 * MiB;
constexpr size_t WS_SKV = 296 * MiB;
constexpr size_t WS_GA = 328 * MiB, WS_GB = 392 * MiB;
constexpr size_t WS_MERGED = 40 * MiB;
constexpr size_t WS_H1B = 104 * MiB;
constexpr size_t WS_U = 168 * MiB;
constexpr size_t WS_GLAL = 456 * MiB, WS_GLAD = 488 * MiB;
constexpr size_t WS_END = 489 * MiB;
constexpr int LDS_BYTES = 147456;
#ifndef REP_P0
#define REP_P0 1
#endif
#ifndef REP_P1
#define REP_P1 1
#endif
#ifndef REP_PA
#define REP_PA 1
#endif
#ifndef REP_SWA
#define REP_SWA 1
#endif
#ifndef REP_P2A
#define REP_P2A 1
#endif
#ifndef REP_P2B
#define REP_P2B 1
#endif
#ifndef PH_MASK
#define PH_MASK 0x1ff
#endif
#define LAS __attribute__((address_space(3)))
namespace pg8 {
#define PG8_LAS __attribute__((address_space(3)))
typedef unsigned short bf16_t;
typedef short bf16x8 __attribute__((ext_vector_type(8)));
typedef float f32x4 __attribute__((ext_vector_type(4)));
typedef unsigned u32x4 __attribute__((ext_vector_type(4)));
constexpr int BM = 256, BK = 64, HALF = 128, HTB = HALF * BK * 2  , STAGE_BYTES = 8 * HTB, NXCD = 8, WGM = 8;

__host__ __device__ __forceinline__ int lds_byte(int r, int c) { const int st = (r >> 4) * 2 + (c >> 5), rr = r & 15, cc = c & 31, ob = rr * 64 + cc * 2; return st * 1024 + (ob ^ (((ob >> 9) & 1) << 5)); }
__host__ __device__ __forceinline__ void stage_rc(int b, int& R, int& C) { const int st = b / 1024, sb = b % 1024, swz = sb ^ (((sb >> 9) & 1) << 5); R = (st >> 1) * 16 + swz / 64; C = (st & 1) * 32 + (swz % 64) / 2; }
__host__ __device__ __forceinline__ int perm32(int rho) { const int n = rho >> 4, i = rho & 15; return 8 * (i >> 2) + 4 * n + (i & 3); }

struct Unit { int pm, pn; };
struct Gemm { const bf16_t* A; const bf16_t* Bt; int M, N, K; };

struct StaticOrder {
    int nM, nN, nwg, G, c;
    __host__ __device__ void init(int M, int N, int G_, int c_) { nM = M / BM; nN = N / BM; nwg = nM * nN; G = G_; c = c_; }
    __host__ __device__ bool next(int i, Unit& u) const {
        const long L = (long)i * G + c; if (L >= nwg) return false;
        int wgid = (int)L; { const int q = nwg / NXCD, r = nwg % NXCD, xcd = wgid % NXCD, off = wgid / NXCD; wgid = (xcd < r ? xcd * (q + 1) : r * (q + 1) + (xcd - r) * q) + off; }
        const int nig = WGM * nN, gid = wgid / nig, fm = gid * WGM, gsz = (nM - fm) < WGM ? (nM - fm) : WGM;
        u.pm = fm + ((wgid % nig) % gsz); u.pn = (wgid % nig) / gsz; return true;
    }
    __device__ __forceinline__ void a_ready(const Unit&) const {}
    __device__ __forceinline__ void done(const Unit&) const {}
};
__device__ __forceinline__ unsigned cvt_pk_bf16(float lo, float hi) { unsigned r; asm volatile("v_cvt_pk_bf16_f32 %0, %1, %2" : "=v"(r) : "v"(lo), "v"(hi)); return r; }
typedef float f32x2c __attribute__((ext_vector_type(2))); typedef __bf16 bf16x2c __attribute__((ext_vector_type(2)));
__device__ __forceinline__ unsigned cvt_pk_bf16_v(float lo, float hi) { const f32x2c v = {lo, hi}; const bf16x2c b = __builtin_convertvector(v, bf16x2c); return __builtin_bit_cast(unsigned, b); }
__device__ __forceinline__ float bflo(unsigned w) { return __uint_as_float(w << 16); }
__device__ __forceinline__ float bfhi(unsigned w) { return __uint_as_float(w & 0xffff0000u); }
__device__ __forceinline__ void unpack8(const u32x4 w, float (&f)[8]) { f[0] = bflo(w.x); f[1] = bfhi(w.x); f[2] = bflo(w.y); f[3] = bfhi(w.y); f[4] = bflo(w.z); f[5] = bfhi(w.z); f[6] = bflo(w.w); f[7] = bfhi(w.w); }
__device__ __forceinline__ u32x4 pack8(const float (&f)[8]) { u32x4 w; w.x = cvt_pk_bf16(f[0], f[1]); w.y = cvt_pk_bf16(f[2], f[3]); w.z = cvt_pk_bf16(f[4], f[5]); w.w = cvt_pk_bf16(f[6], f[7]); return w; }
__device__ __forceinline__ float sigm(float x) { return __builtin_amdgcn_rcpf(1.f + __builtin_amdgcn_exp2f(-1.4426950408889634f * x)); }

struct EpiProj {
    static constexpr bool PERM = true, AFTER_DRAIN = false;
    unsigned char* ws;
    __device__ __forceinline__ void operator()(const f32x4 (&acc)[2][2][4][2], const Unit& u, int wr, int wc, int fr, int fq) const {
        const int pn = u.pn; const int row0 = u.pm * BM + wr * 64 + fr;
        size_t off; int ldc = 1024, colt, act = 0;
        if (pn < 16) { off = WS_QK + (size_t)(pn >> 2) * (64 * MiB); colt = (pn & 3) * 256; if ((pn >> 2) == 2) act = 2; }
        else if (pn < 18) { off = WS_SKV; ldc = 512; colt = (pn - 16) * 256; }
        else if (pn < 22) { off = WS_GA; colt = (pn - 18) * 256; act = 1; }
        else { off = WS_GB; colt = (pn - 22) * 256; act = 1; }
        bf16_t* base = (bf16_t*)(ws + off);
        const int col0 = colt + wc * 32 + 8 * fq;
#pragma unroll
        for (int ai = 0; ai < 2; ++ai)
#pragma unroll
            for (int m = 0; m < 4; ++m) { bf16_t* rowp = base + (size_t)(row0 + ai * HALF + m * 16) * ldc + col0;
#pragma unroll
                for (int bj = 0; bj < 2; ++bj) { const f32x4 v0 = acc[ai][bj][m][0], v1 = acc[ai][bj][m][1];
                    float f[8] = {v0[0], v0[1], v0[2], v0[3], v1[0], v1[1], v1[2], v1[3]};
                    if (act == 1) {
#pragma unroll
                        for (int e = 0; e < 8; ++e) f[e] = sigm(f[e]);
                    } else if (act == 2) {
#pragma unroll
                        for (int e = 0; e < 8; ++e) f[e] = f[e] * sigm(f[e]);
                    }
                    *(u32x4*)(rowp + bj * HALF) = pack8(f); } }
    }
};
template <bool FIRST> struct EpiGate {
    static constexpr bool PERM = true, AFTER_DRAIN = false;
    const bf16_t* gate; bf16_t* merged;
    __device__ __forceinline__ void operator()(const f32x4 (&acc)[2][2][4][2], const Unit& u, int wr, int wc, int fr, int fq) const {
        const int row0 = u.pm * BM + wr * 64 + fr, col0 = u.pn * BM + wc * 32 + 8 * fq;
#pragma unroll
        for (int ai = 0; ai < 2; ++ai)
#pragma unroll
            for (int m = 0; m < 4; ++m) { const size_t idx = (size_t)(row0 + ai * HALF + m * 16) * 1024 + col0;
#pragma unroll
                for (int bj = 0; bj < 2; ++bj) { const f32x4 v0 = acc[ai][bj][m][0], v1 = acc[ai][bj][m][1];
                    float f[8] = {v0[0], v0[1], v0[2], v0[3], v1[0], v1[1], v1[2], v1[3]}; float g[8];
                    unpack8(*(const u32x4*)(gate + idx + bj * HALF), g);
#pragma unroll
                    for (int e = 0; e < 8; ++e) f[e] *= g[e];
                    if (!FIRST) { float p[8]; unpack8(*(const u32x4*)(merged + idx + bj * HALF), p);
#pragma unroll
                        for (int e = 0; e < 8; ++e) f[e] += p[e]; }
                    *(u32x4*)(merged + idx + bj * HALF) = pack8(f); } }
    }
};
struct EpiRes {
    static constexpr bool PERM = true, AFTER_DRAIN = false;
    const float* x; bf16_t* h1b; float* ssq;
    __device__ __forceinline__ void operator()(const f32x4 (&acc)[2][2][4][2], const Unit& u, int wr, int wc, int fr, int fq) const {
        const int row0 = u.pm * BM + wr * 64 + fr, col0 = u.pn * BM + wc * 32 + 8 * fq;
#pragma unroll
        for (int ai = 0; ai < 2; ++ai)
#pragma unroll
            for (int m = 0; m < 4; ++m) { const int row = row0 + ai * HALF + m * 16; const size_t idx = (size_t)row * 1024 + col0; float ss = 0.f;
#pragma unroll
                for (int bj = 0; bj < 2; ++bj) { const f32x4 x0 = *(const f32x4*)(x + idx + bj * HALF), x1 = *(const f32x4*)(x + idx + bj * HALF + 4);
                    const f32x4 h0 = x0 + acc[ai][bj][m][0], h1v = x1 + acc[ai][bj][m][1];
                    float f[8] = {h0[0], h0[1], h0[2], h0[3], h1v[0], h1v[1], h1v[2], h1v[3]};
#pragma unroll
                    for (int e = 0; e < 8; ++e) ss += f[e] * f[e];
                    *(u32x4*)(h1b + idx + bj * HALF) = pack8(f); }
                ss += __shfl_xor(ss, 16); ss += __shfl_xor(ss, 32);
                if (fq == 0) atomicAdd(ssq + row, ss); }
    }
};
struct EpiUp {
    static constexpr bool PERM = true, AFTER_DRAIN = false;
    const float* ssq; bf16_t* U;
    __device__ __forceinline__ void operator()(const f32x4 (&acc)[2][2][4][2], const Unit& u, int wr, int wc, int fr, int fq) const {
        const int row0 = u.pm * BM + wr * 64 + fr, col0 = u.pn * BM + wc * 32 + 8 * fq;
#pragma unroll
        for (int ai = 0; ai < 2; ++ai)
#pragma unroll
            for (int m = 0; m < 4; ++m) { const int row = row0 + ai * HALF + m * 16; const float rs = __builtin_amdgcn_rsqf(ssq[row] * (1.0f / 1024.0f) + 1e-6f); bf16_t* rowp = U + (size_t)row * 4096 + col0;
#pragma unroll
                for (int bj = 0; bj < 2; ++bj) { const f32x4 v0 = acc[ai][bj][m][0], v1 = acc[ai][bj][m][1];
                    float f[8] = {v0[0], v0[1], v0[2], v0[3], v1[0], v1[1], v1[2], v1[3]};
#pragma unroll
                    for (int e = 0; e < 8; ++e) { const float r = fmaxf(f[e] * rs, 0.f); f[e] = r * r; }
                    *(u32x4*)(rowp + bj * HALF) = pack8(f); } }
    }
};
struct EpiDown {
    static constexpr bool PERM = true, AFTER_DRAIN = false;
    const bf16_t* h1b; float* out;
    __device__ __forceinline__ void operator()(const f32x4 (&acc)[2][2][4][2], const Unit& u, int wr, int wc, int fr, int fq) const {
        const int row0 = u.pm * BM + wr * 64 + fr, col0 = u.pn * BM + wc * 32 + 8 * fq;
#pragma unroll
        for (int ai = 0; ai < 2; ++ai)
#pragma unroll
            for (int m = 0; m < 4; ++m) { const size_t idx = (size_t)(row0 + ai * HALF + m * 16) * 1024 + col0;
#pragma unroll
                for (int bj = 0; bj < 2; ++bj) { float h[8]; unpack8(*(const u32x4*)(h1b + idx + bj * HALF), h);
                    const f32x4 a0 = acc[ai][bj][m][0], a1 = acc[ai][bj][m][1];
                    *(f32x4*)(out + idx + bj * HALF) = (f32x4){h[0] + a0[0], h[1] + a0[1], h[2] + a0[2], h[3] + a0[3]};
                    *(f32x4*)(out + idx + bj * HALF + 4) = (f32x4){h[4] + a1[0], h[5] + a1[1], h[6] + a1[2], h[7] + a1[3]}; } }
    }
};
template <class Epi, class Sched, bool ALIGN_EPI = false, bool SP2 = false>
__device__ __forceinline__ void gemm_phase(PG8_LAS unsigned char* lds, const Gemm g, const Sched& S, const Epi& E) {
    int tid_ = threadIdx.x; asm volatile("" : "+v"(tid_));
    const int tid = tid_, wid = __builtin_amdgcn_readfirstlane(tid >> 6), lane = tid & 63, wr = wid >> 2, wc = wid & 3, fr = lane & 15, fq = lane >> 4;
    const int K = g.K, nt = K / BK;
    unsigned voffA[2], voffB[2];
#pragma unroll
    for (int i = 0; i < 2; ++i) { int R, C; stage_rc(tid * 16 + i * 8192, R, C); const int Rb = Epi::PERM ? ((R & ~31) + perm32(R & 31)) : R;
        voffA[i] = (unsigned)(R * K + C) * 2u; voffB[i] = (unsigned)(Rb * K + C) * 2u; }
    const size_t kstep = (size_t)(BK * 2);
    const size_t hstep = (size_t)HALF * K * 2;
    const size_t tstep = 2 * hstep;
    const unsigned ldsw = (unsigned)wid * 1024u;
    const int aoff = lds_byte(wr * 64 + fr, fq * 8), boff = lds_byte(wc * 32 + fr, fq * 8);
#define PG8_SA(b, h) (((b) * 2 + (h)) * HTB)
#define PG8_SB(b, h) ((4 + (b) * 2 + (h)) * HTB)
#define PG8_STAGE(bufoff, gbase, voff) do { _Pragma("unroll") for (int _i = 0; _i < 2; ++_i) \
        __builtin_amdgcn_global_load_lds((const unsigned*)((const char*)(gbase) + (voff)[_i]), (PG8_LAS unsigned*)(lds + (bufoff) + ldsw + _i * 8192), 16, 0, 0); } while (0)
#define PG8_LDA(dst, b, h) do { _Pragma("unroll") for (int m = 0; m < 4; ++m) _Pragma("unroll") for (int k = 0; k < 2; ++k) dst[m][k] = *(const PG8_LAS bf16x8*)(lds + PG8_SA(b, h) + aoff + m * 2048 + k * 1024); } while (0)
#define PG8_LDB(dst, b, h) do { _Pragma("unroll") for (int n = 0; n < 2; ++n) _Pragma("unroll") for (int k = 0; k < 2; ++k) dst[n][k] = *(const PG8_LAS bf16x8*)(lds + PG8_SB(b, h) + boff + n * 2048 + k * 1024); } while (0)
#define PG8_MMA(ai, bj, At, Bt) do { __builtin_amdgcn_s_setprio(1); _Pragma("unroll") for (int m = 0; m < 4; ++m) _Pragma("unroll") for (int n = 0; n < 2; ++n) _Pragma("unroll") for (int k = 0; k < 2; ++k) \
        acc[ai][bj][m][n] = __builtin_amdgcn_mfma_f32_16x16x32_bf16(Bt[n][k], At[m][k], acc[ai][bj][m][n], 0, 0, 0); __builtin_amdgcn_s_setprio(0); } while (0)
#define PG8_WAIT_V(n) asm volatile("s_waitcnt vmcnt(" #n ")" ::: "memory")
#define PG8_WAIT_L(n) asm volatile("s_waitcnt lgkmcnt(" #n ")" ::: "memory")
#define PG8_BAR __builtin_amdgcn_s_barrier()
#define PG8_SCHED __builtin_amdgcn_sched_barrier(0)
    Unit cur, nxt; int ui = 0;
    if (!S.next(0, cur)) return;
    f32x4 acc[2][2][4][2];
#pragma unroll
    for (int a = 0; a < 2; ++a)
#pragma unroll
        for (int b = 0; b < 2; ++b)
#pragma unroll
            for (int m = 0; m < 4; ++m)
#pragma unroll
                for (int n = 0; n < 2; ++n) acc[a][b][m][n] = (f32x4){0.f, 0.f, 0.f, 0.f};
    bf16x8 At[4][2], B0[2][2], B1[2][2];
    const char* cA = (const char*)g.A + (size_t)cur.pm * tstep; const char* cB = (const char*)g.Bt + (size_t)cur.pn * tstep;
    S.a_ready(cur);
    if constexpr (SP2) {
        PG8_STAGE(PG8_SB(0, 0), cB, voffB); PG8_STAGE(PG8_SB(0, 1), cB + hstep, voffB); PG8_STAGE(PG8_SA(0, 0), cA, voffA); PG8_STAGE(PG8_SA(0, 1), cA + hstep, voffA);
        if (wr == 1) PG8_BAR;
        PG8_WAIT_V(2); PG8_BAR;
        PG8_STAGE(PG8_SB(1, 0), cB + kstep, voffB); PG8_STAGE(PG8_SA(1, 0), cA + kstep, voffA); PG8_STAGE(PG8_SB(1, 1), cB + hstep + kstep, voffB);
        PG8_WAIT_V(6); PG8_BAR;
    } else {
        PG8_STAGE(PG8_SB(0, 0), cB, voffB); PG8_STAGE(PG8_SA(0, 0), cA, voffA); PG8_STAGE(PG8_SB(0, 1), cB + hstep, voffB); PG8_STAGE(PG8_SA(0, 1), cA + hstep, voffA);
        if (wr == 1) PG8_BAR;
        PG8_WAIT_V(4); PG8_BAR;
        PG8_STAGE(PG8_SB(1, 0), cB + kstep, voffB); PG8_STAGE(PG8_SA(1, 0), cA + kstep, voffA); PG8_STAGE(PG8_SB(1, 1), cB + hstep + kstep, voffB);
        PG8_WAIT_V(6); PG8_BAR;
    }
    for (;;) {
        const bool has_next = S.next(ui + 1, nxt);
        const char* nA = has_next ? (const char*)g.A + (size_t)nxt.pm * tstep : cA; const char* nB = has_next ? (const char*)g.Bt + (size_t)nxt.pn * tstep : cB;
        for (int t = 0; t < nt; t += 2) {
            const bool last = (t == nt - 2);
            const char* a1 = cA + (size_t)(t + 1) * kstep;
            const char* a2 = last ? nA : cA + (size_t)(t + 2) * kstep; const char* b2 = last ? nB : cB + (size_t)(t + 2) * kstep;
            const char* a3 = a2 + kstep; const char* b3 = b2 + kstep;
            if (last && has_next) S.a_ready(nxt);
            if constexpr (SP2) {
            PG8_LDB(B0, 0, 0); PG8_LDB(B1, 0, 1); PG8_SCHED; PG8_LDA(At, 0, 0); PG8_STAGE(PG8_SA(1, 1), a1 + hstep, voffA);
            PG8_WAIT_V(8); PG8_WAIT_L(0); PG8_BAR; PG8_MMA(0, 0, At, B0); PG8_MMA(0, 1, At, B1); PG8_BAR; PG8_SCHED;
            PG8_LDA(At, 0, 1); PG8_STAGE(PG8_SB(0, 0), b2, voffB); PG8_STAGE(PG8_SB(0, 1), b2 + hstep, voffB); PG8_STAGE(PG8_SA(0, 0), a2, voffA);
            PG8_WAIT_V(8); PG8_WAIT_L(0); PG8_BAR; PG8_MMA(1, 0, At, B0); PG8_MMA(1, 1, At, B1); PG8_BAR; PG8_SCHED;
            PG8_LDB(B0, 1, 0); PG8_LDB(B1, 1, 1); PG8_SCHED; PG8_LDA(At, 1, 0); PG8_STAGE(PG8_SA(0, 1), a2 + hstep, voffA);
            PG8_WAIT_V(8); PG8_WAIT_L(0); PG8_BAR; PG8_MMA(0, 0, At, B0); PG8_MMA(0, 1, At, B1); PG8_BAR; PG8_SCHED;
            PG8_LDA(At, 1, 1); PG8_STAGE(PG8_SB(1, 0), b3, voffB); PG8_STAGE(PG8_SB(1, 1), b3 + hstep, voffB); PG8_STAGE(PG8_SA(1, 0), a3, voffA);
            PG8_WAIT_V(8); PG8_WAIT_L(0); PG8_BAR; PG8_MMA(1, 0, At, B0); PG8_MMA(1, 1, At, B1); PG8_BAR; PG8_SCHED;
            } else {
            PG8_LDB(B0, 0, 0); PG8_SCHED; PG8_LDA(At, 0, 0); PG8_STAGE(PG8_SA(1, 1), a1 + hstep, voffA);
            PG8_WAIT_L(8); PG8_BAR; PG8_WAIT_L(0); PG8_MMA(0, 0, At, B0); PG8_BAR; PG8_SCHED;
            PG8_LDB(B1, 0, 1); PG8_STAGE(PG8_SB(0, 0), b2, voffB);
            PG8_BAR; PG8_WAIT_L(0); PG8_MMA(0, 1, At, B1); PG8_BAR;
            PG8_LDA(At, 0, 1); PG8_STAGE(PG8_SA(0, 0), a2, voffA);
            PG8_BAR; PG8_WAIT_L(0); PG8_MMA(1, 0, At, B0); PG8_BAR; PG8_SCHED;
            PG8_STAGE(PG8_SB(0, 1), b2 + hstep, voffB);
            PG8_WAIT_V(6); PG8_BAR; PG8_MMA(1, 1, At, B1); PG8_BAR;
            PG8_LDB(B0, 1, 0); PG8_SCHED; PG8_LDA(At, 1, 0); PG8_STAGE(PG8_SA(0, 1), a2 + hstep, voffA);
            PG8_WAIT_L(8); PG8_BAR; PG8_WAIT_L(0); PG8_MMA(0, 0, At, B0); PG8_BAR; PG8_SCHED;
            PG8_LDB(B1, 1, 1); PG8_STAGE(PG8_SB(1, 0), b3, voffB);
            PG8_BAR; PG8_WAIT_L(0); PG8_MMA(0, 1, At, B1); PG8_BAR;
            PG8_LDA(At, 1, 1); PG8_STAGE(PG8_SA(1, 0), a3, voffA);
            PG8_BAR; PG8_WAIT_L(0); PG8_MMA(1, 0, At, B0); PG8_BAR; PG8_SCHED;
            PG8_STAGE(PG8_SB(1, 1), b3 + hstep, voffB);
            PG8_WAIT_V(6); PG8_BAR; PG8_MMA(1, 1, At, B1); PG8_BAR;
            }
        }
        if constexpr (ALIGN_EPI) { if (wr == 0) PG8_BAR; }
        if constexpr (!Epi::AFTER_DRAIN) { E(acc, cur, wr, wc, fr, fq); S.done(cur); }
        if (!has_next) break;
#pragma unroll
        for (int a = 0; a < 2; ++a)
#pragma unroll
            for (int b = 0; b < 2; ++b)
#pragma unroll
                for (int m = 0; m < 4; ++m)
#pragma unroll
                    for (int n = 0; n < 2; ++n) acc[a][b][m][n] = (f32x4){0.f, 0.f, 0.f, 0.f};
        cur = nxt; cA = nA; cB = nB; ++ui;
        if constexpr (ALIGN_EPI) { if (wr == 1) PG8_BAR; }
    }
    PG8_WAIT_V(0);
    if constexpr (!ALIGN_EPI) { if (wr == 0) PG8_BAR; }
    PG8_BAR;
    if constexpr (Epi::AFTER_DRAIN) { E.fused(acc, cur, wr, wc, fr, fq, lds, wid, lane); S.done(cur); }
#undef PG8_SA
#undef PG8_SB
#undef PG8_STAGE
#undef PG8_LDA
#undef PG8_LDB
#undef PG8_MMA
#undef PG8_WAIT_V
#undef PG8_WAIT_L
#undef PG8_BAR
#undef PG8_SCHED
}
}

using pg8::bf16_t; using pg8::bf16x8; using pg8::f32x4; using pg8::u32x4; using pg8::unpack8; using pg8::pack8;
typedef unsigned u32x2 __attribute__((ext_vector_type(2)));
#define MFMA16(a, b, c) __builtin_amdgcn_mfma_f32_16x16x32_bf16((a), (b), (c), 0, 0, 0)
__device__ __forceinline__ unsigned pk2(float lo, float hi) { return pg8::cvt_pk_bf16(lo, hi); }
__device__ __forceinline__ unsigned pk2v(float lo, float hi) { return pg8::cvt_pk_bf16_v(lo, hi); }
__device__ __forceinline__ u32x4 pack8v(const float (&f)[8]) { u32x4 w; w.x = pk2v(f[0], f[1]); w.y = pk2v(f[2], f[3]); w.z = pk2v(f[4], f[5]); w.w = pk2v(f[6], f[7]); return w; }
__device__ __forceinline__ float wave_sum(float v) {
#pragma unroll
    for (int o = 1; o < 64; o <<= 1) v += __shfl_xor(v, o);
    return v;
}
#define LDS_WAIT() asm volatile("s_waitcnt lgkmcnt(0)" ::: "memory")
template <int CTRL> __device__ __forceinline__ float dpp_mov(float v) { return __builtin_bit_cast(float, __builtin_amdgcn_update_dpp(0, __builtin_bit_cast(int, v), CTRL, 0xf, 0xf, true)); }
__device__ __forceinline__ float sum8_dpp(float v) { v += dpp_mov<0xB1>(v); v += dpp_mov<0x4E>(v); v += dpp_mov<0x141>(v); return v; }
__device__ __forceinline__ float max8_dpp(float v) { v = fmaxf(v, dpp_mov<0xB1>(v)); v = fmaxf(v, dpp_mov<0x4E>(v)); v = fmaxf(v, dpp_mov<0x141>(v)); return v; }
__device__ __forceinline__ float sum16_dpp(float v) { v = sum8_dpp(v); v += dpp_mov<0x140>(v); return v; }

__device__ __forceinline__ void transpose_item(const float* __restrict__ W, int ldw, int K, bf16_t* WT, int dst_row0, int src_col0, int nvalid, const float* __restrict__ kscale, int k0, LAS float* scr, int lane) {
    const int c4 = lane & 7, kr = lane >> 3;
    f32x4 v[8];
#pragma unroll
    for (int i = 0; i < 8; ++i) { v[i] = (f32x4){0.f, 0.f, 0.f, 0.f};
        if (4 * c4 < nvalid) v[i] = *(const f32x4*)(W + (size_t)(k0 + kr + 8 * i) * ldw + src_col0 + 4 * c4); }
    if (kscale) {
#pragma unroll
        for (int i = 0; i < 8; ++i) v[i] = v[i] * kscale[k0 + kr + 8 * i];
    }
#pragma unroll
    for (int i = 0; i < 8; ++i) { LAS float* d = scr + (kr + 8 * i) * 33 + 4 * c4; d[0] = v[i].x; d[1] = v[i].y; d[2] = v[i].z; d[3] = v[i].w; }
    LDS_WAIT(); asm volatile("" ::: "memory");
    const int ch = lane & 7;
#pragma unroll
    for (int j = 0; j < 4; ++j) { const int n = (lane >> 3) + 8 * j; const LAS float* s = scr + (8 * ch) * 33 + n;
        u32x4 o; o.x = pk2(s[0 * 33], s[1 * 33]); o.y = pk2(s[2 * 33], s[3 * 33]); o.z = pk2(s[4 * 33], s[5 * 33]); o.w = pk2(s[6 * 33], s[7 * 33]);
        *(u32x4*)(WT + (size_t)(dst_row0 + n) * K + k0 + 8 * ch) = o; }
    LDS_WAIT(); asm volatile("" ::: "memory");
}
struct Ptrs {
    const float *x, *norm_mix, *w_in, *w_alpha2, *b_alpha, *gla_norm, *swa_qn, *swa_kn, *sinks, *w_bg, *w_bs, *w_out, *norm_mlp, *w_up, *w_down;
    float* out; unsigned char* ws;
};
constexpr int P0_I_SQ = 16 * 32, P0_I_UP = 16 * 128, P0_I_DN = 64 * 32, P0_REST_ITEMS = 3 * P0_I_SQ + P0_I_UP + P0_I_DN;
__device__ __forceinline__ void transpose_rest_item(const Ptrs& P, int r, LAS float* scr, int lane) {
    if (r < P0_I_SQ) { transpose_item(P.w_bg, 1024, 1024, (bf16_t*)(P.ws + WS_WBG), 32 * (r % 32), 32 * (r % 32), 32, nullptr, 64 * (r / 32), scr, lane); return; } r -= P0_I_SQ;
    if (r < P0_I_SQ) { transpose_item(P.w_bs, 1024, 1024, (bf16_t*)(P.ws + WS_WBS), 32 * (r % 32), 32 * (r % 32), 32, nullptr, 64 * (r / 32), scr, lane); return; } r -= P0_I_SQ;
    if (r < P0_I_SQ) { transpose_item(P.w_out, 1024, 1024, (bf16_t*)(P.ws + WS_WOUT), 32 * (r % 32), 32 * (r % 32), 32, nullptr, 64 * (r / 32), scr, lane); return; } r -= P0_I_SQ;
    if (r < P0_I_UP) { transpose_item(P.w_up, 4096, 1024, (bf16_t*)(P.ws + WS_WUP), 32 * (r % 128), 32 * (r % 128), 32, P.norm_mlp, 64 * (r / 128), scr, lane); return; } r -= P0_I_UP;
    transpose_item(P.w_down, 1024, 4096, (bf16_t*)(P.ws + WS_WDN), 32 * (r % 32), 32 * (r % 32), 32, nullptr, 64 * (r / 32), scr, lane);
}
__device__ __forceinline__ void p0_prologue(const Ptrs& P, LAS unsigned char* lds, int tid, int G, int blk) {
    const int lane = tid & 63, wave = tid >> 6;
    LAS float* scr = (LAS float*)(lds + wave * 12288);
    const int gw = blk * 8 + wave, NGW = G * 8;
    LAS bf16_t* WA = (LAS bf16_t*)(lds + 98304);
    for (int idx = tid; idx < 4096; idx += 512) { const int k = idx >> 2, c = (idx & 3) * 4; const f32x4 w = *(const f32x4*)(P.w_in + (size_t)k * 6672 + 3072 + c); const unsigned p0 = pk2(w.x, w.y), p1 = pk2(w.z, w.w);
        WA[(c + 0) * 1032 + k] = (bf16_t)(p0 & 0xffffu); WA[(c + 1) * 1032 + k] = (bf16_t)(p0 >> 16); WA[(c + 2) * 1032 + k] = (bf16_t)(p1 & 0xffffu); WA[(c + 3) * 1032 + k] = (bf16_t)(p1 >> 16); }
    __syncthreads();
    constexpr int I_IN = 16 * (NPROJ / 32);
    const int nitems = (G == 256) ? I_IN : I_IN + P0_REST_ITEMS;
    for (int it = gw; it < nitems; it += NGW) {
        if (it < I_IN) { const int nblk = NPROJ / 32, kb = it / nblk, nb = it % nblk, d = 32 * nb; int src, nv;
            if (d < 3072) { src = d; nv = 32; } else { src = d + 16; nv = 32; }
            transpose_item(P.w_in, 6672, 1024, (bf16_t*)(P.ws + WS_WIN), d, src, nv, nullptr, 64 * kb, scr, lane); continue; }
        transpose_rest_item(P, it - I_IN, scr, lane);
    }
    bf16_t* hn = (bf16_t*)P.out; float* alr = (float*)(P.ws + WS_ALR);
    LAS bf16_t* SR = (LAS bf16_t*)scr;
    const int fr = lane & 15, fq = lane >> 4;
    f32x4 gm[4];
#pragma unroll
    for (int j = 0; j < 4; ++j) gm[j] = *(const f32x4*)(P.norm_mix + 4 * lane + 256 * j);
    for (int m0 = gw * 4; m0 < M_TOK; m0 += NGW * 4) {
        f32x4 v[4][4];
#pragma unroll
        for (int r = 0; r < 4; ++r) { const f32x4* xr = (const f32x4*)(P.x + (size_t)(m0 + r) * DM) + lane;
#pragma unroll
            for (int j = 0; j < 4; ++j) v[r][j] = xr[64 * j]; }
#pragma unroll
        for (int r = 0; r < 4; ++r) { float s = 0.f;
#pragma unroll
            for (int j = 0; j < 4; ++j) s += (v[r][j].x * v[r][j].x + v[r][j].y * v[r][j].y) + (v[r][j].z * v[r][j].z + v[r][j].w * v[r][j].w);
            const float rs = __builtin_amdgcn_rsqf(wave_sum(s) * (1.0f / DM) + 1e-6f);
            unsigned long long* o8 = (unsigned long long*)(hn + (size_t)(m0 + r) * DM) + lane;
#pragma unroll
            for (int j = 0; j < 4; ++j) { const f32x4 y = v[r][j] * rs * gm[j]; const unsigned long long pk = (unsigned long long)pk2(y.x, y.y) | ((unsigned long long)pk2(y.z, y.w) << 32);
                o8[64 * j] = pk; *(LAS unsigned long long*)(SR + r * 1032 + 4 * lane + 256 * j) = pk; } }
        LDS_WAIT(); asm volatile("" ::: "memory");
        f32x4 ac0 = (f32x4){0.f, 0.f, 0.f, 0.f}, ac1 = ac0;
#pragma unroll 8
        for (int ks = 0; ks < 32; ks += 2) {
            const bf16x8 a0 = *(const LAS bf16x8*)(SR + (fr & 3) * 1032 + ks * 32 + fq * 8), b0 = *(const LAS bf16x8*)(WA + fr * 1032 + ks * 32 + fq * 8);
            const bf16x8 a1 = *(const LAS bf16x8*)(SR + (fr & 3) * 1032 + ks * 32 + 32 + fq * 8), b1 = *(const LAS bf16x8*)(WA + fr * 1032 + ks * 32 + 32 + fq * 8);
            ac0 = MFMA16(a0, b0, ac0); ac1 = MFMA16(a1, b1, ac1); }
        ac0 = ac0 + ac1;
        if (fq == 0) {
#pragma unroll
            for (int i = 0; i < 4; ++i) alr[(size_t)(m0 + i) * 16 + fr] = ac0[i]; }
        LDS_WAIT(); asm volatile("" ::: "memory");
    }
    float* ssq = (float*)(P.ws + WS_SSQ);
    for (int i = blk * 512 + tid; i < M_TOK; i += G * 512) ssq[i] = 0.f;
}

constexpr int SW_QN = 0, SW_KN = 36864, SW_VT = 64512, SW_OT = 90112;
struct SwaRegs { u32x4 q[4], k[3], v[3]; };
__device__ __forceinline__ void swa_load(SwaRegs& R, int b, int n, int kh, const bf16_t* __restrict__ SQ, const bf16_t* __restrict__ SKV, int tid) {
    asm volatile("" : "+v"(tid));
    const int lane = tid & 63, wave = tid >> 6, dq = tid & 7;
    const bf16_t* qb = SQ + ((size_t)b * SEQ_T + (size_t)n * 64) * 1024 + kh * 256;
    const bf16_t* kb = SKV + (size_t)b * SEQ_T * 512 + kh * 64;
    const int p0 = n * 64 - 128;
#pragma unroll
    for (int i = 0; i < 4; ++i) { const unsigned o = (unsigned)tid + 512u * i; R.q[i] = *(const u32x4*)(qb + ((o >> 5) * 1024u + (o & 31u) * 8u)); }
#pragma unroll
    for (int i = 0; i < 3; ++i) { const int j = (int)(((unsigned)tid + 512u * i) >> 3); const int pos = p0 + j;
        R.k[i] = (u32x4){0u, 0u, 0u, 0u};
        if (pos >= 0) R.k[i] = *(const u32x4*)(kb + ((unsigned)pos * 512u + (unsigned)dq * 8u)); }
#pragma unroll
    for (int i = 0; i < 3; ++i) { const int j = (lane >> 3) + 8 * wave + 64 * i; const int pos = p0 + j;
        R.v[i] = (u32x4){0u, 0u, 0u, 0u};
        if (pos >= 0) R.v[i] = *(const u32x4*)(kb + ((unsigned)pos * 512u + 256u + (unsigned)dq * 8u)); }
}
__device__ __forceinline__ float swa_stage(const SwaRegs& R, const float* __restrict__ qn, const float* __restrict__ kn, LAS unsigned char* lds, int tid) {
    asm volatile("" : "+v"(tid));
    const int lane = tid & 63, wave = tid >> 6, dq = tid & 7;
    LAS bf16_t* Qn = (LAS bf16_t*)(lds + SW_QN); LAS bf16_t* Kn = (LAS bf16_t*)(lds + SW_KN); LAS bf16_t* Vt = (LAS bf16_t*)(lds + SW_VT);
    float gqmax, gkmax;
    {
        float g8[8]; { const f32x4 a = *(const f32x4*)(qn + dq * 8), c = *(const f32x4*)(qn + dq * 8 + 4); g8[0] = a.x; g8[1] = a.y; g8[2] = a.z; g8[3] = a.w; g8[4] = c.x; g8[5] = c.y; g8[6] = c.z; g8[7] = c.w; }
#pragma unroll
        for (int i = 0; i < 4; ++i) { const int o = tid + 512 * i, t = o >> 5, oc = o & 31, g = oc >> 3;
            float f[8]; unpack8(R.q[i], f);
            float ss = 0.f;
#pragma unroll
            for (int e = 0; e < 8; ++e) ss += f[e] * f[e];
            ss = sum8_dpp(ss);
            const float rs = __builtin_amdgcn_rsqf(ss * (1.0f / 64.0f) + 1e-6f) * (0.125f * 1.4426950408889634f);
#pragma unroll
            for (int e = 0; e < 8; ++e) f[e] = f[e] * rs * g8[e];
            *(LAS u32x4*)(Qn + (g * 64 + t) * 72 + dq * 8) = pack8(f); __builtin_amdgcn_sched_barrier(0); }
        float m = 0.f;
#pragma unroll
        for (int e = 0; e < 8; ++e) m = fmaxf(m, fabsf(g8[e]));
        gqmax = max8_dpp(m);
    }
    {
        float g8[8]; { const f32x4 a = *(const f32x4*)(kn + dq * 8), c = *(const f32x4*)(kn + dq * 8 + 4); g8[0] = a.x; g8[1] = a.y; g8[2] = a.z; g8[3] = a.w; g8[4] = c.x; g8[5] = c.y; g8[6] = c.z; g8[7] = c.w; }
#pragma unroll
        for (int i = 0; i < 3; ++i) { const int o = tid + 512 * i, j = o >> 3;
            float f[8]; unpack8(R.k[i], f);
            float ss = 0.f;
#pragma unroll
            for (int e = 0; e < 8; ++e) ss += f[e] * f[e];
            ss = sum8_dpp(ss);
            const float rs = __builtin_amdgcn_rsqf(ss * (1.0f / 64.0f) + 1e-6f);
#pragma unroll
            for (int e = 0; e < 8; ++e) f[e] = f[e] * rs * g8[e];
            *(LAS u32x4*)(Kn + j * 72 + dq * 8) = pack8(f); __builtin_amdgcn_sched_barrier(0); }
        float m = 0.f;
#pragma unroll
        for (int e = 0; e < 8; ++e) m = fmaxf(m, fabsf(g8[e]));
        gkmax = max8_dpp(m);
    }
#pragma unroll
    for (int i = 0; i < 3; ++i) { const int j = (lane >> 3) + 8 * wave + 64 * i; const u32x4 w = R.v[i];
        LAS bf16_t* vp = Vt + (dq * 8) * 200 + (j ^ (dq << 3));
        vp[0 * 200] = (bf16_t)(w.x & 0xffffu); vp[1 * 200] = (bf16_t)(w.x >> 16); vp[2 * 200] = (bf16_t)(w.y & 0xffffu); vp[3 * 200] = (bf16_t)(w.y >> 16);
        vp[4 * 200] = (bf16_t)(w.z & 0xffffu); vp[5 * 200] = (bf16_t)(w.z >> 16); vp[6 * 200] = (bf16_t)(w.w & 0xffffu); vp[7 * 200] = (bf16_t)(w.w >> 16); }
    return 8.0f * 1.4426950408889634f * gqmax * gkmax;
}
__device__ __forceinline__ void swa_compute(float M2, int b, int n, int kh, bf16_t* __restrict__ OS, const float* __restrict__ sinks, LAS unsigned char* lds, int tid) {
    asm volatile("" : "+v"(tid));
    const int lane = tid & 63, wave = tid >> 6, fr = lane & 15, fq = lane >> 4;
    LAS bf16_t* Qn = (LAS bf16_t*)(lds + SW_QN); LAS bf16_t* Kn = (LAS bf16_t*)(lds + SW_KN); LAS bf16_t* Vt = (LAS bf16_t*)(lds + SW_VT);
    const int g = wave >> 1, qh = wave & 1;
    const int hh = kh * 4 + g; const float slope = exp2f(-0.5f * (float)(hh + 1)) * 1.4426950408889634f; const float sink = sinks[hh] * 1.4426950408889634f;
    bf16x8 bq[2][2]; float fb[2];
#pragma unroll
    for (int qt = 0; qt < 2; ++qt) { const int qrow = qh * 32 + qt * 16 + fr; fb[qt] = (float)(128 + qrow - 4 * fq);
#pragma unroll
        for (int ks = 0; ks < 2; ++ks) bq[qt][ks] = *(const LAS bf16x8*)(Qn + (g * 64 + qrow) * 72 + ks * 32 + fq * 8); }
    float l[2] = {0.f, 0.f};
    f32x4 oa[4][2];
#pragma unroll
    for (int dt = 0; dt < 4; ++dt)
#pragma unroll
        for (int qt = 0; qt < 2; ++qt) oa[dt][qt] = (f32x4){0.f, 0.f, 0.f, 0.f};
    const int kg0 = n >= 2 ? 0 : 2 - n;
#pragma unroll 1
    for (int kg = kg0; kg < 3; ++kg) {
        float ini[2];
#pragma unroll
        for (int qt = 0; qt < 2; ++qt) ini[qt] = kg < 2 ? -M2 - slope * (fb[qt] - (float)(kg * 64)) : -M2;
        f32x4 sc[4][2];
#pragma unroll
        for (int k4 = 0; k4 < 4; ++k4) { const LAS bf16_t* kr = Kn + (kg * 64 + k4 * 16 + fr) * 72 + fq * 8;
            const bf16x8 ak0 = *(const LAS bf16x8*)(kr), ak1 = *(const LAS bf16x8*)(kr + 32);
#pragma unroll
            for (int qt = 0; qt < 2; ++qt) { f32x4 a = (f32x4){ini[qt], ini[qt], ini[qt], ini[qt]}; a = MFMA16(ak0, bq[qt][0], a); a = MFMA16(ak1, bq[qt][1], a); sc[k4][qt] = a; } }
        if (kg < 2) {
#pragma unroll
            for (int k4 = 0; k4 < 4; ++k4)
#pragma unroll
                for (int qt = 0; qt < 2; ++qt)
#pragma unroll
                    for (int i = 0; i < 4; ++i) sc[k4][qt][i] = fmaf(slope, (float)(k4 * 16 + i), sc[k4][qt][i]);
        } else {
#pragma unroll
            for (int k4 = 0; k4 < 4; ++k4)
#pragma unroll
                for (int qt = 0; qt < 2; ++qt)
#pragma unroll
                    for (int i = 0; i < 4; ++i) sc[k4][qt][i] = sc[k4][qt][i] - slope * fabsf((fb[qt] - 128.0f) - (float)(k4 * 16 + i));
        }
#pragma unroll
        for (int k4 = 0; k4 < 4; ++k4)
#pragma unroll
            for (int qt = 0; qt < 2; ++qt)
#pragma unroll
                for (int i = 0; i < 4; ++i) { const float p = __builtin_amdgcn_exp2f(sc[k4][qt][i]); sc[k4][qt][i] = p; l[qt] += p; }
#pragma unroll
        for (int s2 = 0; s2 < 2; ++s2) {
            bf16x8 bp[2];
#pragma unroll
            for (int qt = 0; qt < 2; ++qt) { u32x4 pw; pw.x = pk2v(sc[2 * s2][qt][0], sc[2 * s2][qt][1]); pw.y = pk2v(sc[2 * s2][qt][2], sc[2 * s2][qt][3]);
                pw.z = pk2v(sc[2 * s2 + 1][qt][0], sc[2 * s2 + 1][qt][1]); pw.w = pk2v(sc[2 * s2 + 1][qt][2], sc[2 * s2 + 1][qt][3]); bp[qt] = __builtin_bit_cast(bf16x8, pw); }
#pragma unroll
            for (int dt = 0; dt < 4; ++dt) { const int d = dt * 16 + fr, swz = ((d >> 3) & 7) << 3; const LAS bf16_t* vr = Vt + d * 200; const int j0 = kg * 64 + 32 * s2 + 4 * fq;
                const u32x2 lo = *(const LAS u32x2*)(vr + (j0 ^ swz)), hi = *(const LAS u32x2*)(vr + ((j0 + 16) ^ swz));
                u32x4 w; w.x = lo.x; w.y = lo.y; w.z = hi.x; w.w = hi.y; const bf16x8 av = __builtin_bit_cast(bf16x8, w);
#pragma unroll
                for (int qt = 0; qt < 2; ++qt) oa[dt][qt] = MFMA16(av, bp[qt], oa[dt][qt]); }
        }
    }
    const float esink = __builtin_amdgcn_exp2f(sink - M2);
#pragma unroll
    for (int qt = 0; qt < 2; ++qt) { float ls = l[qt]; ls += __shfl_xor(ls, 16); ls += __shfl_xor(ls, 32); const float inv = __builtin_amdgcn_rcpf(ls + esink);
        LAS bf16_t* op = (LAS bf16_t*)(lds + SW_OT) + (qh * 32 + qt * 16 + fr) * 264 + g * 64 + 4 * fq;
#pragma unroll
        for (int dt = 0; dt < 4; ++dt) { const f32x4 v = oa[dt][qt] * inv; u32x2 w; w.x = pk2(v[0], v[1]); w.y = pk2(v[2], v[3]); *(LAS u32x2*)(op + dt * 16) = w; } }
}
__device__ __forceinline__ void swa_store(int b, int n, int kh, bf16_t* __restrict__ OS, LAS unsigned char* lds, int tid) {
    asm volatile("" : "+v"(tid));
    const LAS bf16_t* OT = (const LAS bf16_t*)(lds + SW_OT);
    bf16_t* ob = OS + ((size_t)b * SEQ_T + (size_t)n * 64) * 1024 + kh * 256;
#pragma unroll
    for (int i = 0; i < 4; ++i) { const unsigned o = (unsigned)tid + 512u * i, t = o >> 5, oc = o & 31u; *(u32x4*)(ob + (t * 1024u + oc * 8u)) = *(const LAS u32x4*)(OT + t * 264u + oc * 8u); }
}

constexpr int GL_CUM = 0, GL_QD = 34816, GL_KD = 52224, GL_KT = 69632, GL_VT = 88064, GL_P = 124928, GL_SSQ = 134144, GL_DEC = 136192, GL_QT = 137216, GL_ALR = 139264, GL_END = 143360;
static_assert(GL_END <= LDS_BYTES, "GLA LDS map");
constexpr int GLA_NSEG = 8, GLA_SEGC = 64 / GLA_NSEG;
template <bool FULL>
__device__ __forceinline__ void gla_seg(int b, int h, int seg, const bf16_t* __restrict__ QK, const bf16_t* __restrict__ GV, const bf16_t* __restrict__ GG, const float* __restrict__ ALR,
                                        const float* __restrict__ w2, const float* __restrict__ balpha, const float* __restrict__ gnorm, bf16_t* __restrict__ OG,
                                        float* __restrict__ Lws, float* __restrict__ Dws, LAS unsigned char* lds, int tid) {
    asm volatile("" : "+v"(tid));
    const int lane = tid & 63, wave = tid >> 6, fr = lane & 15, fq = lane >> 4;
    LAS float* CUM = (LAS float*)(lds + GL_CUM); LAS bf16_t* OB = (LAS bf16_t*)(lds + GL_QD);
    LAS bf16_t* QD = (LAS bf16_t*)(lds + GL_QD); LAS bf16_t* KD = (LAS bf16_t*)(lds + GL_KD); LAS bf16_t* KT = (LAS bf16_t*)(lds + GL_KT); LAS bf16_t* VT = (LAS bf16_t*)(lds + GL_VT);
    LAS bf16_t* PB = (LAS bf16_t*)(lds + GL_P); LAS float* SSQ = (LAS float*)(lds + GL_SSQ); LAS float* DEC = (LAS float*)(lds + GL_DEC); LAS float* QT = (LAS float*)(lds + GL_QT);
    LAS float* ALRS = (LAS float*)(lds + GL_ALR);
    const int lt = (lane >> 3) + 8 * wave, lo = lane & 7, lsw = lt ^ (lo << 3);
    const int seq = b * 4 + h;
    f32x4 S[8][2];
#pragma unroll
    for (int a = 0; a < 8; ++a)
#pragma unroll
        for (int c = 0; c < 2; ++c) S[a][c] = (f32x4){0.f, 0.f, 0.f, 0.f};
    if (FULL) {
        const float* Lb0 = Lws + (size_t)(seq * GLA_NSEG) * 32768 + (size_t)wave * 4096 + lane * 4; const float* Db0 = Dws + (seq * GLA_NSEG) * 128;
        f32x4 La[16], Lb[16];
#define GLA_LOADL(DST, J) do { _Pragma("unroll") for (int q_ = 0; q_ < 16; ++q_) DST[q_] = *(const f32x4*)(Lb0 + (size_t)(J) * 32768 + q_ * 256); } while (0)
#define GLA_FOLD(SRC, J) do { _Pragma("unroll") for (int dkt = 0; dkt < 8; ++dkt) { const f32x4 dc = *(const f32x4*)(Db0 + (J) * 128 + dkt * 16 + 4 * fq); \
            _Pragma("unroll") for (int dvt = 0; dvt < 2; ++dvt) S[dkt][dvt] = S[dkt][dvt] * dc + SRC[dkt * 2 + dvt]; } } while (0)
        if (seg > 0) GLA_LOADL(La, 0);
#pragma unroll 1
        for (int j = 0; j < seg; j += 2) {
            if (j + 1 < seg) GLA_LOADL(Lb, j + 1);
            GLA_FOLD(La, j);
            if (j + 1 < seg) { if (j + 2 < seg) GLA_LOADL(La, j + 2); GLA_FOLD(Lb, j + 1); }
        }
#undef GLA_LOADL
#undef GLA_FOLD
    }
    const int dkc = wave * 16 + fr;
    bf16x8 w2f; { float w[8];
#pragma unroll
        for (int j = 0; j < 8; ++j) w[j] = w2[((fq & 1) * 8 + j) * 512 + h * 128 + dkc];
        w2f = __builtin_bit_cast(bf16x8, pack8v(w)); }
    const float bz = balpha[h * 128 + dkc];
    const size_t tokb = (size_t)b * SEQ_T + (size_t)seg * (GLA_SEGC * 64);
    if (tid < 256) *(LAS f32x4*)(ALRS + tid * 4) = *(const f32x4*)(ALR + tokb * 16 + tid * 4);
    float segtot = 0.f;
    u32x4 qw[2], kw[2], vw[4];
#define GLA_LOAD_QKV(T0) do { _Pragma("unroll") for (int i_ = 0; i_ < 2; ++i_) { const int oc_ = lo + 8 * i_; \
            kw[i_] = *(const u32x4*)(QK + ((T0) + lt) * 1024 + 512 + h * 128 + oc_ * 8); } \
        _Pragma("unroll") for (int i_ = 0; i_ < 4; ++i_) { const int oc_ = lo + 8 * i_; vw[i_] = *(const u32x4*)(GV + ((T0) + lt) * 1024 + h * 256 + oc_ * 8); } } while (0)
    __syncthreads();
#pragma unroll 1
    for (int c = 0; c < GLA_SEGC; ++c) {
        const size_t tok0 = tokb + (size_t)c * 64;
        GLA_LOAD_QKV(tok0);
        if (FULL) {
#pragma unroll
            for (int i = 0; i < 2; ++i) qw[i] = *(const u32x4*)(QK + (tok0 + lt) * 1024 + h * 128 + (lo + 8 * i) * 8); }
        {
            float carry = 0.f;
#pragma unroll
            for (int tt = 0; tt < 4; ++tt) {
                const LAS f32x4* ar = (const LAS f32x4*)(ALRS + (tt * 16 + fr) * 16 + (fq & 1) * 8); const f32x4 x0 = ar[0], x1 = ar[1];
                float x[8] = {x0.x, x0.y, x0.z, x0.w, x1.x, x1.y, x1.z, x1.w}, xh[8];
                unpack8(pack8v(x), xh);
                if (fq >= 2) {
#pragma unroll
                    for (int e = 0; e < 8; ++e) x[e] -= xh[e];
                }
                const bf16x8 af = __builtin_bit_cast(bf16x8, pack8v(x));
                const f32x4 z4 = MFMA16(af, w2f, ((f32x4){0.f, 0.f, 0.f, 0.f}));
                float v[4];
#pragma unroll
                for (int i = 0; i < 4; ++i) { const float z = z4[i] + bz;
                    v[i] = (fminf(z, 0.f) - 0.6931471805599453f * __builtin_amdgcn_logf(1.0f + __builtin_amdgcn_exp2f(-1.4426950408889634f * fabsf(z)))) * (1.0f / 16.0f); }
                v[1] += v[0]; v[2] += v[1]; v[3] += v[2];
                const float tot4 = v[3];
                const float p1 = __shfl_up(tot4, 16); float sc = tot4 + (fq >= 1 ? p1 : 0.f);
                const float p2 = __shfl_up(sc, 32); sc += (fq >= 2 ? p2 : 0.f);
                const float base = carry + (sc - tot4);
#pragma unroll
                for (int i = 0; i < 4; ++i) CUM[(tt * 16 + 4 * fq + i) * 132 + dkc] = v[i] + base;
                carry += __shfl(sc, 48 + fr);
            }
            if (fq == 0) DEC[dkc] = __builtin_amdgcn_exp2f(1.4426950408889634f * carry);
            segtot += carry;
        }
        __syncthreads();
        if (c + 1 < GLA_SEGC && tid < 256) *(LAS f32x4*)(ALRS + tid * 4) = *(const f32x4*)(ALR + (tok0 + 64) * 16 + tid * 4);
#pragma unroll
        for (int i = 0; i < 2; ++i) { const int oc = lo + 8 * i, t = lt;
            float k8[8]; unpack8(kw[i], k8);
            const f32x4 c0 = *(const LAS f32x4*)(CUM + t * 132 + oc * 8), c1 = *(const LAS f32x4*)(CUM + t * 132 + oc * 8 + 4);
            const f32x4 d0 = *(const LAS f32x4*)(DEC + oc * 8), d1 = *(const LAS f32x4*)(DEC + oc * 8 + 4);
            const float cm[8] = {c0.x, c0.y, c0.z, c0.w, c1.x, c1.y, c1.z, c1.w}; const float dc[8] = {d0.x, d0.y, d0.z, d0.w, d1.x, d1.y, d1.z, d1.w};
            float kd[8], ke[8];
#pragma unroll
            for (int e = 0; e < 8; ++e) { const float em = __builtin_amdgcn_exp2f(-1.4426950408889634f * cm[e]); kd[e] = k8[e] * em; ke[e] = kd[e] * dc[e]; }
            if (FULL) { float q8[8], qd[8]; unpack8(qw[i], q8);
#pragma unroll
                for (int e = 0; e < 8; ++e) qd[e] = q8[e] * __builtin_amdgcn_exp2f(1.4426950408889634f * cm[e]) * 0.08838834764831845f;
                *(LAS u32x4*)(QD + t * 136 + oc * 8) = pack8(qd); *(LAS u32x4*)(KD + t * 136 + oc * 8) = pack8(kd); }
            const u32x4 kp8 = pack8(ke); LAS bf16_t* kp = KT + (oc * 8) * 72 + lsw;
            kp[0 * 72] = (bf16_t)(kp8.x & 0xffffu); kp[1 * 72] = (bf16_t)(kp8.x >> 16); kp[2 * 72] = (bf16_t)(kp8.y & 0xffffu); kp[3 * 72] = (bf16_t)(kp8.y >> 16);
            kp[4 * 72] = (bf16_t)(kp8.z & 0xffffu); kp[5 * 72] = (bf16_t)(kp8.z >> 16); kp[6 * 72] = (bf16_t)(kp8.w & 0xffffu); kp[7 * 72] = (bf16_t)(kp8.w >> 16); }
#pragma unroll
        for (int i = 0; i < 4; ++i) { const int oc = lo + 8 * i; const u32x4 w = vw[i]; LAS bf16_t* vp = VT + (oc * 8) * 72 + lsw;
            vp[0 * 72] = (bf16_t)(w.x & 0xffffu); vp[1 * 72] = (bf16_t)(w.x >> 16); vp[2 * 72] = (bf16_t)(w.y & 0xffffu); vp[3 * 72] = (bf16_t)(w.y >> 16);
            vp[4 * 72] = (bf16_t)(w.z & 0xffffu); vp[5 * 72] = (bf16_t)(w.z >> 16); vp[6 * 72] = (bf16_t)(w.w & 0xffffu); vp[7 * 72] = (bf16_t)(w.w >> 16); }
        __syncthreads();
        f32x4 o[4][2];
        u32x4 gw[4];
        if (FULL) {
            {
                const int tt = wave >> 1;
#pragma unroll
                for (int u2 = 0; u2 < 2; ++u2) { const int st = (wave & 1) * 2 + u2; f32x4 a = (f32x4){0.f, 0.f, 0.f, 0.f};
                    if (st <= tt) {
#pragma unroll
                        for (int ks = 0; ks < 4; ++ks) { const bf16x8 ak = *(const LAS bf16x8*)(KD + (st * 16 + fr) * 136 + ks * 32 + fq * 8), bq = *(const LAS bf16x8*)(QD + (tt * 16 + fr) * 136 + ks * 32 + fq * 8);
                            a = MFMA16(ak, bq, a); }
                    }
                    const int t = tt * 16 + fr, s0 = st * 16 + 4 * fq;
                    const float p0 = (s0 + 0 <= t) ? a[0] : 0.f, p1 = (s0 + 1 <= t) ? a[1] : 0.f, p2 = (s0 + 2 <= t) ? a[2] : 0.f, p3 = (s0 + 3 <= t) ? a[3] : 0.f;
                    u32x2 w; w.x = pk2(p0, p1); w.y = pk2(p2, p3); *(LAS u32x2*)(PB + t * 72 + s0) = w; }
            }
#pragma unroll
            for (int a = 0; a < 4; ++a)
#pragma unroll
                for (int d = 0; d < 2; ++d) o[a][d] = (f32x4){0.f, 0.f, 0.f, 0.f};
#pragma unroll
            for (int ks = 0; ks < 4; ++ks) {
                bf16x8 bs[2];
#pragma unroll
                for (int dvt = 0; dvt < 2; ++dvt) { u32x4 w; w.x = pk2v(S[2 * ks][dvt][0], S[2 * ks][dvt][1]); w.y = pk2v(S[2 * ks][dvt][2], S[2 * ks][dvt][3]);
                    w.z = pk2v(S[2 * ks + 1][dvt][0], S[2 * ks + 1][dvt][1]); w.w = pk2v(S[2 * ks + 1][dvt][2], S[2 * ks + 1][dvt][3]); bs[dvt] = __builtin_bit_cast(bf16x8, w); }
#pragma unroll
                for (int tt = 0; tt < 4; ++tt) { const LAS bf16_t* qp = QD + (tt * 16 + fr) * 136 + 32 * ks + 4 * fq;
                    const u32x2 lo = *(const LAS u32x2*)(qp), hi = *(const LAS u32x2*)(qp + 16);
                    u32x4 w; w.x = lo.x; w.y = lo.y; w.z = hi.x; w.w = hi.y; const bf16x8 aq = __builtin_bit_cast(bf16x8, w);
#pragma unroll
                    for (int dvt = 0; dvt < 2; ++dvt) o[tt][dvt] = MFMA16(aq, bs[dvt], o[tt][dvt]); }
            }
        }
        bf16x8 bv[2][2];
#pragma unroll
        for (int dvt = 0; dvt < 2; ++dvt)
#pragma unroll
            for (int ks = 0; ks < 2; ++ks) { const int dv = wave * 32 + dvt * 16 + fr; bv[dvt][ks] = *(const LAS bf16x8*)(VT + dv * 72 + ((ks * 32 + fq * 8) ^ (((dv >> 3) & 7) << 3))); }
#pragma unroll
        for (int dkt = 0; dkt < 8; ++dkt) { const f32x4 dc = *(const LAS f32x4*)(DEC + dkt * 16 + 4 * fq);
#pragma unroll
            for (int dvt = 0; dvt < 2; ++dvt) S[dkt][dvt] = S[dkt][dvt] * dc;
#pragma unroll
            for (int ks = 0; ks < 2; ++ks) { const int dkr = dkt * 16 + fr; const bf16x8 ak = *(const LAS bf16x8*)(KT + dkr * 72 + ((ks * 32 + fq * 8) ^ (((dkr >> 3) & 7) << 3)));
#pragma unroll
                for (int dvt = 0; dvt < 2; ++dvt) S[dkt][dvt] = MFMA16(ak, bv[dvt][ks], S[dkt][dvt]); } }
        if (FULL) {
#pragma unroll
            for (int i = 0; i < 4; ++i) { const int oid = tid + 512 * i, t = oid >> 5, oc = oid & 31; gw[i] = *(const u32x4*)(GG + (tok0 + t) * 1024 + h * 256 + oc * 8); }
        }
        __syncthreads();
        if (FULL) {
#pragma unroll
            for (int ks = 0; ks < 2; ++ks)
#pragma unroll
                for (int tt = 0; tt < 4; ++tt) { if (ks == 1 && tt < 2) continue;
                    const bf16x8 ap = *(const LAS bf16x8*)(PB + (tt * 16 + fr) * 72 + ks * 32 + fq * 8);
#pragma unroll
                    for (int dvt = 0; dvt < 2; ++dvt) o[tt][dvt] = MFMA16(ap, bv[dvt][ks], o[tt][dvt]); }
#pragma unroll
            for (int tt = 0; tt < 4; ++tt)
#pragma unroll
                for (int i = 0; i < 4; ++i) { const int t = tt * 16 + 4 * fq + i; const float v0 = o[tt][0][i], v1 = o[tt][1][i];
                    const unsigned w = pk2(v0, v1);
                    OB[t * 272 + wave * 32 + fr] = (bf16_t)(w & 0xffffu); OB[t * 272 + wave * 32 + 16 + fr] = (bf16_t)(w >> 16);
                    const float q = sum16_dpp(v0 * v0 + v1 * v1);
                    if (fr == 0) SSQ[wave * 64 + t] = q; }
            __syncthreads();
#pragma unroll
            for (int i = 0; i < 4; ++i) { const int oid = tid + 512 * i, t = oid >> 5, oc = oid & 31;
                float ss = 0.f;
#pragma unroll
                for (int w = 0; w < 8; ++w) ss += SSQ[w * 64 + t];
                const float rs = __builtin_amdgcn_rsqf(ss * (1.0f / 256.0f) + 1e-6f);
                float ov[8], gv[8]; unpack8(*(const LAS u32x4*)(OB + t * 272 + oc * 8), ov); unpack8(gw[i], gv);
                const f32x4 n0 = *(const f32x4*)(gnorm + oc * 8), n1 = *(const f32x4*)(gnorm + oc * 8 + 4); const float gn[8] = {n0.x, n0.y, n0.z, n0.w, n1.x, n1.y, n1.z, n1.w};
#pragma unroll
                for (int e = 0; e < 8; ++e) ov[e] = ov[e] * rs * gn[e] * gv[e];
                *(u32x4*)(OG + (tok0 + t) * 1024 + h * 256 + oc * 8) = pack8(ov); }
        }
    }
    if (!FULL) {
        float* Lj = Lws + (size_t)(seq * GLA_NSEG + seg) * 32768 + (size_t)wave * 4096 + lane * 4;
#pragma unroll
        for (int dkt = 0; dkt < 8; ++dkt)
#pragma unroll
            for (int dvt = 0; dvt < 2; ++dvt) *(f32x4*)(Lj + (dkt * 2 + dvt) * 256) = S[dkt][dvt];
        if (fq == 0) Dws[(seq * GLA_NSEG + seg) * 128 + dkc] = __builtin_amdgcn_exp2f(1.4426950408889634f * segtot);
    }
#undef GLA_LOAD_QKV
}

#define XB_TMO      128
#define XB_XCNT(j)  (256  + 64 * (j))
#define XB_XSUB(j)  (1280 + 64 * (j))
#define XB_XGEN(j)  (2304 + 64 * (j))
#define XB_TOP      3328
#define XB_TOPGEN   3392
#define XCD_BAR_WORDS 3456
#define XB_SPIN_CAP (1u << 18)

__device__ __forceinline__ unsigned xb_ld(unsigned* p)              { return __hip_atomic_load(p, __ATOMIC_RELAXED, __HIP_MEMORY_SCOPE_AGENT); }
__device__ __forceinline__ unsigned xb_add(unsigned* p, unsigned v) { return __hip_atomic_fetch_add(p, v, __ATOMIC_RELAXED, __HIP_MEMORY_SCOPE_AGENT); }
__device__ __forceinline__ unsigned xb_xcc_id() { return (unsigned)__builtin_amdgcn_s_getreg((3 << 11) | 20) & 0xFu; }
#define XB_SPIN(cond, bar) do { unsigned _sp = 0; while (cond) { __builtin_amdgcn_s_sleep(1); \
    if ((++_sp & 255u) == 0u) { if (xb_ld(&(bar)[XB_TMO])) break; if (_sp > XB_SPIN_CAP) { atomicAdd(&(bar)[XB_TMO], 1u); break; } } } } while (0)

struct XcdBarrier {
    unsigned* bar; unsigned x;
    volatile LAS unsigned* st;
};

__device__ __forceinline__ XcdBarrier xcd_barrier_post(unsigned* bar, volatile LAS unsigned* st) {
    XcdBarrier b; b.bar = bar; b.x = xb_xcc_id(); b.st = st;
    if (threadIdx.x == 0) (void)xb_add(&bar[XB_XCNT(b.x)], 1u);
    return b;
}
__device__ __forceinline__ void xcd_barrier_complete(unsigned* bar, unsigned x, unsigned& nloc, unsigned& nx) {
    const unsigned G = gridDim.x * gridDim.y * gridDim.z;
    unsigned sum, cnt, mine, sp = 0u;
    for (;;) {
        sum = 0u; cnt = 0u; mine = 0u;
#pragma unroll
        for (unsigned j = 0; j < 16; ++j) { const unsigned c = xb_ld(&bar[XB_XCNT(j)]); sum += c; cnt += (c > 0u) ? 1u : 0u; mine = (j == x) ? c : mine; }
        if (sum == G) break;
        __builtin_amdgcn_s_sleep(1);
        if ((++sp & 255u) == 0u) { if (xb_ld(&bar[XB_TMO])) break; if (sp > XB_SPIN_CAP) { atomicAdd(&bar[XB_TMO], 1u); break; } }
    }
    nloc = mine > 0u ? mine : 1u; nx = cnt > 0u ? cnt : 1u;
}

__device__ __forceinline__ void xcd_barrier(const XcdBarrier& b) {
    asm volatile("s_waitcnt vmcnt(0)" ::: "memory");
    __syncthreads();
    if (threadIdx.x == 0) {
        unsigned* bar = b.bar;
        __builtin_amdgcn_s_waitcnt(0);
        unsigned nloc = b.st[0], nx = b.st[1];
        if (nloc == 0u) { xcd_barrier_complete(bar, b.x, nloc, nx); b.st[0] = nloc; b.st[1] = nx; }
        const unsigned old = xb_add(&bar[XB_XSUB(b.x)], 1u);
        const unsigned gen = old / nloc;
        if (old + 1u == (gen + 1u) * nloc) {
            __builtin_amdgcn_fence(__ATOMIC_RELEASE, "agent");
            asm volatile("s_waitcnt vmcnt(0)" ::: "memory");
            const unsigned og = xb_add(&bar[XB_TOP], 1u);
            const unsigned tg = og / nx;
            if (og + 1u == (tg + 1u) * nx) xb_add(&bar[XB_TOPGEN], 1u);
            else XB_SPIN(xb_ld(&bar[XB_TOPGEN]) == tg, bar);
            __builtin_amdgcn_fence(__ATOMIC_ACQUIRE, "agent");
            xb_add(&bar[XB_XGEN(b.x)], 1u);
            asm volatile("s_waitcnt vmcnt(0)" ::: "memory");
        } else {
            XB_SPIN(xb_ld(&bar[XB_XGEN(b.x)]) == gen, bar);
            __builtin_amdgcn_fence(__ATOMIC_ACQUIRE, "agent");
            asm volatile("s_waitcnt vmcnt(0)" ::: "memory");
        }
    }
    __syncthreads();
}


struct Args { const float* in[15]; float* out; unsigned char* ws; };
__global__ void __launch_bounds__(512) mk_fwd(Args a) {
    extern __shared__ __attribute__((aligned(16))) unsigned char lds_raw[];
    cg::grid_group grid = cg::this_grid();
    LAS unsigned char* lds = (LAS unsigned char*)lds_raw;
    const int tid = threadIdx.x, G = gridDim.x, blk = blockIdx.x;
    Ptrs P; P.x = a.in[0]; P.norm_mix = a.in[1]; P.w_in = a.in[2]; P.w_alpha2 = a.in[3]; P.b_alpha = a.in[4]; P.gla_norm = a.in[5]; P.swa_qn = a.in[6]; P.swa_kn = a.in[7]; P.sinks = a.in[8];
    P.w_bg = a.in[9]; P.w_bs = a.in[10]; P.w_out = a.in[11]; P.norm_mlp = a.in[12]; P.w_up = a.in[13]; P.w_down = a.in[14]; P.out = a.out; P.ws = a.ws;
    unsigned char* ws = a.ws;
    bf16_t* OGLA = (bf16_t*)a.out; bf16_t* OSWA = (bf16_t*)a.out + (size_t)M_TOK * 1024;
    float* SSQ = (float*)(ws + WS_SSQ); float* ALR = (float*)(ws + WS_ALR);

    volatile LAS unsigned* xst = (volatile LAS unsigned*)(lds + LDS_BYTES - 16);
    if (tid < 4) xst[tid] = 0u;
    __syncthreads();
    const XcdBarrier xbar = xcd_barrier_post((unsigned*)(ws + WS_BAR), xst);
    const bool use_cg = G > 1024;
#define GRID_BAR() xcd_barrier(xbar)
    if (PH_MASK & 1) for (int rep = 0; rep < REP_P0; ++rep) p0_prologue(P, lds, tid, G, blk);
    if (use_cg) grid.sync(); else xcd_barrier(xbar);
    if (PH_MASK & 2) {
        pg8::Gemm g{(const bf16_t*)a.out, (const bf16_t*)(ws + WS_WIN), M_TOK, NPROJ, 1024}; pg8::StaticOrder S; S.init(M_TOK, NPROJ, G, blk);
        pg8::EpiProj E{ws};
        for (int rep = 0; rep < REP_P1; ++rep)
        pg8::gemm_phase<pg8::EpiProj, pg8::StaticOrder, true, true>(lds, g, S, E);
    }
    GRID_BAR();
    {
        const bf16_t* QKp = (const bf16_t*)(ws + WS_QK); const bf16_t* GVp = (const bf16_t*)(ws + WS_GV); const bf16_t* GGp = (const bf16_t*)(ws + WS_GG);
        float* Lws = (float*)(ws + WS_GLAL); float* Dws = (float*)(ws + WS_GLAD);
        constexpr int NA = 32 * (GLA_NSEG - 1);
        for (int rep = 0; rep < REP_P2A; ++rep) {
        for (int rpa = 0; rpa < REP_PA; ++rpa)
        if (PH_MASK & 64) for (int it = blk; it < NA; it += G) { const int seq = it / (GLA_NSEG - 1), seg = it % (GLA_NSEG - 1);
            gla_seg<false>(seq >> 2, seq & 3, seg, QKp, GVp, GGp, ALR, P.w_alpha2, P.b_alpha, P.gla_norm, OGLA, Lws, Dws, lds, tid); }
        for (int rsw = 0; rsw < REP_SWA; ++rsw)
        if (PH_MASK & 128) {
            int u0, u1, ustep;
            if (G == 256) { if (blk >= NA) { u0 = (blk - NA) * 12; u1 = u0 + 12; } else if (blk < 96) { u0 = 384 + blk * 8; u1 = u0 + 8; } else { u0 = 1152 + (blk - 96) * 7; u1 = u0 + 7; } ustep = 1; }
            else { u0 = blk; u1 = 2048; ustep = G; }
            int tl = tid; asm volatile("" : "+v"(tl));
            const bf16_t* SQp = (const bf16_t*)(ws + WS_SQ); const bf16_t* SKVp = (const bf16_t*)(ws + WS_SKV);
            SwaRegs R;
            if (u0 < u1) swa_load(R, u0 >> 8, u0 & 63, (u0 >> 6) & 3, SQp, SKVp, tl);
#pragma unroll 1
            for (int u = u0; u < u1; u += ustep) { const int n = u & 63, kh = (u >> 6) & 3, b = u >> 8;
                const float M2 = swa_stage(R, P.swa_qn, P.swa_kn, lds, tl);
                __syncthreads();
                const int un = u + ustep;
                if (un < u1) swa_load(R, un >> 8, un & 63, (un >> 6) & 3, SQp, SKVp, tl);
                swa_compute(M2, b, n, kh, OSWA, P.sinks, lds, tl);
                __syncthreads();
                swa_store(b, n, kh, OSWA, lds, tl); }
            if (G == 256 && blk >= 96 && blk < NA && rsw == 0) {
                __syncthreads();
                const int wv = tl >> 6; LAS float* scr = (LAS float*)(lds + wv * 12288);
                for (int q = wv; q < 44; q += 8) transpose_rest_item(P, (blk - 96) * 44 + q, scr, tl & 63);
            }
        }
        }
        GRID_BAR();
        for (int rep = 0; rep < REP_P2B; ++rep)
        if (PH_MASK & 64) for (int it = blk; it < 32 * GLA_NSEG; it += G) { const int seq = it / GLA_NSEG, seg = it % GLA_NSEG;
            gla_seg<true>(seq >> 2, seq & 3, seg, QKp, GVp, GGp, ALR, P.w_alpha2, P.b_alpha, P.gla_norm, OGLA, Lws, Dws, lds, tid); }
    }
    GRID_BAR();
    if (PH_MASK & 8) {
        pg8::StaticOrder S; S.init(M_TOK, 1024, G, blk);
        { pg8::Gemm g{OGLA, (const bf16_t*)(ws + WS_WBG), M_TOK, 1024, 1024}; pg8::EpiGate<true> E{(const bf16_t*)(ws + WS_GA), (bf16_t*)(ws + WS_MERGED)};
          pg8::gemm_phase<pg8::EpiGate<true>, pg8::StaticOrder, true, true>(lds, g, S, E); }
        { pg8::Gemm g{OSWA, (const bf16_t*)(ws + WS_WBS), M_TOK, 1024, 1024}; pg8::EpiGate<false> E{(const bf16_t*)(ws + WS_GB), (bf16_t*)(ws + WS_MERGED)};
          pg8::gemm_phase<pg8::EpiGate<false>, pg8::StaticOrder, true, true>(lds, g, S, E); }
    }
    GRID_BAR();
    if (PH_MASK & 16) {
        pg8::Gemm g{(const bf16_t*)(ws + WS_MERGED), (const bf16_t*)(ws + WS_WOUT), M_TOK, 1024, 1024}; pg8::StaticOrder S; S.init(M_TOK, 1024, G, blk);
        pg8::EpiRes E{P.x, (bf16_t*)(ws + WS_H1B), SSQ};
        pg8::gemm_phase<pg8::EpiRes, pg8::StaticOrder, true, true>(lds, g, S, E);
    }
    GRID_BAR();
    if (PH_MASK & 32) {
        pg8::Gemm g{(const bf16_t*)(ws + WS_H1B), (const bf16_t*)(ws + WS_WUP), M_TOK, DFF, 1024}; pg8::StaticOrder S; S.init(M_TOK, DFF, G, blk);
        pg8::EpiUp E{SSQ, (bf16_t*)(ws + WS_U)};
        pg8::gemm_phase<pg8::EpiUp, pg8::StaticOrder, true, true>(lds, g, S, E);
    }
    GRID_BAR();
    if (PH_MASK & 256) {
        pg8::Gemm g{(const bf16_t*)(ws + WS_U), (const bf16_t*)(ws + WS_WDN), M_TOK, 1024, DFF}; pg8::StaticOrder S; S.init(M_TOK, 1024, G, blk);
        pg8::EpiDown E{(const bf16_t*)(ws + WS_H1B), a.out};
        pg8::gemm_phase<pg8::EpiDown, pg8::StaticOrder, true, true>(lds, g, S, E);
    }
}

extern "C" void kernel_launch(void* const* d_in, const int* in_sizes, int n_in, void* d_out, int out_size, void* d_ws, size_t ws_size, hipStream_t stream) {
    static int grid = 0;
    if (grid == 0) {
        if (n_in != 15 || out_size != M_TOK * DM || ws_size < WS_END) { fprintf(stderr, "kernel_launch: unexpected shapes (n_in %d out %d ws %zu)\n", n_in, out_size, ws_size); grid = -1; return; }
        int dev = 0, cus = 0, per_cu = 0;
        hipGetDevice(&dev); hipDeviceGetAttribute(&cus, hipDeviceAttributeMultiprocessorCount, dev);
        if (hipFuncSetAttribute((const void*)mk_fwd, hipFuncAttributeMaxDynamicSharedMemorySize, LDS_BYTES) != hipSuccess) { fprintf(stderr, "kernel_launch: hipFuncSetAttribute failed\n"); grid = -1; return; }
        if (hipOccupancyMaxActiveBlocksPerMultiprocessor(&per_cu, (const void*)mk_fwd, 512, LDS_BYTES) != hipSuccess || per_cu < 1) { fprintf(stderr, "kernel_launch: occupancy query says %d\n", per_cu); per_cu = 1; }
        (void)hipGetLastError();
        grid = cus > 1024 ? 1024 : cus;
        if (grid < 64) { fprintf(stderr, "kernel_launch: only %d CUs\n", cus); grid = -1; return; }
    }
    if (grid < 0) return;
    if (hipMemsetAsync((char*)d_ws + WS_BAR, 0, BAR_BYTES, stream) != hipSuccess) { fprintf(stderr, "kernel_launch: hipMemsetAsync failed\n"); return; }
    Args a{};
    for (int i = 0; i < 15; ++i) a.in[i] = (const float*)d_in[i];
    a.out = (float*)d_out; a.ws = (unsigned char*)d_ws;
    void* args[] = {&a};
    hipError_t e = hipLaunchCooperativeKernel((const void*)mk_fwd, dim3(grid), dim3(512), args, LDS_BYTES, stream);
    if (e != hipSuccess) fprintf(stderr, "kernel_launch: cooperative launch failed: %s (grid %d)\n", hipGetErrorString(e), grid);
}
```

```cpp
#include <hip/hip_runtime.h>
#include <hip/hip_cooperative_groups.h>
#include <cstdio>
#include <cstdint>
namespace cg = cooperative_groups;

constexpr int M_TOK = 32768, DM = 1024, SEQ_T = 4096, NPROJ = 6656, DFF = 4096;
constexpr size_t MiB = 1u << 20;
constexpr size_t WS_SSQ = 0;
constexpr size_t WS_BAR = 1 * MiB, BAR_BYTES = 16384;
constexpr size_t WS_WIN = 2 * MiB, WS_WBG = 16 * MiB, WS_WBS = 18 * MiB, WS_WOUT = 20 * MiB, WS_WUP = 22 * MiB, WS_WDN = 30 * MiB;
constexpr size_t WS_ALR = 38 * MiB;
constexpr size_t WS_QK = 40 * MiB, WS_GV = 104 * MiB, WS_GG = 168 * MiB, WS_SQ = 232 * MiB;
constexpr size_t WS_SKV = 296 * MiB;
constexpr size_t WS_GA = 328 * MiB, WS_GB = 392 * MiB;
constexpr size_t WS_MERGED = 40 * MiB;
constexpr size_t WS_H1B = 104 * MiB;
constexpr size_t WS_U = 168 * MiB;
constexpr size_t WS_GLAL = 456 * MiB, WS_GLAD = 488 * MiB;
constexpr size_t WS_END = 489 * MiB;
constexpr int LDS_BYTES = 147456;
#ifndef REP_P0
#define REP_P0 1
#endif
#ifndef REP_P1
#define REP_P1 1
#endif
#ifndef REP_PA
#define REP_PA 1
#endif
#ifndef REP_SWA
#define REP_SWA 1
#endif
#ifndef REP_P2A
#define REP_P2A 1
#endif
#ifndef REP_P2B
#define REP_P2B 1
#endif
#ifndef PH_MASK
#define PH_MASK 0x1ff
#endif
#define LAS __attribute__((address_space(3)))
namespace pg8 {
#define PG8_LAS __attribute__((address_space(3)))
typedef unsigned short bf16_t;
typedef short bf16x8 __attribute__((ext_vector_type(8)));
typedef float f32x4 __attribute__((ext_vector_type(4)));
typedef unsigned u32x4 __attribute__((ext_vector_type(4)));
constexpr int BM = 256, BK = 64, HALF = 128, HTB = HALF * BK * 2  , STAGE_BYTES = 8 * HTB, NXCD = 8, WGM = 8;

__host__ __device__ __forceinline__ int lds_byte(int r, int c) { const int st = (r >> 4) * 2 + (c >> 5), rr = r & 15, cc = c & 31, ob = rr * 64 + cc * 2; return st * 1024 + (ob ^ (((ob >> 9) & 1) << 5)); }
__host__ __device__ __forceinline__ void stage_rc(int b, int& R, int& C) { const int st = b / 1024, sb = b % 1024, swz = sb ^ (((sb >> 9) & 1) << 5); R = (st >> 1) * 16 + swz / 64; C = (st & 1) * 32 + (swz % 64) / 2; }
__host__ __device__ __forceinline__ int perm32(int rho) { const int n = rho >> 4, i = rho & 15; return 8 * (i >> 2) + 4 * n + (i & 3); }

struct Unit { int pm, pn; };
struct Gemm { const bf16_t* A; const bf16_t* Bt; int M, N, K; };

struct StaticOrder {
    int nM, nN, nwg, G, c;
    __host__ __device__ void init(int M, int N, int G_, int c_) { nM = M / BM; nN = N / BM; nwg = nM * nN; G = G_; c = c_; }
    __host__ __device__ bool next(int i, Unit& u) const {
        const long L = (long)i * G + c; if (L >= nwg) return false;
        int wgid = (int)L; { const int q = nwg / NXCD, r = nwg % NXCD, xcd = wgid % NXCD, off = wgid / NXCD; wgid = (xcd < r ? xcd * (q + 1) : r * (q + 1) + (xcd - r) * q) + off; }
        const int nig = WGM * nN, gid = wgid / nig, fm = gid * WGM, gsz = (nM - fm) < WGM ? (nM - fm) : WGM;
        u.pm = fm + ((wgid % nig) % gsz); u.pn = (wgid % nig) / gsz; return true;
    }
    __device__ __forceinline__ void a_ready(const Unit&) const {}
    __device__ __forceinline__ void done(const Unit&) const {}
};
__device__ __forceinline__ unsigned cvt_pk_bf16(float lo, float hi) { unsigned r; asm volatile("v_cvt_pk_bf16_f32 %0, %1, %2" : "=v"(r) : "v"(lo), "v"(hi)); return r; }
typedef float f32x2c __attribute__((ext_vector_type(2))); typedef __bf16 bf16x2c __attribute__((ext_vector_type(2)));
__device__ __forceinline__ unsigned cvt_pk_bf16_v(float lo, float hi) { const f32x2c v = {lo, hi}; const bf16x2c b = __builtin_convertvector(v, bf16x2c); return __builtin_bit_cast(unsigned, b); }
__device__ __forceinline__ float bflo(unsigned w) { return __uint_as_float(w << 16); }
__device__ __forceinline__ float bfhi(unsigned w) { return __uint_as_float(w & 0xffff0000u); }
__device__ __forceinline__ void unpack8(const u32x4 w, float (&f)[8]) { f[0] = bflo(w.x); f[1] = bfhi(w.x); f[2] = bflo(w.y); f[3] = bfhi(w.y); f[4] = bflo(w.z); f[5] = bfhi(w.z); f[6] = bflo(w.w); f[7] = bfhi(w.w); }
__device__ __forceinline__ u32x4 pack8(const float (&f)[8]) { u32x4 w; w.x = cvt_pk_bf16(f[0], f[1]); w.y = cvt_pk_bf16(f[2], f[3]); w.z = cvt_pk_bf16(f[4], f[5]); w.w = cvt_pk_bf16(f[6], f[7]); return w; }
__device__ __forceinline__ float sigm(float x) { return __builtin_amdgcn_rcpf(1.f + __builtin_amdgcn_exp2f(-1.4426950408889634f * x)); }

struct EpiProj {
    static constexpr bool PERM = true, AFTER_DRAIN = false;
    unsigned char* ws;
    __device__ __forceinline__ void operator()(const f32x4 (&acc)[2][2][4][2], const Unit& u, int wr, int wc, int fr, int fq) const {
        const int pn = u.pn; const int row0 = u.pm * BM + wr * 64 + fr;
        size_t off; int ldc = 1024, colt, act = 0;
        if (pn < 16) { off = WS_QK + (size_t)(pn >> 2) * (64 * MiB); colt = (pn & 3) * 256; if ((pn >> 2) == 2) act = 2; }
        else if (pn < 18) { off = WS_SKV; ldc = 512; colt = (pn - 16) * 256; }
        else if (pn < 22) { off = WS_GA; colt = (pn - 18) * 256; act = 1; }
        else { off = WS_GB; colt = (pn - 22) * 256; act = 1; }
        bf16_t* base = (bf16_t*)(ws + off);
        const int col0 = colt + wc * 32 + 8 * fq;
#pragma unroll
        for (int ai = 0; ai < 2; ++ai)
#pragma unroll
            for (int m = 0; m < 4; ++m) { bf16_t* rowp = base + (size_t)(row0 + ai * HALF + m * 16) * ldc + col0;
#pragma unroll
                for (int bj = 0; bj < 2; ++bj) { const f32x4 v0 = acc[ai][bj][m][0], v1 = acc[ai][bj][m][1];
                    float f[8] = {v0[0], v0[1], v0[2], v0[3], v1[0], v1[1], v1[2], v1[3]};
                    if (act == 1) {
#pragma unroll
                        for (int e = 0; e < 8; ++e) f[e] = sigm(f[e]);
                    } else if (act == 2) {
#pragma unroll
                        for (int e = 0; e < 8; ++e) f[e] = f[e] * sigm(f[e]);
                    }
                    *(u32x4*)(rowp + bj * HALF) = pack8(f); } }
    }
};
template <bool FIRST> struct EpiGate {
    static constexpr bool PERM = true, AFTER_DRAIN = false;
    const bf16_t* gate; bf16_t* merged;
    __device__ __forceinline__ void operator()(const f32x4 (&acc)[2][2][4][2], const Unit& u, int wr, int wc, int fr, int fq) const {
        const int row0 = u.pm * BM + wr * 64 + fr, col0 = u.pn * BM + wc * 32 + 8 * fq;
#pragma unroll
        for (int ai = 0; ai < 2; ++ai)
#pragma unroll
            for (int m = 0; m < 4; ++m) { const size_t idx = (size_t)(row0 + ai * HALF + m * 16) * 1024 + col0;
#pragma unroll
                for (int bj = 0; bj < 2; ++bj) { const f32x4 v0 = acc[ai][bj][m][0], v1 = acc[ai][bj][m][1];
                    float f[8] = {v0[0], v0[1], v0[2], v0[3], v1[0], v1[1], v1[2], v1[3]}; float g[8];
                    unpack8(*(const u32x4*)(gate + idx + bj * HALF), g);
#pragma unroll
                    for (int e = 0; e < 8; ++e) f[e] *= g[e];
                    if (!FIRST) { float p[8]; unpack8(*(const u32x4*)(merged + idx + bj * HALF), p);
#pragma unroll
                        for (int e = 0; e < 8; ++e) f[e] += p[e]; }
                    *(u32x4*)(merged + idx + bj * HALF) = pack8(f); } }
    }
};
struct PairOrder {
    StaticOrder base;
    __host__ __device__ void init(int M, int N, int G_, int c_) { base.init(M, N, G_, c_); }
    __host__ __device__ bool next(int i, Unit& u) const { Unit v; if (!base.next(i >> 1, v)) return false; u.pm = v.pm + ((i & 1) ? 128 : 0); u.pn = v.pn + ((i & 1) ? 4 : 0); return true; }
    __device__ __forceinline__ void a_ready(const Unit&) const {}
    __device__ __forceinline__ void done(const Unit&) const {}
};
struct EpiGatePair {
    static constexpr bool PERM = true, AFTER_DRAIN = false;
    EpiGate<true> e0; EpiGate<false> e1;
    __device__ __forceinline__ void operator()(const f32x4 (&acc)[2][2][4][2], const Unit& u, int wr, int wc, int fr, int fq) const {
        if (u.pm < 128) e0(acc, u, wr, wc, fr, fq); else { const Unit v{u.pm - 128, u.pn - 4}; e1(acc, v, wr, wc, fr, fq); }
    }
};
struct EpiRes {
    static constexpr bool PERM = true, AFTER_DRAIN = false;
    const float* x; bf16_t* h1b; float* ssq;
    __device__ __forceinline__ void operator()(const f32x4 (&acc)[2][2][4][2], const Unit& u, int wr, int wc, int fr, int fq) const {
        const int row0 = u.pm * BM + wr * 64 + fr, col0 = u.pn * BM + wc * 32 + 8 * fq;
#pragma unroll
        for (int ai = 0; ai < 2; ++ai)
#pragma unroll
            for (int m = 0; m < 4; ++m) { const int row = row0 + ai * HALF + m * 16; const size_t idx = (size_t)row * 1024 + col0; float ss = 0.f;
#pragma unroll
                for (int bj = 0; bj < 2; ++bj) { const f32x4 x0 = *(const f32x4*)(x + idx + bj * HALF), x1 = *(const f32x4*)(x + idx + bj * HALF + 4);
                    const f32x4 h0 = x0 + acc[ai][bj][m][0], h1v = x1 + acc[ai][bj][m][1];
                    float f[8] = {h0[0], h0[1], h0[2], h0[3], h1v[0], h1v[1], h1v[2], h1v[3]};
#pragma unroll
                    for (int e = 0; e < 8; ++e) ss += f[e] * f[e];
                    *(u32x4*)(h1b + idx + bj * HALF) = pack8(f); }
                ss += __shfl_xor(ss, 16); ss += __shfl_xor(ss, 32);
                if (fq == 0) atomicAdd(ssq + row, ss); }
    }
};
struct EpiUp {
    static constexpr bool PERM = true, AFTER_DRAIN = false;
    const float* ssq; bf16_t* U;
    __device__ __forceinline__ void operator()(const f32x4 (&acc)[2][2][4][2], const Unit& u, int wr, int wc, int fr, int fq) const {
        const int row0 = u.pm * BM + wr * 64 + fr, col0 = u.pn * BM + wc * 32 + 8 * fq;
#pragma unroll
        for (int ai = 0; ai < 2; ++ai)
#pragma unroll
            for (int m = 0; m < 4; ++m) { const int row = row0 + ai * HALF + m * 16; const float rs = __builtin_amdgcn_rsqf(ssq[row] * (1.0f / 1024.0f) + 1e-6f); bf16_t* rowp = U + (size_t)row * 4096 + col0;
#pragma unroll
                for (int bj = 0; bj < 2; ++bj) { const f32x4 v0 = acc[ai][bj][m][0], v1 = acc[ai][bj][m][1];
                    float f[8] = {v0[0], v0[1], v0[2], v0[3], v1[0], v1[1], v1[2], v1[3]};
#pragma unroll
                    for (int e = 0; e < 8; ++e) { const float r = fmaxf(f[e] * rs, 0.f); f[e] = r * r; }
                    *(u32x4*)(rowp + bj * HALF) = pack8(f); } }
    }
};
struct EpiDown {
    static constexpr bool PERM = true, AFTER_DRAIN = false;
    const bf16_t* h1b; float* out;
    __device__ __forceinline__ void operator()(const f32x4 (&acc)[2][2][4][2], const Unit& u, int wr, int wc, int fr, int fq) const {
        const int row0 = u.pm * BM + wr * 64 + fr, col0 = u.pn * BM + wc * 32 + 8 * fq;
#pragma unroll
        for (int ai = 0; ai < 2; ++ai)
#pragma unroll
            for (int m = 0; m < 4; ++m) { const size_t idx = (size_t)(row0 + ai * HALF + m * 16) * 1024 + col0;
#pragma unroll
                for (int bj = 0; bj < 2; ++bj) { float h[8]; unpack8(*(const u32x4*)(h1b + idx + bj * HALF), h);
                    const f32x4 a0 = acc[ai][bj][m][0], a1 = acc[ai][bj][m][1];
                    *(f32x4*)(out + idx + bj * HALF) = (f32x4){h[0] + a0[0], h[1] + a0[1], h[2] + a0[2], h[3] + a0[3]};
                    *(f32x4*)(out + idx + bj * HALF + 4) = (f32x4){h[4] + a1[0], h[5] + a1[1], h[6] + a1[2], h[7] + a1[3]}; } }
    }
};
template <class Epi, class Sched, bool ALIGN_EPI = false, bool SP2 = false>
__device__ __forceinline__ void gemm_phase(PG8_LAS unsigned char* lds, const Gemm g, const Sched& S, const Epi& E) {
    int tid_ = threadIdx.x; asm volatile("" : "+v"(tid_));
    const int tid = tid_, wid = __builtin_amdgcn_readfirstlane(tid >> 6), lane = tid & 63, wr = wid >> 2, wc = wid & 3, fr = lane & 15, fq = lane >> 4;
    const int K = g.K, nt = K / BK;
    unsigned voffA[2], voffB[2];
#pragma unroll
    for (int i = 0; i < 2; ++i) { int R, C; stage_rc(tid * 16 + i * 8192, R, C); const int Rb = Epi::PERM ? ((R & ~31) + perm32(R & 31)) : R;
        voffA[i] = (unsigned)(R * K + C) * 2u; voffB[i] = (unsigned)(Rb * K + C) * 2u; }
    const size_t kstep = (size_t)(BK * 2);
    const size_t hstep = (size_t)HALF * K * 2;
    const size_t tstep = 2 * hstep;
    const unsigned ldsw = (unsigned)wid * 1024u;
    const int aoff = lds_byte(wr * 64 + fr, fq * 8), boff = lds_byte(wc * 32 + fr, fq * 8);
#define PG8_SA(b, h) (((b) * 2 + (h)) * HTB)
#define PG8_SB(b, h) ((4 + (b) * 2 + (h)) * HTB)
#define PG8_STAGE(bufoff, gbase, voff) do { _Pragma("unroll") for (int _i = 0; _i < 2; ++_i) \
        __builtin_amdgcn_global_load_lds((const unsigned*)((const char*)(gbase) + (voff)[_i]), (PG8_LAS unsigned*)(lds + (bufoff) + ldsw + _i * 8192), 16, 0, 0); } while (0)
#define PG8_LDA(dst, b, h) do { _Pragma("unroll") for (int m = 0; m < 4; ++m) _Pragma("unroll") for (int k = 0; k < 2; ++k) dst[m][k] = *(const PG8_LAS bf16x8*)(lds + PG8_SA(b, h) + aoff + m * 2048 + k * 1024); } while (0)
#define PG8_LDB(dst, b, h) do { _Pragma("unroll") for (int n = 0; n < 2; ++n) _Pragma("unroll") for (int k = 0; k < 2; ++k) dst[n][k] = *(const PG8_LAS bf16x8*)(lds + PG8_SB(b, h) + boff + n * 2048 + k * 1024); } while (0)
#define PG8_MMA(ai, bj, At, Bt) do { __builtin_amdgcn_s_setprio(1); _Pragma("unroll") for (int m = 0; m < 4; ++m) _Pragma("unroll") for (int n = 0; n < 2; ++n) _Pragma("unroll") for (int k = 0; k < 2; ++k) \
        acc[ai][bj][m][n] = __builtin_amdgcn_mfma_f32_16x16x32_bf16(Bt[n][k], At[m][k], acc[ai][bj][m][n], 0, 0, 0); __builtin_amdgcn_s_setprio(0); } while (0)
#define PG8_WAIT_V(n) asm volatile("s_waitcnt vmcnt(" #n ")" ::: "memory")
#define PG8_WAIT_L(n) asm volatile("s_waitcnt lgkmcnt(" #n ")" ::: "memory")
#define PG8_BAR __builtin_amdgcn_s_barrier()
#define PG8_SCHED __builtin_amdgcn_sched_barrier(0)
    Unit cur, nxt; int ui = 0;
    if (!S.next(0, cur)) return;
    f32x4 acc[2][2][4][2];
#pragma unroll
    for (int a = 0; a < 2; ++a)
#pragma unroll
        for (int b = 0; b < 2; ++b)
#pragma unroll
            for (int m = 0; m < 4; ++m)
#pragma unroll
                for (int n = 0; n < 2; ++n) acc[a][b][m][n] = (f32x4){0.f, 0.f, 0.f, 0.f};
    bf16x8 At[4][2], B0[2][2], B1[2][2];
    const char* cA = (const char*)g.A + (size_t)cur.pm * tstep; const char* cB = (const char*)g.Bt + (size_t)cur.pn * tstep;
    S.a_ready(cur);
    if constexpr (SP2) {
        PG8_STAGE(PG8_SB(0, 0), cB, voffB); PG8_STAGE(PG8_SB(0, 1), cB + hstep, voffB); PG8_STAGE(PG8_SA(0, 0), cA, voffA); PG8_STAGE(PG8_SA(0, 1), cA + hstep, voffA);
        if (wr == 1) PG8_BAR;
        PG8_WAIT_V(2); PG8_BAR;
        PG8_STAGE(PG8_SB(1, 0), cB + kstep, voffB); PG8_STAGE(PG8_SA(1, 0), cA + kstep, voffA); PG8_STAGE(PG8_SB(1, 1), cB + hstep + kstep, voffB);
        PG8_WAIT_V(6); PG8_BAR;
    } else {
        PG8_STAGE(PG8_SB(0, 0), cB, voffB); PG8_STAGE(PG8_SA(0, 0), cA, voffA); PG8_STAGE(PG8_SB(0, 1), cB + hstep, voffB); PG8_STAGE(PG8_SA(0, 1), cA + hstep, voffA);
        if (wr == 1) PG8_BAR;
        PG8_WAIT_V(4); PG8_BAR;
        PG8_STAGE(PG8_SB(1, 0), cB + kstep, voffB); PG8_STAGE(PG8_SA(1, 0), cA + kstep, voffA); PG8_STAGE(PG8_SB(1, 1), cB + hstep + kstep, voffB);
        PG8_WAIT_V(6); PG8_BAR;
    }
    for (;;) {
        const bool has_next = S.next(ui + 1, nxt);
        const char* nA = has_next ? (const char*)g.A + (size_t)nxt.pm * tstep : cA; const char* nB = has_next ? (const char*)g.Bt + (size_t)nxt.pn * tstep : cB;
        for (int t = 0; t < nt; t += 2) {
            const bool last = (t == nt - 2);
            const char* a1 = cA + (size_t)(t + 1) * kstep;
            const char* a2 = last ? nA : cA + (size_t)(t + 2) * kstep; const char* b2 = last ? nB : cB + (size_t)(t + 2) * kstep;
            const char* a3 = a2 + kstep; const char* b3 = b2 + kstep;
            if (last && has_next) S.a_ready(nxt);
            if constexpr (SP2) {
            PG8_LDB(B0, 0, 0); PG8_LDB(B1, 0, 1); PG8_SCHED; PG8_LDA(At, 0, 0); PG8_STAGE(PG8_SA(1, 1), a1 + hstep, voffA);
            PG8_WAIT_V(8); PG8_WAIT_L(0); PG8_BAR; PG8_MMA(0, 0, At, B0); PG8_MMA(0, 1, At, B1); PG8_BAR; PG8_SCHED;
            PG8_LDA(At, 0, 1); PG8_STAGE(PG8_SB(0, 0), b2, voffB); PG8_STAGE(PG8_SB(0, 1), b2 + hstep, voffB); PG8_STAGE(PG8_SA(0, 0), a2, voffA);
            PG8_WAIT_V(8); PG8_WAIT_L(0); PG8_BAR; PG8_MMA(1, 0, At, B0); PG8_MMA(1, 1, At, B1); PG8_BAR; PG8_SCHED;
            PG8_LDB(B0, 1, 0); PG8_LDB(B1, 1, 1); PG8_SCHED; PG8_LDA(At, 1, 0); PG8_STAGE(PG8_SA(0, 1), a2 + hstep, voffA);
            PG8_WAIT_V(8); PG8_WAIT_L(0); PG8_BAR; PG8_MMA(0, 0, At, B0); PG8_MMA(0, 1, At, B1); PG8_BAR; PG8_SCHED;
            PG8_LDA(At, 1, 1); PG8_STAGE(PG8_SB(1, 0), b3, voffB); PG8_STAGE(PG8_SB(1, 1), b3 + hstep, voffB); PG8_STAGE(PG8_SA(1, 0), a3, voffA);
            PG8_WAIT_V(8); PG8_WAIT_L(0); PG8_BAR; PG8_MMA(1, 0, At, B0); PG8_MMA(1, 1, At, B1); PG8_BAR; PG8_SCHED;
            } else {
            PG8_LDB(B0, 0, 0); PG8_SCHED; PG8_LDA(At, 0, 0); PG8_STAGE(PG8_SA(1, 1), a1 + hstep, voffA);
            PG8_WAIT_L(8); PG8_BAR; PG8_WAIT_L(0); PG8_MMA(0, 0, At, B0); PG8_BAR; PG8_SCHED;
            PG8_LDB(B1, 0, 1); PG8_STAGE(PG8_SB(0, 0), b2, voffB);
            PG8_BAR; PG8_WAIT_L(0); PG8_MMA(0, 1, At, B1); PG8_BAR;
            PG8_LDA(At, 0, 1); PG8_STAGE(PG8_SA(0, 0), a2, voffA);
            PG8_BAR; PG8_WAIT_L(0); PG8_MMA(1, 0, At, B0); PG8_BAR; PG8_SCHED;
            PG8_STAGE(PG8_SB(0, 1), b2 + hstep, voffB);
            PG8_WAIT_V(6); PG8_BAR; PG8_MMA(1, 1, At, B1); PG8_BAR;
            PG8_LDB(B0, 1, 0); PG8_SCHED; PG8_LDA(At, 1, 0); PG8_STAGE(PG8_SA(0, 1), a2 + hstep, voffA);
            PG8_WAIT_L(8); PG8_BAR; PG8_WAIT_L(0); PG8_MMA(0, 0, At, B0); PG8_BAR; PG8_SCHED;
            PG8_LDB(B1, 1, 1); PG8_STAGE(PG8_SB(1, 0), b3, voffB);
            PG8_BAR; PG8_WAIT_L(0); PG8_MMA(0, 1, At, B1); PG8_BAR;
            PG8_LDA(At, 1, 1); PG8_STAGE(PG8_SA(1, 0), a3, voffA);
            PG8_BAR; PG8_WAIT_L(0); PG8_MMA(1, 0, At, B0); PG8_BAR; PG8_SCHED;
            PG8_STAGE(PG8_SB(1, 1), b3 + hstep, voffB);
            PG8_WAIT_V(6); PG8_BAR; PG8_MMA(1, 1, At, B1); PG8_BAR;
            }
        }
        if constexpr (ALIGN_EPI) { if (wr == 0) PG8_BAR; }
        if constexpr (!Epi::AFTER_DRAIN) { E(acc, cur, wr, wc, fr, fq); S.done(cur); }
        if (!has_next) break;
#pragma unroll
        for (int a = 0; a < 2; ++a)
#pragma unroll
            for (int b = 0; b < 2; ++b)
#pragma unroll
                for (int m = 0; m < 4; ++m)
#pragma unroll
                    for (int n = 0; n < 2; ++n) acc[a][b][m][n] = (f32x4){0.f, 0.f, 0.f, 0.f};
        cur = nxt; cA = nA; cB = nB; ++ui;
        if constexpr (ALIGN_EPI) { if (wr == 1) PG8_BAR; }
    }
    PG8_WAIT_V(0);
    if constexpr (!ALIGN_EPI) { if (wr == 0) PG8_BAR; }
    PG8_BAR;
    if constexpr (Epi::AFTER_DRAIN) { E.fused(acc, cur, wr, wc, fr, fq, lds, wid, lane); S.done(cur); }
#undef PG8_SA
#undef PG8_SB
#undef PG8_STAGE
#undef PG8_LDA
#undef PG8_LDB
#undef PG8_MMA
#undef PG8_WAIT_V
#undef PG8_WAIT_L
#undef PG8_BAR
#undef PG8_SCHED
}
}

using pg8::bf16_t; using pg8::bf16x8; using pg8::f32x4; using pg8::u32x4; using pg8::unpack8; using pg8::pack8;
typedef unsigned u32x2 __attribute__((ext_vector_type(2)));
#define MFMA16(a, b, c) __builtin_amdgcn_mfma_f32_16x16x32_bf16((a), (b), (c), 0, 0, 0)
__device__ __forceinline__ unsigned pk2(float lo, float hi) { return pg8::cvt_pk_bf16(lo, hi); }
__device__ __forceinline__ unsigned pk2v(float lo, float hi) { return pg8::cvt_pk_bf16_v(lo, hi); }
__device__ __forceinline__ u32x4 pack8v(const float (&f)[8]) { u32x4 w; w.x = pk2v(f[0], f[1]); w.y = pk2v(f[2], f[3]); w.z = pk2v(f[4], f[5]); w.w = pk2v(f[6], f[7]); return w; }
__device__ __forceinline__ float wave_sum(float v) {
#pragma unroll
    for (int o = 1; o < 64; o <<= 1) v += __shfl_xor(v, o);
    return v;
}
#define LDS_WAIT() asm volatile("s_waitcnt lgkmcnt(0)" ::: "memory")
template <int CTRL> __device__ __forceinline__ float dpp_mov(float v) { return __builtin_bit_cast(float, __builtin_amdgcn_update_dpp(0, __builtin_bit_cast(int, v), CTRL, 0xf, 0xf, true)); }
__device__ __forceinline__ float sum8_dpp(float v) { v += dpp_mov<0xB1>(v); v += dpp_mov<0x4E>(v); v += dpp_mov<0x141>(v); return v; }
__device__ __forceinline__ float max8_dpp(float v) { v = fmaxf(v, dpp_mov<0xB1>(v)); v = fmaxf(v, dpp_mov<0x4E>(v)); v = fmaxf(v, dpp_mov<0x141>(v)); return v; }
__device__ __forceinline__ float sum16_dpp(float v) { v = sum8_dpp(v); v += dpp_mov<0x140>(v); return v; }

__device__ __forceinline__ void transpose_item(const float* __restrict__ W, int ldw, int K, bf16_t* WT, int dst_row0, int src_col0, int nvalid, const float* __restrict__ kscale, int k0, LAS float* scr, int lane) {
    const int c4 = lane & 7, kr = lane >> 3;
    f32x4 v[8];
#pragma unroll
    for (int i = 0; i < 8; ++i) { v[i] = (f32x4){0.f, 0.f, 0.f, 0.f};
        if (4 * c4 < nvalid) v[i] = *(const f32x4*)(W + (size_t)(k0 + kr + 8 * i) * ldw + src_col0 + 4 * c4); }
    if (kscale) {
#pragma unroll
        for (int i = 0; i < 8; ++i) v[i] = v[i] * kscale[k0 + kr + 8 * i];
    }
#pragma unroll
    for (int i = 0; i < 8; ++i) { LAS float* d = scr + (kr + 8 * i) * 33 + 4 * c4; d[0] = v[i].x; d[1] = v[i].y; d[2] = v[i].z; d[3] = v[i].w; }
    LDS_WAIT(); asm volatile("" ::: "memory");
    const int ch = lane & 7;
#pragma unroll
    for (int j = 0; j < 4; ++j) { const int n = (lane >> 3) + 8 * j; const LAS float* s = scr + (8 * ch) * 33 + n;
        u32x4 o; o.x = pk2(s[0 * 33], s[1 * 33]); o.y = pk2(s[2 * 33], s[3 * 33]); o.z = pk2(s[4 * 33], s[5 * 33]); o.w = pk2(s[6 * 33], s[7 * 33]);
        *(u32x4*)(WT + (size_t)(dst_row0 + n) * K + k0 + 8 * ch) = o; }
    LDS_WAIT(); asm volatile("" ::: "memory");
}
struct Ptrs {
    const float *x, *norm_mix, *w_in, *w_alpha2, *b_alpha, *gla_norm, *swa_qn, *swa_kn, *sinks, *w_bg, *w_bs, *w_out, *norm_mlp, *w_up, *w_down;
    float* out; unsigned char* ws;
};
constexpr int P0_I_SQ = 16 * 32, P0_I_UP = 16 * 128, P0_I_DN = 64 * 32, P0_REST_ITEMS = 3 * P0_I_SQ + P0_I_UP + P0_I_DN;
__device__ __forceinline__ void transpose_rest_item(const Ptrs& P, int r, LAS float* scr, int lane) {
    if (r < P0_I_SQ) { transpose_item(P.w_bg, 1024, 1024, (bf16_t*)(P.ws + WS_WBG), 32 * (r % 32), 32 * (r % 32), 32, nullptr, 64 * (r / 32), scr, lane); return; } r -= P0_I_SQ;
    if (r < P0_I_SQ) { transpose_item(P.w_bs, 1024, 1024, (bf16_t*)(P.ws + WS_WBS), 32 * (r % 32), 32 * (r % 32), 32, nullptr, 64 * (r / 32), scr, lane); return; } r -= P0_I_SQ;
    if (r < P0_I_SQ) { transpose_item(P.w_out, 1024, 1024, (bf16_t*)(P.ws + WS_WOUT), 32 * (r % 32), 32 * (r % 32), 32, nullptr, 64 * (r / 32), scr, lane); return; } r -= P0_I_SQ;
    if (r < P0_I_UP) { transpose_item(P.w_up, 4096, 1024, (bf16_t*)(P.ws + WS_WUP), 32 * (r % 128), 32 * (r % 128), 32, P.norm_mlp, 64 * (r / 128), scr, lane); return; } r -= P0_I_UP;
    transpose_item(P.w_down, 1024, 4096, (bf16_t*)(P.ws + WS_WDN), 32 * (r % 32), 32 * (r % 32), 32, nullptr, 64 * (r / 32), scr, lane);
}
__device__ __forceinline__ void p0_prologue(const Ptrs& P, LAS unsigned char* lds, int tid, int G, int blk) {
    const int lane = tid & 63, wave = tid >> 6;
    LAS float* scr = (LAS float*)(lds + wave * 12288);
    const int gw = blk * 8 + wave, NGW = G * 8;
    LAS bf16_t* WA = (LAS bf16_t*)(lds + 98304);
    for (int idx = tid; idx < 4096; idx += 512) { const int k = idx >> 2, c = (idx & 3) * 4; const f32x4 w = *(const f32x4*)(P.w_in + (size_t)k * 6672 + 3072 + c); const unsigned p0 = pk2(w.x, w.y), p1 = pk2(w.z, w.w);
        WA[(c + 0) * 1032 + k] = (bf16_t)(p0 & 0xffffu); WA[(c + 1) * 1032 + k] = (bf16_t)(p0 >> 16); WA[(c + 2) * 1032 + k] = (bf16_t)(p1 & 0xffffu); WA[(c + 3) * 1032 + k] = (bf16_t)(p1 >> 16); }
    __syncthreads();
    constexpr int I_IN = 16 * (NPROJ / 32);
    const int nitems = (G == 256) ? I_IN : I_IN + P0_REST_ITEMS;
    for (int it = gw; it < nitems; it += NGW) {
        if (it < I_IN) { const int nblk = NPROJ / 32, kb = it / nblk, nb = it % nblk, d = 32 * nb; int src, nv;
            if (d < 3072) { src = d; nv = 32; } else { src = d + 16; nv = 32; }
            transpose_item(P.w_in, 6672, 1024, (bf16_t*)(P.ws + WS_WIN), d, src, nv, nullptr, 64 * kb, scr, lane); continue; }
        transpose_rest_item(P, it - I_IN, scr, lane);
    }
    bf16_t* hn = (bf16_t*)P.out; float* alr = (float*)(P.ws + WS_ALR);
    LAS bf16_t* SR = (LAS bf16_t*)scr;
    const int fr = lane & 15, fq = lane >> 4;
    f32x4 gm[4];
#pragma unroll
    for (int j = 0; j < 4; ++j) gm[j] = *(const f32x4*)(P.norm_mix + 4 * lane + 256 * j);
    for (int m0 = gw * 4; m0 < M_TOK; m0 += NGW * 4) {
        f32x4 v[4][4];
#pragma unroll
        for (int r = 0; r < 4; ++r) { const f32x4* xr = (const f32x4*)(P.x + (size_t)(m0 + r) * DM) + lane;
#pragma unroll
            for (int j = 0; j < 4; ++j) v[r][j] = xr[64 * j]; }
#pragma unroll
        for (int r = 0; r < 4; ++r) { float s = 0.f;
#pragma unroll
            for (int j = 0; j < 4; ++j) s += (v[r][j].x * v[r][j].x + v[r][j].y * v[r][j].y) + (v[r][j].z * v[r][j].z + v[r][j].w * v[r][j].w);
            const float rs = __builtin_amdgcn_rsqf(wave_sum(s) * (1.0f / DM) + 1e-6f);
            unsigned long long* o8 = (unsigned long long*)(hn + (size_t)(m0 + r) * DM) + lane;
#pragma unroll
            for (int j = 0; j < 4; ++j) { const f32x4 y = v[r][j] * rs * gm[j]; const unsigned long long pk = (unsigned long long)pk2(y.x, y.y) | ((unsigned long long)pk2(y.z, y.w) << 32);
                o8[64 * j] = pk; *(LAS unsigned long long*)(SR + r * 1032 + 4 * lane + 256 * j) = pk; } }
        LDS_WAIT(); asm volatile("" ::: "memory");
        f32x4 ac0 = (f32x4){0.f, 0.f, 0.f, 0.f}, ac1 = ac0;
#pragma unroll 8
        for (int ks = 0; ks < 32; ks += 2) {
            const bf16x8 a0 = *(const LAS bf16x8*)(SR + (fr & 3) * 1032 + ks * 32 + fq * 8), b0 = *(const LAS bf16x8*)(WA + fr * 1032 + ks * 32 + fq * 8);
            const bf16x8 a1 = *(const LAS bf16x8*)(SR + (fr & 3) * 1032 + ks * 32 + 32 + fq * 8), b1 = *(const LAS bf16x8*)(WA + fr * 1032 + ks * 32 + 32 + fq * 8);
            ac0 = MFMA16(a0, b0, ac0); ac1 = MFMA16(a1, b1, ac1); }
        ac0 = ac0 + ac1;
        if (fq == 0) {
#pragma unroll
            for (int i = 0; i < 4; ++i) alr[(size_t)(m0 + i) * 16 + fr] = ac0[i]; }
        LDS_WAIT(); asm volatile("" ::: "memory");
    }
    float* ssq = (float*)(P.ws + WS_SSQ);
    for (int i = blk * 512 + tid; i < M_TOK; i += G * 512) ssq[i] = 0.f;
}

constexpr int SW_QN = 0, SW_KN = 36864, SW_VT = 64512, SW_OT = 90112;
struct SwaRegs { u32x4 q[4], k[3], v[3]; };
__device__ __forceinline__ void swa_load(SwaRegs& R, int b, int n, int kh, const bf16_t* __restrict__ SQ, const bf16_t* __restrict__ SKV, int tid) {
    asm volatile("" : "+v"(tid));
    const int lane = tid & 63, wave = tid >> 6, dq = tid & 7;
    const bf16_t* qb = SQ + ((size_t)b * SEQ_T + (size_t)n * 64) * 1024 + kh * 256;
    const bf16_t* kb = SKV + (size_t)b * SEQ_T * 512 + kh * 64;
    const int p0 = n * 64 - 128;
#pragma unroll
    for (int i = 0; i < 4; ++i) { const unsigned o = (unsigned)tid + 512u * i; R.q[i] = *(const u32x4*)(qb + ((o >> 5) * 1024u + (o & 31u) * 8u)); }
#pragma unroll
    for (int i = 0; i < 3; ++i) { const int j = (int)(((unsigned)tid + 512u * i) >> 3); const int pos = p0 + j;
        R.k[i] = (u32x4){0u, 0u, 0u, 0u};
        if (pos >= 0) R.k[i] = *(const u32x4*)(kb + ((unsigned)pos * 512u + (unsigned)dq * 8u)); }
#pragma unroll
    for (int i = 0; i < 3; ++i) { const int j = (lane >> 3) + 8 * wave + 64 * i; const int pos = p0 + j;
        R.v[i] = (u32x4){0u, 0u, 0u, 0u};
        if (pos >= 0) R.v[i] = *(const u32x4*)(kb + ((unsigned)pos * 512u + 256u + (unsigned)dq * 8u)); }
}
__device__ __forceinline__ float swa_stage(const SwaRegs& R, const float* __restrict__ qn, const float* __restrict__ kn, LAS unsigned char* lds, int tid) {
    asm volatile("" : "+v"(tid));
    const int lane = tid & 63, wave = tid >> 6, dq = tid & 7;
    LAS bf16_t* Qn = (LAS bf16_t*)(lds + SW_QN); LAS bf16_t* Kn = (LAS bf16_t*)(lds + SW_KN); LAS bf16_t* Vt = (LAS bf16_t*)(lds + SW_VT);
    float gqmax, gkmax;
    {
        float g8[8]; { const f32x4 a = *(const f32x4*)(qn + dq * 8), c = *(const f32x4*)(qn + dq * 8 + 4); g8[0] = a.x; g8[1] = a.y; g8[2] = a.z; g8[3] = a.w; g8[4] = c.x; g8[5] = c.y; g8[6] = c.z; g8[7] = c.w; }
#pragma unroll
        for (int i = 0; i < 4; ++i) { const int o = tid + 512 * i, t = o >> 5, oc = o & 31, g = oc >> 3;
            float f[8]; unpack8(R.q[i], f);
            float ss = 0.f;
#pragma unroll
            for (int e = 0; e < 8; ++e) ss += f[e] * f[e];
            ss = sum8_dpp(ss);
            const float rs = __builtin_amdgcn_rsqf(ss * (1.0f / 64.0f) + 1e-6f) * (0.125f * 1.4426950408889634f);
#pragma unroll
            for (int e = 0; e < 8; ++e) f[e] = f[e] * rs * g8[e];
            *(LAS u32x4*)(Qn + (g * 64 + t) * 72 + dq * 8) = pack8(f); __builtin_amdgcn_sched_barrier(0); }
        float m = 0.f;
#pragma unroll
        for (int e = 0; e < 8; ++e) m = fmaxf(m, fabsf(g8[e]));
        gqmax = max8_dpp(m);
    }
    {
        float g8[8]; { const f32x4 a = *(const f32x4*)(kn + dq * 8), c = *(const f32x4*)(kn + dq * 8 + 4); g8[0] = a.x; g8[1] = a.y; g8[2] = a.z; g8[3] = a.w; g8[4] = c.x; g8[5] = c.y; g8[6] = c.z; g8[7] = c.w; }
#pragma unroll
        for (int i = 0; i < 3; ++i) { const int o = tid + 512 * i, j = o >> 3;
            float f[8]; unpack8(R.k[i], f);
            float ss = 0.f;
#pragma unroll
            for (int e = 0; e < 8; ++e) ss += f[e] * f[e];
            ss = sum8_dpp(ss);
            const float rs = __builtin_amdgcn_rsqf(ss * (1.0f / 64.0f) + 1e-6f);
#pragma unroll
            for (int e = 0; e < 8; ++e) f[e] = f[e] * rs * g8[e];
            *(LAS u32x4*)(Kn + j * 72 + dq * 8) = pack8(f); __builtin_amdgcn_sched_barrier(0); }
        float m = 0.f;
#pragma unroll
        for (int e = 0; e < 8; ++e) m = fmaxf(m, fabsf(g8[e]));
        gkmax = max8_dpp(m);
    }
#pragma unroll
    for (int i = 0; i < 3; ++i) { const int j = (lane >> 3) + 8 * wave + 64 * i; const u32x4 w = R.v[i];
        LAS bf16_t* vp = Vt + (dq * 8) * 200 + (j ^ (dq << 3));
        vp[0 * 200] = (bf16_t)(w.x & 0xffffu); vp[1 * 200] = (bf16_t)(w.x >> 16); vp[2 * 200] = (bf16_t)(w.y & 0xffffu); vp[3 * 200] = (bf16_t)(w.y >> 16);
        vp[4 * 200] = (bf16_t)(w.z & 0xffffu); vp[5 * 200] = (bf16_t)(w.z >> 16); vp[6 * 200] = (bf16_t)(w.w & 0xffffu); vp[7 * 200] = (bf16_t)(w.w >> 16); }
    return 8.0f * 1.4426950408889634f * gqmax * gkmax;
}
__device__ __forceinline__ void swa_compute(float M2, int b, int n, int kh, bf16_t* __restrict__ OS, const float* __restrict__ sinks, LAS unsigned char* lds, int tid) {
    asm volatile("" : "+v"(tid));
    const int lane = tid & 63, wave = tid >> 6, fr = lane & 15, fq = lane >> 4;
    LAS bf16_t* Qn = (LAS bf16_t*)(lds + SW_QN); LAS bf16_t* Kn = (LAS bf16_t*)(lds + SW_KN); LAS bf16_t* Vt = (LAS bf16_t*)(lds + SW_VT);
    const int g = wave >> 1, qh = wave & 1;
    const int hh = kh * 4 + g; const float slope = exp2f(-0.5f * (float)(hh + 1)) * 1.4426950408889634f; const float sink = sinks[hh] * 1.4426950408889634f;
    bf16x8 bq[2][2]; float fb[2];
#pragma unroll
    for (int qt = 0; qt < 2; ++qt) { const int qrow = qh * 32 + qt * 16 + fr; fb[qt] = (float)(128 + qrow - 4 * fq);
#pragma unroll
        for (int ks = 0; ks < 2; ++ks) bq[qt][ks] = *(const LAS bf16x8*)(Qn + (g * 64 + qrow) * 72 + ks * 32 + fq * 8); }
    float l[2] = {0.f, 0.f};
    f32x4 oa[4][2];
#pragma unroll
    for (int dt = 0; dt < 4; ++dt)
#pragma unroll
        for (int qt = 0; qt < 2; ++qt) oa[dt][qt] = (f32x4){0.f, 0.f, 0.f, 0.f};
    const int kg0 = n >= 2 ? 0 : 2 - n;
#pragma unroll 1
    for (int kg = kg0; kg < 3; ++kg) {
        float ini[2];
#pragma unroll
        for (int qt = 0; qt < 2; ++qt) ini[qt] = kg < 2 ? -M2 - slope * (fb[qt] - (float)(kg * 64)) : -M2;
        f32x4 sc[4][2];
#pragma unroll
        for (int k4 = 0; k4 < 4; ++k4) { const LAS bf16_t* kr = Kn + (kg * 64 + k4 * 16 + fr) * 72 + fq * 8;
            const bf16x8 ak0 = *(const LAS bf16x8*)(kr), ak1 = *(const LAS bf16x8*)(kr + 32);
#pragma unroll
            for (int qt = 0; qt < 2; ++qt) { f32x4 a = (f32x4){ini[qt], ini[qt], ini[qt], ini[qt]}; a = MFMA16(ak0, bq[qt][0], a); a = MFMA16(ak1, bq[qt][1], a); sc[k4][qt] = a; } }
        if (kg < 2) {
#pragma unroll
            for (int k4 = 0; k4 < 4; ++k4)
#pragma unroll
                for (int qt = 0; qt < 2; ++qt)
#pragma unroll
                    for (int i = 0; i < 4; ++i) sc[k4][qt][i] = fmaf(slope, (float)(k4 * 16 + i), sc[k4][qt][i]);
        } else {
#pragma unroll
            for (int k4 = 0; k4 < 4; ++k4)
#pragma unroll
                for (int qt = 0; qt < 2; ++qt)
#pragma unroll
                    for (int i = 0; i < 4; ++i) sc[k4][qt][i] = sc[k4][qt][i] - slope * fabsf((fb[qt] - 128.0f) - (float)(k4 * 16 + i));
        }
#pragma unroll
        for (int k4 = 0; k4 < 4; ++k4)
#pragma unroll
            for (int qt = 0; qt < 2; ++qt)
#pragma unroll
                for (int i = 0; i < 4; ++i) { const float p = __builtin_amdgcn_exp2f(sc[k4][qt][i]); sc[k4][qt][i] = p; l[qt] += p; }
#pragma unroll
        for (int s2 = 0; s2 < 2; ++s2) {
            bf16x8 bp[2];
#pragma unroll
            for (int qt = 0; qt < 2; ++qt) { u32x4 pw; pw.x = pk2v(sc[2 * s2][qt][0], sc[2 * s2][qt][1]); pw.y = pk2v(sc[2 * s2][qt][2], sc[2 * s2][qt][3]);
                pw.z = pk2v(sc[2 * s2 + 1][qt][0], sc[2 * s2 + 1][qt][1]); pw.w = pk2v(sc[2 * s2 + 1][qt][2], sc[2 * s2 + 1][qt][3]); bp[qt] = __builtin_bit_cast(bf16x8, pw); }
#pragma unroll
            for (int dt = 0; dt < 4; ++dt) { const int d = dt * 16 + fr, swz = ((d >> 3) & 7) << 3; const LAS bf16_t* vr = Vt + d * 200; const int j0 = kg * 64 + 32 * s2 + 4 * fq;
                const u32x2 lo = *(const LAS u32x2*)(vr + (j0 ^ swz)), hi = *(const LAS u32x2*)(vr + ((j0 + 16) ^ swz));
                u32x4 w; w.x = lo.x; w.y = lo.y; w.z = hi.x; w.w = hi.y; const bf16x8 av = __builtin_bit_cast(bf16x8, w);
#pragma unroll
                for (int qt = 0; qt < 2; ++qt) oa[dt][qt] = MFMA16(av, bp[qt], oa[dt][qt]); }
        }
    }
    const float esink = __builtin_amdgcn_exp2f(sink - M2);
#pragma unroll
    for (int qt = 0; qt < 2; ++qt) { float ls = l[qt]; ls += __shfl_xor(ls, 16); ls += __shfl_xor(ls, 32); const float inv = __builtin_amdgcn_rcpf(ls + esink);
        LAS bf16_t* op = (LAS bf16_t*)(lds + SW_OT) + (qh * 32 + qt * 16 + fr) * 264 + g * 64 + 4 * fq;
#pragma unroll
        for (int dt = 0; dt < 4; ++dt) { const f32x4 v = oa[dt][qt] * inv; u32x2 w; w.x = pk2(v[0], v[1]); w.y = pk2(v[2], v[3]); *(LAS u32x2*)(op + dt * 16) = w; } }
}
__device__ __forceinline__ void swa_store(int b, int n, int kh, bf16_t* __restrict__ OS, LAS unsigned char* lds, int tid) {
    asm volatile("" : "+v"(tid));
    const LAS bf16_t* OT = (const LAS bf16_t*)(lds + SW_OT);
    bf16_t* ob = OS + ((size_t)b * SEQ_T + (size_t)n * 64) * 1024 + kh * 256;
#pragma unroll
    for (int i = 0; i < 4; ++i) { const unsigned o = (unsigned)tid + 512u * i, t = o >> 5, oc = o & 31u; *(u32x4*)(ob + (t * 1024u + oc * 8u)) = *(const LAS u32x4*)(OT + t * 264u + oc * 8u); }
}

constexpr int GL_CUM = 0, GL_QD = 34816, GL_KD = 52224, GL_KT = 69632, GL_VT = 88064, GL_P = 124928, GL_SSQ = 134144, GL_DEC = 136192, GL_QT = 137216, GL_ALR = 139264, GL_END = 143360;
static_assert(GL_END <= LDS_BYTES, "GLA LDS map");
constexpr int GLA_NSEG = 8, GLA_SEGC = 64 / GLA_NSEG;
template <bool FULL>
__device__ __forceinline__ void gla_seg(int b, int h, int seg, const bf16_t* __restrict__ QK, const bf16_t* __restrict__ GV, const bf16_t* __restrict__ GG, const float* __restrict__ ALR,
                                        const float* __restrict__ w2, const float* __restrict__ balpha, const float* __restrict__ gnorm, bf16_t* __restrict__ OG,
                                        float* __restrict__ Lws, float* __restrict__ Dws, LAS unsigned char* lds, int tid) {
    asm volatile("" : "+v"(tid));
    const int lane = tid & 63, wave = tid >> 6, fr = lane & 15, fq = lane >> 4;
    LAS float* CUM = (LAS float*)(lds + GL_CUM); LAS bf16_t* OB = (LAS bf16_t*)(lds + GL_QD);
    LAS bf16_t* QD = (LAS bf16_t*)(lds + GL_QD); LAS bf16_t* KD = (LAS bf16_t*)(lds + GL_KD); LAS bf16_t* KT = (LAS bf16_t*)(lds + GL_KT); LAS bf16_t* VT = (LAS bf16_t*)(lds + GL_VT);
    LAS bf16_t* PB = (LAS bf16_t*)(lds + GL_P); LAS float* SSQ = (LAS float*)(lds + GL_SSQ); LAS float* DEC = (LAS float*)(lds + GL_DEC); LAS float* QT = (LAS float*)(lds + GL_QT);
    LAS float* ALRS = (LAS float*)(lds + GL_ALR);
    const int lt = (lane >> 3) + 8 * wave, lo = lane & 7, lsw = lt ^ (lo << 3);
    const int seq = b * 4 + h;
    f32x4 S[8][2];
#pragma unroll
    for (int a = 0; a < 8; ++a)
#pragma unroll
        for (int c = 0; c < 2; ++c) S[a][c] = (f32x4){0.f, 0.f, 0.f, 0.f};
    if (FULL) {
        const float* Lb0 = Lws + (size_t)(seq * GLA_NSEG) * 32768 + (size_t)wave * 4096 + lane * 4; const float* Db0 = Dws + (seq * GLA_NSEG) * 128;
        f32x4 La[16], Lb[16];
#define GLA_LOADL(DST, J) do { _Pragma("unroll") for (int q_ = 0; q_ < 16; ++q_) DST[q_] = *(const f32x4*)(Lb0 + (size_t)(J) * 32768 + q_ * 256); } while (0)
#define GLA_FOLD(SRC, J) do { _Pragma("unroll") for (int dkt = 0; dkt < 8; ++dkt) { const f32x4 dc = *(const f32x4*)(Db0 + (J) * 128 + dkt * 16 + 4 * fq); \
            _Pragma("unroll") for (int dvt = 0; dvt < 2; ++dvt) S[dkt][dvt] = S[dkt][dvt] * dc + SRC[dkt * 2 + dvt]; } } while (0)
        if (seg > 0) GLA_LOADL(La, 0);
#pragma unroll 1
        for (int j = 0; j < seg; j += 2) {
            if (j + 1 < seg) GLA_LOADL(Lb, j + 1);
            GLA_FOLD(La, j);
            if (j + 1 < seg) { if (j + 2 < seg) GLA_LOADL(La, j + 2); GLA_FOLD(Lb, j + 1); }
        }
#undef GLA_LOADL
#undef GLA_FOLD
    }
    const int dkc = wave * 16 + fr;
    bf16x8 w2f; { float w[8];
#pragma unroll
        for (int j = 0; j < 8; ++j) w[j] = w2[((fq & 1) * 8 + j) * 512 + h * 128 + dkc];
        w2f = __builtin_bit_cast(bf16x8, pack8v(w)); }
    const float bz = balpha[h * 128 + dkc];
    const size_t tokb = (size_t)b * SEQ_T + (size_t)seg * (GLA_SEGC * 64);
    if (tid < 256) *(LAS f32x4*)(ALRS + tid * 4) = *(const f32x4*)(ALR + tokb * 16 + tid * 4);
    float segtot = 0.f;
    u32x4 qw[2], kw[2], vw[4];
#define GLA_LOAD_QKV(T0) do { _Pragma("unroll") for (int i_ = 0; i_ < 2; ++i_) { const int oc_ = lo + 8 * i_; \
            kw[i_] = *(const u32x4*)(QK + ((T0) + lt) * 1024 + 512 + h * 128 + oc_ * 8); } \
        _Pragma("unroll") for (int i_ = 0; i_ < 4; ++i_) { const int oc_ = lo + 8 * i_; vw[i_] = *(const u32x4*)(GV + ((T0) + lt) * 1024 + h * 256 + oc_ * 8); } } while (0)
    __syncthreads();
#pragma unroll 1
    for (int c = 0; c < GLA_SEGC; ++c) {
        const size_t tok0 = tokb + (size_t)c * 64;
        GLA_LOAD_QKV(tok0);
        if (FULL) {
#pragma unroll
            for (int i = 0; i < 2; ++i) qw[i] = *(const u32x4*)(QK + (tok0 + lt) * 1024 + h * 128 + (lo + 8 * i) * 8); }
        {
            float carry = 0.f;
#pragma unroll
            for (int tt = 0; tt < 4; ++tt) {
                const LAS f32x4* ar = (const LAS f32x4*)(ALRS + (tt * 16 + fr) * 16 + (fq & 1) * 8); const f32x4 x0 = ar[0], x1 = ar[1];
                float x[8] = {x0.x, x0.y, x0.z, x0.w, x1.x, x1.y, x1.z, x1.w}, xh[8];
                unpack8(pack8v(x), xh);
                if (fq >= 2) {
#pragma unroll
                    for (int e = 0; e < 8; ++e) x[e] -= xh[e];
                }
                const bf16x8 af = __builtin_bit_cast(bf16x8, pack8v(x));
                const f32x4 z4 = MFMA16(af, w2f, ((f32x4){0.f, 0.f, 0.f, 0.f}));
                float v[4];
#pragma unroll
                for (int i = 0; i < 4; ++i) { const float z = z4[i] + bz;
                    v[i] = (fminf(z, 0.f) - 0.6931471805599453f * __builtin_amdgcn_logf(1.0f + __builtin_amdgcn_exp2f(-1.4426950408889634f * fabsf(z)))) * (1.0f / 16.0f); }
                v[1] += v[0]; v[2] += v[1]; v[3] += v[2];
                const float tot4 = v[3];
                const float p1 = __shfl_up(tot4, 16); float sc = tot4 + (fq >= 1 ? p1 : 0.f);
                const float p2 = __shfl_up(sc, 32); sc += (fq >= 2 ? p2 : 0.f);
                const float base = carry + (sc - tot4);
#pragma unroll
                for (int i = 0; i < 4; ++i) CUM[(tt * 16 + 4 * fq + i) * 132 + dkc] = v[i] + base;
                carry += __shfl(sc, 48 + fr);
            }
            if (fq == 0) DEC[dkc] = __builtin_amdgcn_exp2f(1.4426950408889634f * carry);
            segtot += carry;
        }
        __syncthreads();
        if (c + 1 < GLA_SEGC && tid < 256) *(LAS f32x4*)(ALRS + tid * 4) = *(const f32x4*)(ALR + (tok0 + 64) * 16 + tid * 4);
#pragma unroll
        for (int i = 0; i < 2; ++i) { const int oc = lo + 8 * i, t = lt;
            float k8[8]; unpack8(kw[i], k8);
            const f32x4 c0 = *(const LAS f32x4*)(CUM + t * 132 + oc * 8), c1 = *(const LAS f32x4*)(CUM + t * 132 + oc * 8 + 4);
            const f32x4 d0 = *(const LAS f32x4*)(DEC + oc * 8), d1 = *(const LAS f32x4*)(DEC + oc * 8 + 4);
            const float cm[8] = {c0.x, c0.y, c0.z, c0.w, c1.x, c1.y, c1.z, c1.w}; const float dc[8] = {d0.x, d0.y, d0.z, d0.w, d1.x, d1.y, d1.z, d1.w};
            float kd[8], ke[8];
#pragma unroll
            for (int e = 0; e < 8; ++e) { const float em = __builtin_amdgcn_exp2f(-1.4426950408889634f * cm[e]); kd[e] = k8[e] * em; ke[e] = kd[e] * dc[e]; }
            if (FULL) { float q8[8], qd[8]; unpack8(qw[i], q8);
#pragma unroll
                for (int e = 0; e < 8; ++e) qd[e] = q8[e] * __builtin_amdgcn_exp2f(1.4426950408889634f * cm[e]) * 0.08838834764831845f;
                *(LAS u32x4*)(QD + t * 136 + oc * 8) = pack8(qd); *(LAS u32x4*)(KD + t * 136 + oc * 8) = pack8(kd); }
            const u32x4 kp8 = pack8(ke); LAS bf16_t* kp = KT + (oc * 8) * 72 + lsw;
            kp[0 * 72] = (bf16_t)(kp8.x & 0xffffu); kp[1 * 72] = (bf16_t)(kp8.x >> 16); kp[2 * 72] = (bf16_t)(kp8.y & 0xffffu); kp[3 * 72] = (bf16_t)(kp8.y >> 16);
            kp[4 * 72] = (bf16_t)(kp8.z & 0xffffu); kp[5 * 72] = (bf16_t)(kp8.z >> 16); kp[6 * 72] = (bf16_t)(kp8.w & 0xffffu); kp[7 * 72] = (bf16_t)(kp8.w >> 16); }
#pragma unroll
        for (int i = 0; i < 4; ++i) { const int oc = lo + 8 * i; const u32x4 w = vw[i]; LAS bf16_t* vp = VT + (oc * 8) * 72 + lsw;
            vp[0 * 72] = (bf16_t)(w.x & 0xffffu); vp[1 * 72] = (bf16_t)(w.x >> 16); vp[2 * 72] = (bf16_t)(w.y & 0xffffu); vp[3 * 72] = (bf16_t)(w.y >> 16);
            vp[4 * 72] = (bf16_t)(w.z & 0xffffu); vp[5 * 72] = (bf16_t)(w.z >> 16); vp[6 * 72] = (bf16_t)(w.w & 0xffffu); vp[7 * 72] = (bf16_t)(w.w >> 16); }
        __syncthreads();
        f32x4 o[4][2];
        u32x4 gw[4];
        if (FULL) {
            {
                const int tt = wave >> 1;
#pragma unroll
                for (int u2 = 0; u2 < 2; ++u2) { const int st = (wave & 1) * 2 + u2; f32x4 a = (f32x4){0.f, 0.f, 0.f, 0.f};
                    if (st <= tt) {
#pragma unroll
                        for (int ks = 0; ks < 4; ++ks) { const bf16x8 ak = *(const LAS bf16x8*)(KD + (st * 16 + fr) * 136 + ks * 32 + fq * 8), bq = *(const LAS bf16x8*)(QD + (tt * 16 + fr) * 136 + ks * 32 + fq * 8);
                            a = MFMA16(ak, bq, a); }
                    }
                    const int t = tt * 16 + fr, s0 = st * 16 + 4 * fq;
                    const float p0 = (s0 + 0 <= t) ? a[0] : 0.f, p1 = (s0 + 1 <= t) ? a[1] : 0.f, p2 = (s0 + 2 <= t) ? a[2] : 0.f, p3 = (s0 + 3 <= t) ? a[3] : 0.f;
                    u32x2 w; w.x = pk2(p0, p1); w.y = pk2(p2, p3); *(LAS u32x2*)(PB + t * 72 + s0) = w; }
            }
#pragma unroll
            for (int a = 0; a < 4; ++a)
#pragma unroll
                for (int d = 0; d < 2; ++d) o[a][d] = (f32x4){0.f, 0.f, 0.f, 0.f};
#pragma unroll
            for (int ks = 0; ks < 4; ++ks) {
                bf16x8 bs[2];
#pragma unroll
                for (int dvt = 0; dvt < 2; ++dvt) { u32x4 w; w.x = pk2v(S[2 * ks][dvt][0], S[2 * ks][dvt][1]); w.y = pk2v(S[2 * ks][dvt][2], S[2 * ks][dvt][3]);
                    w.z = pk2v(S[2 * ks + 1][dvt][0], S[2 * ks + 1][dvt][1]); w.w = pk2v(S[2 * ks + 1][dvt][2], S[2 * ks + 1][dvt][3]); bs[dvt] = __builtin_bit_cast(bf16x8, w); }
#pragma unroll
                for (int tt = 0; tt < 4; ++tt) { const LAS bf16_t* qp = QD + (tt * 16 + fr) * 136 + 32 * ks + 4 * fq;
                    const u32x2 lo = *(const LAS u32x2*)(qp), hi = *(const LAS u32x2*)(qp + 16);
                    u32x4 w; w.x = lo.x; w.y = lo.y; w.z = hi.x; w.w = hi.y; const bf16x8 aq = __builtin_bit_cast(bf16x8, w);
#pragma unroll
                    for (int dvt = 0; dvt < 2; ++dvt) o[tt][dvt] = MFMA16(aq, bs[dvt], o[tt][dvt]); }
            }
        }
        bf16x8 bv[2][2];
#pragma unroll
        for (int dvt = 0; dvt < 2; ++dvt)
#pragma unroll
            for (int ks = 0; ks < 2; ++ks) { const int dv = wave * 32 + dvt * 16 + fr; bv[dvt][ks] = *(const LAS bf16x8*)(VT + dv * 72 + ((ks * 32 + fq * 8) ^ (((dv >> 3) & 7) << 3))); }
#pragma unroll
        for (int dkt = 0; dkt < 8; ++dkt) { const f32x4 dc = *(const LAS f32x4*)(DEC + dkt * 16 + 4 * fq);
#pragma unroll
            for (int dvt = 0; dvt < 2; ++dvt) S[dkt][dvt] = S[dkt][dvt] * dc;
#pragma unroll
            for (int ks = 0; ks < 2; ++ks) { const int dkr = dkt * 16 + fr; const bf16x8 ak = *(const LAS bf16x8*)(KT + dkr * 72 + ((ks * 32 + fq * 8) ^ (((dkr >> 3) & 7) << 3)));
#pragma unroll
                for (int dvt = 0; dvt < 2; ++dvt) S[dkt][dvt] = MFMA16(ak, bv[dvt][ks], S[dkt][dvt]); } }
        if (FULL) {
#pragma unroll
            for (int i = 0; i < 4; ++i) { const int oid = tid + 512 * i, t = oid >> 5, oc = oid & 31; gw[i] = *(const u32x4*)(GG + (tok0 + t) * 1024 + h * 256 + oc * 8); }
        }
        __syncthreads();
        if (FULL) {
#pragma unroll
            for (int ks = 0; ks < 2; ++ks)
#pragma unroll
                for (int tt = 0; tt < 4; ++tt) { if (ks == 1 && tt < 2) continue;
                    const bf16x8 ap = *(const LAS bf16x8*)(PB + (tt * 16 + fr) * 72 + ks * 32 + fq * 8);
#pragma unroll
                    for (int dvt = 0; dvt < 2; ++dvt) o[tt][dvt] = MFMA16(ap, bv[dvt][ks], o[tt][dvt]); }
#pragma unroll
            for (int tt = 0; tt < 4; ++tt)
#pragma unroll
                for (int i = 0; i < 4; ++i) { const int t = tt * 16 + 4 * fq + i; const float v0 = o[tt][0][i], v1 = o[tt][1][i];
                    const unsigned w = pk2(v0, v1);
                    OB[t * 272 + wave * 32 + fr] = (bf16_t)(w & 0xffffu); OB[t * 272 + wave * 32 + 16 + fr] = (bf16_t)(w >> 16);
                    const float q = sum16_dpp(v0 * v0 + v1 * v1);
                    if (fr == 0) SSQ[wave * 64 + t] = q; }
            __syncthreads();
#pragma unroll
            for (int i = 0; i < 4; ++i) { const int oid = tid + 512 * i, t = oid >> 5, oc = oid & 31;
                float ss = 0.f;
#pragma unroll
                for (int w = 0; w < 8; ++w) ss += SSQ[w * 64 + t];
                const float rs = __builtin_amdgcn_rsqf(ss * (1.0f / 256.0f) + 1e-6f);
                float ov[8], gv[8]; unpack8(*(const LAS u32x4*)(OB + t * 272 + oc * 8), ov); unpack8(gw[i], gv);
                const f32x4 n0 = *(const f32x4*)(gnorm + oc * 8), n1 = *(const f32x4*)(gnorm + oc * 8 + 4); const float gn[8] = {n0.x, n0.y, n0.z, n0.w, n1.x, n1.y, n1.z, n1.w};
#pragma unroll
                for (int e = 0; e < 8; ++e) ov[e] = ov[e] * rs * gn[e] * gv[e];
                *(u32x4*)(OG + (tok0 + t) * 1024 + h * 256 + oc * 8) = pack8(ov); }
        }
    }
    if (!FULL) {
        float* Lj = Lws + (size_t)(seq * GLA_NSEG + seg) * 32768 + (size_t)wave * 4096 + lane * 4;
#pragma unroll
        for (int dkt = 0; dkt < 8; ++dkt)
#pragma unroll
            for (int dvt = 0; dvt < 2; ++dvt) *(f32x4*)(Lj + (dkt * 2 + dvt) * 256) = S[dkt][dvt];
        if (fq == 0) Dws[(seq * GLA_NSEG + seg) * 128 + dkc] = __builtin_amdgcn_exp2f(1.4426950408889634f * segtot);
    }
#undef GLA_LOAD_QKV
}

#define XB_TMO      128
#define XB_XCNT(j)  (256  + 64 * (j))
#define XB_XSUB(j)  (1280 + 64 * (j))
#define XB_XGEN(j)  (2304 + 64 * (j))
#define XB_TOP      3328
#define XB_TOPGEN   3392
#define XCD_BAR_WORDS 3456
#define XB_SPIN_CAP (1u << 18)

__device__ __forceinline__ unsigned xb_ld(unsigned* p)              { return __hip_atomic_load(p, __ATOMIC_RELAXED, __HIP_MEMORY_SCOPE_AGENT); }
__device__ __forceinline__ unsigned xb_add(unsigned* p, unsigned v) { return __hip_atomic_fetch_add(p, v, __ATOMIC_RELAXED, __HIP_MEMORY_SCOPE_AGENT); }
__device__ __forceinline__ unsigned xb_xcc_id() { return (unsigned)__builtin_amdgcn_s_getreg((3 << 11) | 20) & 0xFu; }
#define XB_SPIN(cond, bar) do { unsigned _sp = 0; while (cond) { __builtin_amdgcn_s_sleep(1); \
    if ((++_sp & 255u) == 0u) { if (xb_ld(&(bar)[XB_TMO])) break; if (_sp > XB_SPIN_CAP) { atomicAdd(&(bar)[XB_TMO], 1u); break; } } } } while (0)

struct XcdBarrier {
    unsigned* bar; unsigned x;
    volatile LAS unsigned* st;
};

__device__ __forceinline__ XcdBarrier xcd_barrier_post(unsigned* bar, volatile LAS unsigned* st) {
    XcdBarrier b; b.bar = bar; b.x = xb_xcc_id(); b.st = st;
    if (threadIdx.x == 0) (void)xb_add(&bar[XB_XCNT(b.x)], 1u);
    return b;
}
__device__ __forceinline__ void xcd_barrier_complete(unsigned* bar, unsigned x, unsigned& nloc, unsigned& nx) {
    const unsigned G = gridDim.x * gridDim.y * gridDim.z;
    unsigned sum, cnt, mine, sp = 0u;
    for (;;) {
        sum = 0u; cnt = 0u; mine = 0u;
#pragma unroll
        for (unsigned j = 0; j < 16; ++j) { const unsigned c = xb_ld(&bar[XB_XCNT(j)]); sum += c; cnt += (c > 0u) ? 1u : 0u; mine = (j == x) ? c : mine; }
        if (sum == G) break;
        __builtin_amdgcn_s_sleep(1);
        if ((++sp & 255u) == 0u) { if (xb_ld(&bar[XB_TMO])) break; if (sp > XB_SPIN_CAP) { atomicAdd(&bar[XB_TMO], 1u); break; } }
    }
    nloc = mine > 0u ? mine : 1u; nx = cnt > 0u ? cnt : 1u;
}

__device__ __forceinline__ void xcd_barrier(const XcdBarrier& b) {
    asm volatile("s_waitcnt vmcnt(0)" ::: "memory");
    __syncthreads();
    if (threadIdx.x == 0) {
        unsigned* bar = b.bar;
        __builtin_amdgcn_s_waitcnt(0);
        unsigned nloc = b.st[0], nx = b.st[1];
        if (nloc == 0u) { xcd_barrier_complete(bar, b.x, nloc, nx); b.st[0] = nloc; b.st[1] = nx; }
        const unsigned old = xb_add(&bar[XB_XSUB(b.x)], 1u);
        const unsigned gen = old / nloc;
        if (old + 1u == (gen + 1u) * nloc) {
            __builtin_amdgcn_fence(__ATOMIC_RELEASE, "agent");
            asm volatile("s_waitcnt vmcnt(0)" ::: "memory");
            const unsigned og = xb_add(&bar[XB_TOP], 1u);
            const unsigned tg = og / nx;
            if (og + 1u == (tg + 1u) * nx) xb_add(&bar[XB_TOPGEN], 1u);
            else XB_SPIN(xb_ld(&bar[XB_TOPGEN]) == tg, bar);
            __builtin_amdgcn_fence(__ATOMIC_ACQUIRE, "agent");
            xb_add(&bar[XB_XGEN(b.x)], 1u);
            asm volatile("s_waitcnt vmcnt(0)" ::: "memory");
        } else {
            XB_SPIN(xb_ld(&bar[XB_XGEN(b.x)]) == gen, bar);
            __builtin_amdgcn_fence(__ATOMIC_ACQUIRE, "agent");
            asm volatile("s_waitcnt vmcnt(0)" ::: "memory");
        }
    }
    __syncthreads();
}


struct Args { const float* in[15]; float* out; unsigned char* ws; };
__global__ void __launch_bounds__(512) mk_fwd(Args a) {
    extern __shared__ __attribute__((aligned(16))) unsigned char lds_raw[];
    cg::grid_group grid = cg::this_grid();
    LAS unsigned char* lds = (LAS unsigned char*)lds_raw;
    const int tid = threadIdx.x, G = gridDim.x, blk = blockIdx.x;
    Ptrs P; P.x = a.in[0]; P.norm_mix = a.in[1]; P.w_in = a.in[2]; P.w_alpha2 = a.in[3]; P.b_alpha = a.in[4]; P.gla_norm = a.in[5]; P.swa_qn = a.in[6]; P.swa_kn = a.in[7]; P.sinks = a.in[8];
    P.w_bg = a.in[9]; P.w_bs = a.in[10]; P.w_out = a.in[11]; P.norm_mlp = a.in[12]; P.w_up = a.in[13]; P.w_down = a.in[14]; P.out = a.out; P.ws = a.ws;
    unsigned char* ws = a.ws;
    bf16_t* OGLA = (bf16_t*)a.out; bf16_t* OSWA = (bf16_t*)a.out + (size_t)M_TOK * 1024;
    float* SSQ = (float*)(ws + WS_SSQ); float* ALR = (float*)(ws + WS_ALR);

    volatile LAS unsigned* xst = (volatile LAS unsigned*)(lds + LDS_BYTES - 16);
    if (tid < 4) xst[tid] = 0u;
    __syncthreads();
    const XcdBarrier xbar = xcd_barrier_post((unsigned*)(ws + WS_BAR), xst);
    const bool use_cg = G > 1024;
#define GRID_BAR() xcd_barrier(xbar)
    if (PH_MASK & 1) for (int rep = 0; rep < REP_P0; ++rep) p0_prologue(P, lds, tid, G, blk);
    if (use_cg) grid.sync(); else xcd_barrier(xbar);
    if (PH_MASK & 2) {
        pg8::Gemm g{(const bf16_t*)a.out, (const bf16_t*)(ws + WS_WIN), M_TOK, NPROJ, 1024}; pg8::StaticOrder S; S.init(M_TOK, NPROJ, G, blk);
        pg8::EpiProj E{ws};
        for (int rep = 0; rep < REP_P1; ++rep)
        pg8::gemm_phase<pg8::EpiProj, pg8::StaticOrder, true, true>(lds, g, S, E);
    }
    GRID_BAR();
    {
        const bf16_t* QKp = (const bf16_t*)(ws + WS_QK); const bf16_t* GVp = (const bf16_t*)(ws + WS_GV); const bf16_t* GGp = (const bf16_t*)(ws + WS_GG);
        float* Lws = (float*)(ws + WS_GLAL); float* Dws = (float*)(ws + WS_GLAD);
        constexpr int NA = 32 * (GLA_NSEG - 1);
        for (int rep = 0; rep < REP_P2A; ++rep) {
        for (int rpa = 0; rpa < REP_PA; ++rpa)
        if (PH_MASK & 64) for (int it = blk; it < NA; it += G) { const int seq = it / (GLA_NSEG - 1), seg = it % (GLA_NSEG - 1);
            gla_seg<false>(seq >> 2, seq & 3, seg, QKp, GVp, GGp, ALR, P.w_alpha2, P.b_alpha, P.gla_norm, OGLA, Lws, Dws, lds, tid); }
        for (int rsw = 0; rsw < REP_SWA; ++rsw)
        if (PH_MASK & 128) {
            int u0, u1, ustep;
            if (G == 256) { if (blk >= NA) { u0 = (blk - NA) * 12; u1 = u0 + 12; } else if (blk < 96) { u0 = 384 + blk * 8; u1 = u0 + 8; } else { u0 = 1152 + (blk - 96) * 7; u1 = u0 + 7; } ustep = 1; }
            else { u0 = blk; u1 = 2048; ustep = G; }
            int tl = tid; asm volatile("" : "+v"(tl));
            const bf16_t* SQp = (const bf16_t*)(ws + WS_SQ); const bf16_t* SKVp = (const bf16_t*)(ws + WS_SKV);
            SwaRegs R;
            if (u0 < u1) swa_load(R, u0 >> 8, u0 & 63, (u0 >> 6) & 3, SQp, SKVp, tl);
#pragma unroll 1
            for (int u = u0; u < u1; u += ustep) { const int n = u & 63, kh = (u >> 6) & 3, b = u >> 8;
                const float M2 = swa_stage(R, P.swa_qn, P.swa_kn, lds, tl);
                __syncthreads();
                const int un = u + ustep;
                if (un < u1) swa_load(R, un >> 8, un & 63, (un >> 6) & 3, SQp, SKVp, tl);
                swa_compute(M2, b, n, kh, OSWA, P.sinks, lds, tl);
                __syncthreads();
                swa_store(b, n, kh, OSWA, lds, tl); }
            if (G == 256 && blk >= 96 && blk < NA && rsw == 0) {
                __syncthreads();
                const int wv = tl >> 6; LAS float* scr = (LAS float*)(lds + wv * 12288);
                for (int q = wv; q < 44; q += 8) transpose_rest_item(P, (blk - 96) * 44 + q, scr, tl & 63);
            }
        }
        }
        GRID_BAR();
        for (int rep = 0; rep < REP_P2B; ++rep)
        if (PH_MASK & 64) for (int it = blk; it < 32 * GLA_NSEG; it += G) { const int seq = it / GLA_NSEG, seg = it % GLA_NSEG;
            gla_seg<true>(seq >> 2, seq & 3, seg, QKp, GVp, GGp, ALR, P.w_alpha2, P.b_alpha, P.gla_norm, OGLA, Lws, Dws, lds, tid); }
    }
    GRID_BAR();
    if (PH_MASK & 8) {
        static_assert(WS_WBS == WS_WBG + (size_t)1024 * 1024 * 2, "Wbg^T and Wbs^T are one [2048][1024] matrix");
        pg8::PairOrder S; S.init(M_TOK, 1024, G, blk);
        pg8::Gemm g{OGLA, (const bf16_t*)(ws + WS_WBG), 2 * M_TOK, 2048, 1024};
        pg8::EpiGatePair E{{(const bf16_t*)(ws + WS_GA), (bf16_t*)(ws + WS_MERGED)}, {(const bf16_t*)(ws + WS_GB), (bf16_t*)(ws + WS_MERGED)}};
        pg8::gemm_phase<pg8::EpiGatePair, pg8::PairOrder, true, true>(lds, g, S, E);
    }
    GRID_BAR();
    if (PH_MASK & 16) {
        pg8::Gemm g{(const bf16_t*)(ws + WS_MERGED), (const bf16_t*)(ws + WS_WOUT), M_TOK, 1024, 1024}; pg8::StaticOrder S; S.init(M_TOK, 1024, G, blk);
        pg8::EpiRes E{P.x, (bf16_t*)(ws + WS_H1B), SSQ};
        pg8::gemm_phase<pg8::EpiRes, pg8::StaticOrder, true, true>(lds, g, S, E);
    }
    GRID_BAR();
    if (PH_MASK & 32) {
        pg8::Gemm g{(const bf16_t*)(ws + WS_H1B), (const bf16_t*)(ws + WS_WUP), M_TOK, DFF, 1024}; pg8::StaticOrder S; S.init(M_TOK, DFF, G, blk);
        pg8::EpiUp E{SSQ, (bf16_t*)(ws + WS_U)};
        pg8::gemm_phase<pg8::EpiUp, pg8::StaticOrder, true, true>(lds, g, S, E);
    }
    GRID_BAR();
    if (PH_MASK & 256) {
        pg8::Gemm g{(const bf16_t*)(ws + WS_U), (const bf16_t*)(ws + WS_WDN), M_TOK, 1024, DFF}; pg8::StaticOrder S; S.init(M_TOK, 1024, G, blk);
        pg8::EpiDown E{(const bf16_t*)(ws + WS_H1B), a.out};
        pg8::gemm_phase<pg8::EpiDown, pg8::StaticOrder, true, true>(lds, g, S, E);
    }
}

extern "C" void kernel_launch(void* const* d_in, const int* in_sizes, int n_in, void* d_out, int out_size, void* d_ws, size_t ws_size, hipStream_t stream) {
    static int grid = 0;
    if (grid == 0) {
        if (n_in != 15 || out_size != M_TOK * DM || ws_size < WS_END) { fprintf(stderr, "kernel_launch: unexpected shapes (n_in %d out %d ws %zu)\n", n_in, out_size, ws_size); grid = -1; return; }
        int dev = 0, cus = 0, per_cu = 0;
        hipGetDevice(&dev); hipDeviceGetAttribute(&cus, hipDeviceAttributeMultiprocessorCount, dev);
        if (hipFuncSetAttribute((const void*)mk_fwd, hipFuncAttributeMaxDynamicSharedMemorySize, LDS_BYTES) != hipSuccess) { fprintf(stderr, "kernel_launch: hipFuncSetAttribute failed\n"); grid = -1; return; }
        if (hipOccupancyMaxActiveBlocksPerMultiprocessor(&per_cu, (const void*)mk_fwd, 512, LDS_BYTES) != hipSuccess || per_cu < 1) { fprintf(stderr, "kernel_launch: occupancy query says %d\n", per_cu); per_cu = 1; }
        (void)hipGetLastError();
        grid = cus > 1024 ? 1024 : cus;
        if (grid < 64) { fprintf(stderr, "kernel_launch: only %d CUs\n", cus); grid = -1; return; }
    }
    if (grid < 0) return;
    if (hipMemsetAsync((char*)d_ws + WS_BAR, 0, BAR_BYTES, stream) != hipSuccess) { fprintf(stderr, "kernel_launch: hipMemsetAsync failed\n"); return; }
    Args a{};
    for (int i = 0; i < 15; ++i) a.in[i] = (const float*)d_in[i];
    a.out = (float*)d_out; a.ws = (unsigned char*)d_ws;
    void* args[] = {&a};
    hipError_t e = hipLaunchCooperativeKernel((const void*)mk_fwd, dim3(grid), dim3(512), args, LDS_BYTES, stream);
    if (e != hipSuccess) fprintf(stderr, "kernel_launch: cooperative launch failed: %s (grid %d)\n", hipGetErrorString(e), grid);
}
```

```cpp
#include <hip/hip_runtime.h>
#include <hip/hip_cooperative_groups.h>
#include <cstdio>
#include <cstdint>
namespace cg = cooperative_groups;

constexpr int M_TOK = 32768, DM = 1024, SEQ_T = 4096, NPROJ = 6656, DFF = 4096;
constexpr size_t MiB = 1u << 20;
constexpr size_t WS_SSQ = 0;
constexpr size_t WS_BAR = 1 * MiB, BAR_BYTES = 16384;
constexpr size_t WS_WIN = 2 * MiB, WS_WBG = 16 * MiB, WS_WBS = 18 * MiB, WS_WOUT = 20 * MiB, WS_WUP = 22 * MiB, WS_WDN = 30 * MiB;
constexpr size_t WS_ALR = 38 * MiB;
constexpr size_t WS_QK = 40 * MiB, WS_GV = 104 * MiB, WS_GG = 168 * MiB, WS_SQ = 232 * MiB;
constexpr size_t WS_SKV = 296 * MiB;
constexpr size_t WS_GA = 328 * MiB, WS_GB = 392 * MiB;
constexpr size_t WS_MERGED = 40 * MiB;
constexpr size_t WS_H1B = 104 * MiB;
constexpr size_t WS_U = 168 * MiB;
constexpr size_t WS_GLAL = 456 * MiB, WS_GLAD = 488 * MiB;
constexpr size_t WS_END = 489 * MiB;
constexpr int LDS_BYTES = 147456;
#ifndef REP_P0
#define REP_P0 1
#endif
#ifndef REP_P1
#define REP_P1 1
#endif
#ifndef REP_PA
#define REP_PA 1
#endif
#ifndef REP_SWA
#define REP_SWA 1
#endif
#ifndef REP_P2A
#define REP_P2A 1
#endif
#ifndef REP_P2B
#define REP_P2B 1
#endif
#ifndef PH_MASK
#define PH_MASK 0x1ff
#endif
#define LAS __attribute__((address_space(3)))
namespace pg8 {
#define PG8_LAS __attribute__((address_space(3)))
typedef unsigned short bf16_t;
typedef short bf16x8 __attribute__((ext_vector_type(8)));
typedef float f32x4 __attribute__((ext_vector_type(4)));
typedef unsigned u32x4 __attribute__((ext_vector_type(4)));
constexpr int BM = 256, BK = 64, HALF = 128, HTB = HALF * BK * 2  , STAGE_BYTES = 8 * HTB, NXCD = 8, WGM = 8;

__host__ __device__ __forceinline__ int lds_byte(int r, int c) { const int st = (r >> 4) * 2 + (c >> 5), rr = r & 15, cc = c & 31, ob = rr * 64 + cc * 2; return st * 1024 + (ob ^ (((ob >> 9) & 1) << 5)); }
__host__ __device__ __forceinline__ void stage_rc(int b, int& R, int& C) { const int st = b / 1024, sb = b % 1024, swz = sb ^ (((sb >> 9) & 1) << 5); R = (st >> 1) * 16 + swz / 64; C = (st & 1) * 32 + (swz % 64) / 2; }
__host__ __device__ __forceinline__ int perm32(int rho) { const int n = rho >> 4, i = rho & 15; return 8 * (i >> 2) + 4 * n + (i & 3); }

struct Unit { int pm, pn; };
struct Gemm { const bf16_t* A; const bf16_t* Bt; int M, N, K; };

struct StaticOrder {
    int nM, nN, nwg, G, c;
    __host__ __device__ void init(int M, int N, int G_, int c_) { nM = M / BM; nN = N / BM; nwg = nM * nN; G = G_; c = c_; }
    __host__ __device__ bool next(int i, Unit& u) const {
        const long L = (long)i * G + c; if (L >= nwg) return false;
        int wgid = (int)L; { const int q = nwg / NXCD, r = nwg % NXCD, xcd = wgid % NXCD, off = wgid / NXCD; wgid = (xcd < r ? xcd * (q + 1) : r * (q + 1) + (xcd - r) * q) + off; }
        const int nig = WGM * nN, gid = wgid / nig, fm = gid * WGM, gsz = (nM - fm) < WGM ? (nM - fm) : WGM;
        u.pm = fm + ((wgid % nig) % gsz); u.pn = (wgid % nig) / gsz; return true;
    }
    __device__ __forceinline__ void a_ready(const Unit&) const {}
    __device__ __forceinline__ void done(const Unit&) const {}
};
__device__ __forceinline__ unsigned cvt_pk_bf16(float lo, float hi) { unsigned r; asm volatile("v_cvt_pk_bf16_f32 %0, %1, %2" : "=v"(r) : "v"(lo), "v"(hi)); return r; }
typedef float f32x2c __attribute__((ext_vector_type(2))); typedef __bf16 bf16x2c __attribute__((ext_vector_type(2)));
__device__ __forceinline__ unsigned cvt_pk_bf16_v(float lo, float hi) { const f32x2c v = {lo, hi}; const bf16x2c b = __builtin_convertvector(v, bf16x2c); return __builtin_bit_cast(unsigned, b); }
__device__ __forceinline__ float bflo(unsigned w) { return __uint_as_float(w << 16); }
__device__ __forceinline__ float bfhi(unsigned w) { return __uint_as_float(w & 0xffff0000u); }
__device__ __forceinline__ void unpack8(const u32x4 w, float (&f)[8]) { f[0] = bflo(w.x); f[1] = bfhi(w.x); f[2] = bflo(w.y); f[3] = bfhi(w.y); f[4] = bflo(w.z); f[5] = bfhi(w.z); f[6] = bflo(w.w); f[7] = bfhi(w.w); }
__device__ __forceinline__ u32x4 pack8(const float (&f)[8]) { u32x4 w; w.x = cvt_pk_bf16(f[0], f[1]); w.y = cvt_pk_bf16(f[2], f[3]); w.z = cvt_pk_bf16(f[4], f[5]); w.w = cvt_pk_bf16(f[6], f[7]); return w; }
__device__ __forceinline__ float sigm(float x) { return __builtin_amdgcn_rcpf(1.f + __builtin_amdgcn_exp2f(-1.4426950408889634f * x)); }

struct EpiProj {
    static constexpr bool PERM = true, AFTER_DRAIN = false;
    unsigned char* ws;
    __device__ __forceinline__ void operator()(const f32x4 (&acc)[2][2][4][2], const Unit& u, int wr, int wc, int fr, int fq) const {
        const int pn = u.pn; const int row0 = u.pm * BM + wr * 64 + fr;
        size_t off; int ldc = 1024, colt, act = 0;
        if (pn < 16) { off = WS_QK + (size_t)(pn >> 2) * (64 * MiB); colt = (pn & 3) * 256; if ((pn >> 2) == 2) act = 2; }
        else if (pn < 18) { off = WS_SKV; ldc = 512; colt = (pn - 16) * 256; }
        else if (pn < 22) { off = WS_GA; colt = (pn - 18) * 256; act = 1; }
        else { off = WS_GB; colt = (pn - 22) * 256; act = 1; }
        bf16_t* base = (bf16_t*)(ws + off);
        const int col0 = colt + wc * 32 + 8 * fq;
#pragma unroll
        for (int ai = 0; ai < 2; ++ai)
#pragma unroll
            for (int m = 0; m < 4; ++m) { bf16_t* rowp = base + (size_t)(row0 + ai * HALF + m * 16) * ldc + col0;
#pragma unroll
                for (int bj = 0; bj < 2; ++bj) { const f32x4 v0 = acc[ai][bj][m][0], v1 = acc[ai][bj][m][1];
                    float f[8] = {v0[0], v0[1], v0[2], v0[3], v1[0], v1[1], v1[2], v1[3]};
                    if (act == 1) {
#pragma unroll
                        for (int e = 0; e < 8; ++e) f[e] = sigm(f[e]);
                    } else if (act == 2) {
#pragma unroll
                        for (int e = 0; e < 8; ++e) f[e] = f[e] * sigm(f[e]);
                    }
                    *(u32x4*)(rowp + bj * HALF) = pack8(f); } }
    }
};
template <bool FIRST> struct EpiGate {
    static constexpr bool PERM = true, AFTER_DRAIN = false;
    const bf16_t* gate; bf16_t* merged;
    __device__ __forceinline__ void operator()(const f32x4 (&acc)[2][2][4][2], const Unit& u, int wr, int wc, int fr, int fq) const {
        const int row0 = u.pm * BM + wr * 64 + fr, col0 = u.pn * BM + wc * 32 + 8 * fq;
#pragma unroll
        for (int ai = 0; ai < 2; ++ai)
#pragma unroll
            for (int m = 0; m < 4; ++m) { const size_t idx = (size_t)(row0 + ai * HALF + m * 16) * 1024 + col0;
#pragma unroll
                for (int bj = 0; bj < 2; ++bj) { const f32x4 v0 = acc[ai][bj][m][0], v1 = acc[ai][bj][m][1];
                    float f[8] = {v0[0], v0[1], v0[2], v0[3], v1[0], v1[1], v1[2], v1[3]}; float g[8];
                    unpack8(*(const u32x4*)(gate + idx + bj * HALF), g);
#pragma unroll
                    for (int e = 0; e < 8; ++e) f[e] *= g[e];
                    if (!FIRST) { float p[8]; unpack8(*(const u32x4*)(merged + idx + bj * HALF), p);
#pragma unroll
                        for (int e = 0; e < 8; ++e) f[e] += p[e]; }
                    *(u32x4*)(merged + idx + bj * HALF) = pack8(f); } }
    }
};
struct PairOrder {
    StaticOrder base;
    __host__ __device__ void init(int M, int N, int G_, int c_) { base.init(M, N, G_, c_); }
    __host__ __device__ bool next(int i, Unit& u) const { Unit v; if (!base.next(i >> 1, v)) return false; u.pm = v.pm + ((i & 1) ? 128 : 0); u.pn = v.pn + ((i & 1) ? 4 : 0); return true; }
    __device__ __forceinline__ void a_ready(const Unit&) const {}
    __device__ __forceinline__ void done(const Unit&) const {}
};
struct EpiGatePair {
    static constexpr bool PERM = true, AFTER_DRAIN = false;
    EpiGate<true> e0; EpiGate<false> e1;
    __device__ __forceinline__ void operator()(const f32x4 (&acc)[2][2][4][2], const Unit& u, int wr, int wc, int fr, int fq) const {
        if (u.pm < 128) e0(acc, u, wr, wc, fr, fq); else { const Unit v{u.pm - 128, u.pn - 4}; e1(acc, v, wr, wc, fr, fq); }
    }
};
struct EpiRes {
    static constexpr bool PERM = true, AFTER_DRAIN = false;
    const float* x; bf16_t* h1b; float* ssq;
    __device__ __forceinline__ void operator()(const f32x4 (&acc)[2][2][4][2], const Unit& u, int wr, int wc, int fr, int fq) const {
        const int row0 = u.pm * BM + wr * 64 + fr, col0 = u.pn * BM + wc * 32 + 8 * fq;
#pragma unroll
        for (int ai = 0; ai < 2; ++ai)
#pragma unroll
            for (int m = 0; m < 4; ++m) { const int row = row0 + ai * HALF + m * 16; const size_t idx = (size_t)row * 1024 + col0; float ss = 0.f;
#pragma unroll
                for (int bj = 0; bj < 2; ++bj) { const f32x4 x0 = __builtin_nontemporal_load((const f32x4*)(x + idx + bj * HALF)), x1 = __builtin_nontemporal_load((const f32x4*)(x + idx + bj * HALF + 4));
                    const f32x4 h0 = x0 + acc[ai][bj][m][0], h1v = x1 + acc[ai][bj][m][1];
                    float f[8] = {h0[0], h0[1], h0[2], h0[3], h1v[0], h1v[1], h1v[2], h1v[3]};
#pragma unroll
                    for (int e = 0; e < 8; ++e) ss += f[e] * f[e];
                    *(u32x4*)(h1b + idx + bj * HALF) = pack8(f); }
                ss += __shfl_xor(ss, 16); ss += __shfl_xor(ss, 32);
                if (fq == 0) atomicAdd(ssq + row, ss); }
    }
};
struct EpiUp {
    static constexpr bool PERM = true, AFTER_DRAIN = false;
    const float* ssq; bf16_t* U;
    __device__ __forceinline__ void operator()(const f32x4 (&acc)[2][2][4][2], const Unit& u, int wr, int wc, int fr, int fq) const {
        const int row0 = u.pm * BM + wr * 64 + fr, col0 = u.pn * BM + wc * 32 + 8 * fq;
#pragma unroll
        for (int ai = 0; ai < 2; ++ai)
#pragma unroll
            for (int m = 0; m < 4; ++m) { const int row = row0 + ai * HALF + m * 16; const float rs = __builtin_amdgcn_rsqf(ssq[row] * (1.0f / 1024.0f) + 1e-6f); bf16_t* rowp = U + (size_t)row * 4096 + col0;
#pragma unroll
                for (int bj = 0; bj < 2; ++bj) { const f32x4 v0 = acc[ai][bj][m][0], v1 = acc[ai][bj][m][1];
                    float f[8] = {v0[0], v0[1], v0[2], v0[3], v1[0], v1[1], v1[2], v1[3]};
#pragma unroll
                    for (int e = 0; e < 8; ++e) { const float r = fmaxf(f[e] * rs, 0.f); f[e] = r * r; }
                    *(u32x4*)(rowp + bj * HALF) = pack8(f); } }
    }
};
struct EpiDown {
    static constexpr bool PERM = true, AFTER_DRAIN = false;
    const bf16_t* h1b; float* out;
    __device__ __forceinline__ void operator()(const f32x4 (&acc)[2][2][4][2], const Unit& u, int wr, int wc, int fr, int fq) const {
        const int row0 = u.pm * BM + wr * 64 + fr, col0 = u.pn * BM + wc * 32 + 8 * fq;
#pragma unroll
        for (int ai = 0; ai < 2; ++ai)
#pragma unroll
            for (int m = 0; m < 4; ++m) { const size_t idx = (size_t)(row0 + ai * HALF + m * 16) * 1024 + col0;
#pragma unroll
                for (int bj = 0; bj < 2; ++bj) { float h[8]; unpack8(*(const u32x4*)(h1b + idx + bj * HALF), h);
                    const f32x4 a0 = acc[ai][bj][m][0], a1 = acc[ai][bj][m][1];
                    __builtin_nontemporal_store(((f32x4){h[0] + a0[0], h[1] + a0[1], h[2] + a0[2], h[3] + a0[3]}), (f32x4*)(out + idx + bj * HALF));
                    __builtin_nontemporal_store(((f32x4){h[4] + a1[0], h[5] + a1[1], h[6] + a1[2], h[7] + a1[3]}), (f32x4*)(out + idx + bj * HALF + 4)); } }
    }
};
template <class Epi, class Sched, bool ALIGN_EPI = false, bool SP2 = false>
__device__ __forceinline__ void gemm_phase(PG8_LAS unsigned char* lds, const Gemm g, const Sched& S, const Epi& E) {
    int tid_ = threadIdx.x; asm volatile("" : "+v"(tid_));
    const int tid = tid_, wid = __builtin_amdgcn_readfirstlane(tid >> 6), lane = tid & 63, wr = wid >> 2, wc = wid & 3, fr = lane & 15, fq = lane >> 4;
    const int K = g.K, nt = K / BK;
    unsigned voffA[2], voffB[2];
#pragma unroll
    for (int i = 0; i < 2; ++i) { int R, C; stage_rc(tid * 16 + i * 8192, R, C); const int Rb = Epi::PERM ? ((R & ~31) + perm32(R & 31)) : R;
        voffA[i] = (unsigned)(R * K + C) * 2u; voffB[i] = (unsigned)(Rb * K + C) * 2u; }
    const size_t kstep = (size_t)(BK * 2);
    const size_t hstep = (size_t)HALF * K * 2;
    const size_t tstep = 2 * hstep;
    const unsigned ldsw = (unsigned)wid * 1024u;
    const int aoff = lds_byte(wr * 64 + fr, fq * 8), boff = lds_byte(wc * 32 + fr, fq * 8);
#define PG8_SA(b, h) (((b) * 2 + (h)) * HTB)
#define PG8_SB(b, h) ((4 + (b) * 2 + (h)) * HTB)
#define PG8_STAGE(bufoff, gbase, voff) do { _Pragma("unroll") for (int _i = 0; _i < 2; ++_i) \
        __builtin_amdgcn_global_load_lds((const unsigned*)((const char*)(gbase) + (voff)[_i]), (PG8_LAS unsigned*)(lds + (bufoff) + ldsw + _i * 8192), 16, 0, 0); } while (0)
#define PG8_LDA(dst, b, h) do { _Pragma("unroll") for (int m = 0; m < 4; ++m) _Pragma("unroll") for (int k = 0; k < 2; ++k) dst[m][k] = *(const PG8_LAS bf16x8*)(lds + PG8_SA(b, h) + aoff + m * 2048 + k * 1024); } while (0)
#define PG8_LDB(dst, b, h) do { _Pragma("unroll") for (int n = 0; n < 2; ++n) _Pragma("unroll") for (int k = 0; k < 2; ++k) dst[n][k] = *(const PG8_LAS bf16x8*)(lds + PG8_SB(b, h) + boff + n * 2048 + k * 1024); } while (0)
#define PG8_MMA(ai, bj, At, Bt) do { __builtin_amdgcn_s_setprio(1); _Pragma("unroll") for (int m = 0; m < 4; ++m) _Pragma("unroll") for (int n = 0; n < 2; ++n) _Pragma("unroll") for (int k = 0; k < 2; ++k) \
        acc[ai][bj][m][n] = __builtin_amdgcn_mfma_f32_16x16x32_bf16(Bt[n][k], At[m][k], acc[ai][bj][m][n], 0, 0, 0); __builtin_amdgcn_s_setprio(0); } while (0)
#define PG8_WAIT_V(n) asm volatile("s_waitcnt vmcnt(" #n ")" ::: "memory")
#define PG8_WAIT_L(n) asm volatile("s_waitcnt lgkmcnt(" #n ")" ::: "memory")
#define PG8_BAR __builtin_amdgcn_s_barrier()
#define PG8_SCHED __builtin_amdgcn_sched_barrier(0)
    Unit cur, nxt; int ui = 0;
    if (!S.next(0, cur)) return;
    f32x4 acc[2][2][4][2];
#pragma unroll
    for (int a = 0; a < 2; ++a)
#pragma unroll
        for (int b = 0; b < 2; ++b)
#pragma unroll
            for (int m = 0; m < 4; ++m)
#pragma unroll
                for (int n = 0; n < 2; ++n) acc[a][b][m][n] = (f32x4){0.f, 0.f, 0.f, 0.f};
    bf16x8 At[4][2], B0[2][2], B1[2][2];
    const char* cA = (const char*)g.A + (size_t)cur.pm * tstep; const char* cB = (const char*)g.Bt + (size_t)cur.pn * tstep;
    S.a_ready(cur);
    if constexpr (SP2) {
        PG8_STAGE(PG8_SB(0, 0), cB, voffB); PG8_STAGE(PG8_SB(0, 1), cB + hstep, voffB); PG8_STAGE(PG8_SA(0, 0), cA, voffA); PG8_STAGE(PG8_SA(0, 1), cA + hstep, voffA);
        if (wr == 1) PG8_BAR;
        PG8_WAIT_V(2); PG8_BAR;
        PG8_STAGE(PG8_SB(1, 0), cB + kstep, voffB); PG8_STAGE(PG8_SA(1, 0), cA + kstep, voffA); PG8_STAGE(PG8_SB(1, 1), cB + hstep + kstep, voffB);
        PG8_WAIT_V(6); PG8_BAR;
    } else {
        PG8_STAGE(PG8_SB(0, 0), cB, voffB); PG8_STAGE(PG8_SA(0, 0), cA, voffA); PG8_STAGE(PG8_SB(0, 1), cB + hstep, voffB); PG8_STAGE(PG8_SA(0, 1), cA + hstep, voffA);
        if (wr == 1) PG8_BAR;
        PG8_WAIT_V(4); PG8_BAR;
        PG8_STAGE(PG8_SB(1, 0), cB + kstep, voffB); PG8_STAGE(PG8_SA(1, 0), cA + kstep, voffA); PG8_STAGE(PG8_SB(1, 1), cB + hstep + kstep, voffB);
        PG8_WAIT_V(6); PG8_BAR;
    }
    for (;;) {
        const bool has_next = S.next(ui + 1, nxt);
        const char* nA = has_next ? (const char*)g.A + (size_t)nxt.pm * tstep : cA; const char* nB = has_next ? (const char*)g.Bt + (size_t)nxt.pn * tstep : cB;
        for (int t = 0; t < nt; t += 2) {
            const bool last = (t == nt - 2);
            const char* a1 = cA + (size_t)(t + 1) * kstep;
            const char* a2 = last ? nA : cA + (size_t)(t + 2) * kstep; const char* b2 = last ? nB : cB + (size_t)(t + 2) * kstep;
            const char* a3 = a2 + kstep; const char* b3 = b2 + kstep;
            if (last && has_next) S.a_ready(nxt);
            if constexpr (SP2) {
            PG8_LDB(B0, 0, 0); PG8_LDB(B1, 0, 1); PG8_SCHED; PG8_LDA(At, 0, 0); PG8_STAGE(PG8_SA(1, 1), a1 + hstep, voffA);
            PG8_WAIT_V(8); PG8_WAIT_L(0); PG8_BAR; PG8_MMA(0, 0, At, B0); PG8_MMA(0, 1, At, B1); PG8_BAR; PG8_SCHED;
            PG8_LDA(At, 0, 1); PG8_STAGE(PG8_SB(0, 0), b2, voffB); PG8_STAGE(PG8_SB(0, 1), b2 + hstep, voffB); PG8_STAGE(PG8_SA(0, 0), a2, voffA);
            PG8_WAIT_V(8); PG8_WAIT_L(0); PG8_BAR; PG8_MMA(1, 0, At, B0); PG8_MMA(1, 1, At, B1); PG8_BAR; PG8_SCHED;
            PG8_LDB(B0, 1, 0); PG8_LDB(B1, 1, 1); PG8_SCHED; PG8_LDA(At, 1, 0); PG8_STAGE(PG8_SA(0, 1), a2 + hstep, voffA);
            PG8_WAIT_V(8); PG8_WAIT_L(0); PG8_BAR; PG8_MMA(0, 0, At, B0); PG8_MMA(0, 1, At, B1); PG8_BAR; PG8_SCHED;
            PG8_LDA(At, 1, 1); PG8_STAGE(PG8_SB(1, 0), b3, voffB); PG8_STAGE(PG8_SB(1, 1), b3 + hstep, voffB); PG8_STAGE(PG8_SA(1, 0), a3, voffA);
            PG8_WAIT_V(8); PG8_WAIT_L(0); PG8_BAR; PG8_MMA(1, 0, At, B0); PG8_MMA(1, 1, At, B1); PG8_BAR; PG8_SCHED;
            } else {
            PG8_LDB(B0, 0, 0); PG8_SCHED; PG8_LDA(At, 0, 0); PG8_STAGE(PG8_SA(1, 1), a1 + hstep, voffA);
            PG8_WAIT_L(8); PG8_BAR; PG8_WAIT_L(0); PG8_MMA(0, 0, At, B0); PG8_BAR; PG8_SCHED;
            PG8_LDB(B1, 0, 1); PG8_STAGE(PG8_SB(0, 0), b2, voffB);
            PG8_BAR; PG8_WAIT_L(0); PG8_MMA(0, 1, At, B1); PG8_BAR;
            PG8_LDA(At, 0, 1); PG8_STAGE(PG8_SA(0, 0), a2, voffA);
            PG8_BAR; PG8_WAIT_L(0); PG8_MMA(1, 0, At, B0); PG8_BAR; PG8_SCHED;
            PG8_STAGE(PG8_SB(0, 1), b2 + hstep, voffB);
            PG8_WAIT_V(6); PG8_BAR; PG8_MMA(1, 1, At, B1); PG8_BAR;
            PG8_LDB(B0, 1, 0); PG8_SCHED; PG8_LDA(At, 1, 0); PG8_STAGE(PG8_SA(0, 1), a2 + hstep, voffA);
            PG8_WAIT_L(8); PG8_BAR; PG8_WAIT_L(0); PG8_MMA(0, 0, At, B0); PG8_BAR; PG8_SCHED;
            PG8_LDB(B1, 1, 1); PG8_STAGE(PG8_SB(1, 0), b3, voffB);
            PG8_BAR; PG8_WAIT_L(0); PG8_MMA(0, 1, At, B1); PG8_BAR;
            PG8_LDA(At, 1, 1); PG8_STAGE(PG8_SA(1, 0), a3, voffA);
            PG8_BAR; PG8_WAIT_L(0); PG8_MMA(1, 0, At, B0); PG8_BAR; PG8_SCHED;
            PG8_STAGE(PG8_SB(1, 1), b3 + hstep, voffB);
            PG8_WAIT_V(6); PG8_BAR; PG8_MMA(1, 1, At, B1); PG8_BAR;
            }
        }
        if constexpr (ALIGN_EPI) { if (wr == 0) PG8_BAR; }
        if constexpr (!Epi::AFTER_DRAIN) { E(acc, cur, wr, wc, fr, fq); S.done(cur); }
        if (!has_next) break;
#pragma unroll
        for (int a = 0; a < 2; ++a)
#pragma unroll
            for (int b = 0; b < 2; ++b)
#pragma unroll
                for (int m = 0; m < 4; ++m)
#pragma unroll
                    for (int n = 0; n < 2; ++n) acc[a][b][m][n] = (f32x4){0.f, 0.f, 0.f, 0.f};
        cur = nxt; cA = nA; cB = nB; ++ui;
        if constexpr (ALIGN_EPI) { if (wr == 1) PG8_BAR; }
    }
    PG8_WAIT_V(0);
    if constexpr (!ALIGN_EPI) { if (wr == 0) PG8_BAR; }
    PG8_BAR;
    if constexpr (Epi::AFTER_DRAIN) { E.fused(acc, cur, wr, wc, fr, fq, lds, wid, lane); S.done(cur); }
#undef PG8_SA
#undef PG8_SB
#undef PG8_STAGE
#undef PG8_LDA
#undef PG8_LDB
#undef PG8_MMA
#undef PG8_WAIT_V
#undef PG8_WAIT_L
#undef PG8_BAR
#undef PG8_SCHED
}
}

using pg8::bf16_t; using pg8::bf16x8; using pg8::f32x4; using pg8::u32x4; using pg8::unpack8; using pg8::pack8;
typedef unsigned u32x2 __attribute__((ext_vector_type(2)));
#define MFMA16(a, b, c) __builtin_amdgcn_mfma_f32_16x16x32_bf16((a), (b), (c), 0, 0, 0)
__device__ __forceinline__ unsigned pk2(float lo, float hi) { return pg8::cvt_pk_bf16(lo, hi); }
__device__ __forceinline__ unsigned pk2v(float lo, float hi) { return pg8::cvt_pk_bf16_v(lo, hi); }
__device__ __forceinline__ u32x4 pack8v(const float (&f)[8]) { u32x4 w; w.x = pk2v(f[0], f[1]); w.y = pk2v(f[2], f[3]); w.z = pk2v(f[4], f[5]); w.w = pk2v(f[6], f[7]); return w; }
__device__ __forceinline__ float wave_sum(float v) {
#pragma unroll
    for (int o = 1; o < 64; o <<= 1) v += __shfl_xor(v, o);
    return v;
}
#define LDS_WAIT() asm volatile("s_waitcnt lgkmcnt(0)" ::: "memory")
template <int CTRL> __device__ __forceinline__ float dpp_mov(float v) { return __builtin_bit_cast(float, __builtin_amdgcn_update_dpp(0, __builtin_bit_cast(int, v), CTRL, 0xf, 0xf, true)); }
__device__ __forceinline__ float sum8_dpp(float v) { v += dpp_mov<0xB1>(v); v += dpp_mov<0x4E>(v); v += dpp_mov<0x141>(v); return v; }
__device__ __forceinline__ float max8_dpp(float v) { v = fmaxf(v, dpp_mov<0xB1>(v)); v = fmaxf(v, dpp_mov<0x4E>(v)); v = fmaxf(v, dpp_mov<0x141>(v)); return v; }
__device__ __forceinline__ float sum16_dpp(float v) { v = sum8_dpp(v); v += dpp_mov<0x140>(v); return v; }

__device__ __forceinline__ void transpose_item(const float* __restrict__ W, int ldw, int K, bf16_t* WT, int dst_row0, int src_col0, int nvalid, const float* __restrict__ kscale, int k0, LAS float* scr, int lane) {
    const int c4 = lane & 7, kr = lane >> 3;
    f32x4 v[8];
#pragma unroll
    for (int i = 0; i < 8; ++i) { v[i] = (f32x4){0.f, 0.f, 0.f, 0.f};
        if (4 * c4 < nvalid) v[i] = *(const f32x4*)(W + (size_t)(k0 + kr + 8 * i) * ldw + src_col0 + 4 * c4); }
    if (kscale) {
#pragma unroll
        for (int i = 0; i < 8; ++i) v[i] = v[i] * kscale[k0 + kr + 8 * i];
    }
#pragma unroll
    for (int i = 0; i < 8; ++i) { LAS float* d = scr + (kr + 8 * i) * 33 + 4 * c4; d[0] = v[i].x; d[1] = v[i].y; d[2] = v[i].z; d[3] = v[i].w; }
    LDS_WAIT(); asm volatile("" ::: "memory");
    const int ch = lane & 7;
#pragma unroll
    for (int j = 0; j < 4; ++j) { const int n = (lane >> 3) + 8 * j; const LAS float* s = scr + (8 * ch) * 33 + n;
        u32x4 o; o.x = pk2(s[0 * 33], s[1 * 33]); o.y = pk2(s[2 * 33], s[3 * 33]); o.z = pk2(s[4 * 33], s[5 * 33]); o.w = pk2(s[6 * 33], s[7 * 33]);
        *(u32x4*)(WT + (size_t)(dst_row0 + n) * K + k0 + 8 * ch) = o; }
    LDS_WAIT(); asm volatile("" ::: "memory");
}
struct Ptrs {
    const float *x, *norm_mix, *w_in, *w_alpha2, *b_alpha, *gla_norm, *swa_qn, *swa_kn, *sinks, *w_bg, *w_bs, *w_out, *norm_mlp, *w_up, *w_down;
    float* out; unsigned char* ws;
};
constexpr int P0_I_SQ = 16 * 32, P0_I_UP = 16 * 128, P0_I_DN = 64 * 32, P0_REST_ITEMS = 3 * P0_I_SQ + P0_I_UP + P0_I_DN;
__device__ __forceinline__ void transpose_rest_item(const Ptrs& P, int r, LAS float* scr, int lane) {
    if (r < P0_I_SQ) { transpose_item(P.w_bg, 1024, 1024, (bf16_t*)(P.ws + WS_WBG), 32 * (r % 32), 32 * (r % 32), 32, nullptr, 64 * (r / 32), scr, lane); return; } r -= P0_I_SQ;
    if (r < P0_I_SQ) { transpose_item(P.w_bs, 1024, 1024, (bf16_t*)(P.ws + WS_WBS), 32 * (r % 32), 32 * (r % 32), 32, nullptr, 64 * (r / 32), scr, lane); return; } r -= P0_I_SQ;
    if (r < P0_I_SQ) { transpose_item(P.w_out, 1024, 1024, (bf16_t*)(P.ws + WS_WOUT), 32 * (r % 32), 32 * (r % 32), 32, nullptr, 64 * (r / 32), scr, lane); return; } r -= P0_I_SQ;
    if (r < P0_I_UP) { transpose_item(P.w_up, 4096, 1024, (bf16_t*)(P.ws + WS_WUP), 32 * (r % 128), 32 * (r % 128), 32, P.norm_mlp, 64 * (r / 128), scr, lane); return; } r -= P0_I_UP;
    transpose_item(P.w_down, 1024, 4096, (bf16_t*)(P.ws + WS_WDN), 32 * (r % 32), 32 * (r % 32), 32, nullptr, 64 * (r / 32), scr, lane);
}
__device__ __forceinline__ void p0_prologue(const Ptrs& P, LAS unsigned char* lds, int tid, int G, int blk) {
    const int lane = tid & 63, wave = tid >> 6;
    LAS float* scr = (LAS float*)(lds + wave * 12288);
    const int gw = blk * 8 + wave, NGW = G * 8;
    LAS bf16_t* WA = (LAS bf16_t*)(lds + 98304);
    for (int idx = tid; idx < 4096; idx += 512) { const int k = idx >> 2, c = (idx & 3) * 4; const f32x4 w = *(const f32x4*)(P.w_in + (size_t)k * 6672 + 3072 + c); const unsigned p0 = pk2(w.x, w.y), p1 = pk2(w.z, w.w);
        WA[(c + 0) * 1032 + k] = (bf16_t)(p0 & 0xffffu); WA[(c + 1) * 1032 + k] = (bf16_t)(p0 >> 16); WA[(c + 2) * 1032 + k] = (bf16_t)(p1 & 0xffffu); WA[(c + 3) * 1032 + k] = (bf16_t)(p1 >> 16); }
    __syncthreads();
    constexpr int I_IN = 16 * (NPROJ / 32);
    const int nitems = (G == 256) ? I_IN : I_IN + P0_REST_ITEMS;
    for (int it = gw; it < nitems; it += NGW) {
        if (it < I_IN) { const int nblk = NPROJ / 32, kb = it / nblk, nb = it % nblk, d = 32 * nb; int src, nv;
            if (d < 3072) { src = d; nv = 32; } else { src = d + 16; nv = 32; }
            transpose_item(P.w_in, 6672, 1024, (bf16_t*)(P.ws + WS_WIN), d, src, nv, nullptr, 64 * kb, scr, lane); continue; }
        transpose_rest_item(P, it - I_IN, scr, lane);
    }
    bf16_t* hn = (bf16_t*)P.out; float* alr = (float*)(P.ws + WS_ALR);
    LAS bf16_t* SR = (LAS bf16_t*)scr;
    const int fr = lane & 15, fq = lane >> 4;
    f32x4 gm[4];
#pragma unroll
    for (int j = 0; j < 4; ++j) gm[j] = *(const f32x4*)(P.norm_mix + 4 * lane + 256 * j);
    for (int m0 = gw * 4; m0 < M_TOK; m0 += NGW * 4) {
        f32x4 v[4][4];
#pragma unroll
        for (int r = 0; r < 4; ++r) { const f32x4* xr = (const f32x4*)(P.x + (size_t)(m0 + r) * DM) + lane;
#pragma unroll
            for (int j = 0; j < 4; ++j) v[r][j] = __builtin_nontemporal_load(xr + 64 * j); }
#pragma unroll
        for (int r = 0; r < 4; ++r) { float s = 0.f;
#pragma unroll
            for (int j = 0; j < 4; ++j) s += (v[r][j].x * v[r][j].x + v[r][j].y * v[r][j].y) + (v[r][j].z * v[r][j].z + v[r][j].w * v[r][j].w);
            const float rs = __builtin_amdgcn_rsqf(wave_sum(s) * (1.0f / DM) + 1e-6f);
            unsigned long long* o8 = (unsigned long long*)(hn + (size_t)(m0 + r) * DM) + lane;
#pragma unroll
            for (int j = 0; j < 4; ++j) { const f32x4 y = v[r][j] * rs * gm[j]; const unsigned long long pk = (unsigned long long)pk2(y.x, y.y) | ((unsigned long long)pk2(y.z, y.w) << 32);
                o8[64 * j] = pk; *(LAS unsigned long long*)(SR + r * 1032 + 4 * lane + 256 * j) = pk; } }
        LDS_WAIT(); asm volatile("" ::: "memory");
        f32x4 ac0 = (f32x4){0.f, 0.f, 0.f, 0.f}, ac1 = ac0;
#pragma unroll 8
        for (int ks = 0; ks < 32; ks += 2) {
            const bf16x8 a0 = *(const LAS bf16x8*)(SR + (fr & 3) * 1032 + ks * 32 + fq * 8), b0 = *(const LAS bf16x8*)(WA + fr * 1032 + ks * 32 + fq * 8);
            const bf16x8 a1 = *(const LAS bf16x8*)(SR + (fr & 3) * 1032 + ks * 32 + 32 + fq * 8), b1 = *(const LAS bf16x8*)(WA + fr * 1032 + ks * 32 + 32 + fq * 8);
            ac0 = MFMA16(a0, b0, ac0); ac1 = MFMA16(a1, b1, ac1); }
        ac0 = ac0 + ac1;
        if (fq == 0) {
#pragma unroll
            for (int i = 0; i < 4; ++i) alr[(size_t)(m0 + i) * 16 + fr] = ac0[i]; }
        LDS_WAIT(); asm volatile("" ::: "memory");
    }
    float* ssq = (float*)(P.ws + WS_SSQ);
    for (int i = blk * 512 + tid; i < M_TOK; i += G * 512) ssq[i] = 0.f;
}

constexpr int SW_QN = 0, SW_KN = 36864, SW_VT = 64512, SW_OT = 90112;
struct SwaRegs { u32x4 q[4], k[3], v[3]; };
__device__ __forceinline__ void swa_load(SwaRegs& R, int b, int n, int kh, const bf16_t* __restrict__ SQ, const bf16_t* __restrict__ SKV, int tid) {
    asm volatile("" : "+v"(tid));
    const int lane = tid & 63, wave = tid >> 6, dq = tid & 7;
    const bf16_t* qb = SQ + ((size_t)b * SEQ_T + (size_t)n * 64) * 1024 + kh * 256;
    const bf16_t* kb = SKV + (size_t)b * SEQ_T * 512 + kh * 64;
    const int p0 = n * 64 - 128;
#pragma unroll
    for (int i = 0; i < 4; ++i) { const unsigned o = (unsigned)tid + 512u * i; R.q[i] = *(const u32x4*)(qb + ((o >> 5) * 1024u + (o & 31u) * 8u)); }
#pragma unroll
    for (int i = 0; i < 3; ++i) { const int j = (int)(((unsigned)tid + 512u * i) >> 3); const int pos = p0 + j;
        R.k[i] = (u32x4){0u, 0u, 0u, 0u};
        if (pos >= 0) R.k[i] = *(const u32x4*)(kb + ((unsigned)pos * 512u + (unsigned)dq * 8u)); }
#pragma unroll
    for (int i = 0; i < 3; ++i) { const int j = (lane >> 3) + 8 * wave + 64 * i; const int pos = p0 + j;
        R.v[i] = (u32x4){0u, 0u, 0u, 0u};
        if (pos >= 0) R.v[i] = *(const u32x4*)(kb + ((unsigned)pos * 512u + 256u + (unsigned)dq * 8u)); }
}
__device__ __forceinline__ float swa_stage(const SwaRegs& R, const float* __restrict__ qn, const float* __restrict__ kn, LAS unsigned char* lds, int tid) {
    asm volatile("" : "+v"(tid));
    const int lane = tid & 63, wave = tid >> 6, dq = tid & 7;
    LAS bf16_t* Qn = (LAS bf16_t*)(lds + SW_QN); LAS bf16_t* Kn = (LAS bf16_t*)(lds + SW_KN); LAS bf16_t* Vt = (LAS bf16_t*)(lds + SW_VT);
    float gqmax, gkmax;
    {
        float g8[8]; { const f32x4 a = *(const f32x4*)(qn + dq * 8), c = *(const f32x4*)(qn + dq * 8 + 4); g8[0] = a.x; g8[1] = a.y; g8[2] = a.z; g8[3] = a.w; g8[4] = c.x; g8[5] = c.y; g8[6] = c.z; g8[7] = c.w; }
#pragma unroll
        for (int i = 0; i < 4; ++i) { const int o = tid + 512 * i, t = o >> 5, oc = o & 31, g = oc >> 3;
            float f[8]; unpack8(R.q[i], f);
            float ss = 0.f;
#pragma unroll
            for (int e = 0; e < 8; ++e) ss += f[e] * f[e];
            ss = sum8_dpp(ss);
            const float rs = __builtin_amdgcn_rsqf(ss * (1.0f / 64.0f) + 1e-6f) * (0.125f * 1.4426950408889634f);
#pragma unroll
            for (int e = 0; e < 8; ++e) f[e] = f[e] * rs * g8[e];
            *(LAS u32x4*)(Qn + (g * 64 + t) * 72 + dq * 8) = pack8(f); __builtin_amdgcn_sched_barrier(0); }
        float m = 0.f;
#pragma unroll
        for (int e = 0; e < 8; ++e) m = fmaxf(m, fabsf(g8[e]));
        gqmax = max8_dpp(m);
    }
    {
        float g8[8]; { const f32x4 a = *(const f32x4*)(kn + dq * 8), c = *(const f32x4*)(kn + dq * 8 + 4); g8[0] = a.x; g8[1] = a.y; g8[2] = a.z; g8[3] = a.w; g8[4] = c.x; g8[5] = c.y; g8[6] = c.z; g8[7] = c.w; }
#pragma unroll
        for (int i = 0; i < 3; ++i) { const int o = tid + 512 * i, j = o >> 3;
            float f[8]; unpack8(R.k[i], f);
            float ss = 0.f;
#pragma unroll
            for (int e = 0; e < 8; ++e) ss += f[e] * f[e];
            ss = sum8_dpp(ss);
            const float rs = __builtin_amdgcn_rsqf(ss * (1.0f / 64.0f) + 1e-6f);
#pragma unroll
            for (int e = 0; e < 8; ++e) f[e] = f[e] * rs * g8[e];
            *(LAS u32x4*)(Kn + j * 72 + dq * 8) = pack8(f); __builtin_amdgcn_sched_barrier(0); }
        float m = 0.f;
#pragma unroll
        for (int e = 0; e < 8; ++e) m = fmaxf(m, fabsf(g8[e]));
        gkmax = max8_dpp(m);
    }
#pragma unroll
    for (int i = 0; i < 3; ++i) { const int j = (lane >> 3) + 8 * wave + 64 * i; const u32x4 w = R.v[i];
        LAS bf16_t* vp = Vt + (dq * 8) * 200 + (j ^ (dq << 3));
        vp[0 * 200] = (bf16_t)(w.x & 0xffffu); vp[1 * 200] = (bf16_t)(w.x >> 16); vp[2 * 200] = (bf16_t)(w.y & 0xffffu); vp[3 * 200] = (bf16_t)(w.y >> 16);
        vp[4 * 200] = (bf16_t)(w.z & 0xffffu); vp[5 * 200] = (bf16_t)(w.z >> 16); vp[6 * 200] = (bf16_t)(w.w & 0xffffu); vp[7 * 200] = (bf16_t)(w.w >> 16); }
    return 8.0f * 1.4426950408889634f * gqmax * gkmax;
}
__device__ __forceinline__ void swa_compute(float M2, int b, int n, int kh, bf16_t* __restrict__ OS, const float* __restrict__ sinks, LAS unsigned char* lds, int tid) {
    asm volatile("" : "+v"(tid));
    const int lane = tid & 63, wave = tid >> 6, fr = lane & 15, fq = lane >> 4;
    LAS bf16_t* Qn = (LAS bf16_t*)(lds + SW_QN); LAS bf16_t* Kn = (LAS bf16_t*)(lds + SW_KN); LAS bf16_t* Vt = (LAS bf16_t*)(lds + SW_VT);
    const int g = wave >> 1, qh = wave & 1;
    const int hh = kh * 4 + g; const float slope = exp2f(-0.5f * (float)(hh + 1)) * 1.4426950408889634f; const float sink = sinks[hh] * 1.4426950408889634f;
    bf16x8 bq[2][2]; float fb[2];
#pragma unroll
    for (int qt = 0; qt < 2; ++qt) { const int qrow = qh * 32 + qt * 16 + fr; fb[qt] = (float)(128 + qrow - 4 * fq);
#pragma unroll
        for (int ks = 0; ks < 2; ++ks) bq[qt][ks] = *(const LAS bf16x8*)(Qn + (g * 64 + qrow) * 72 + ks * 32 + fq * 8); }
    float l[2] = {0.f, 0.f};
    f32x4 oa[4][2];
#pragma unroll
    for (int dt = 0; dt < 4; ++dt)
#pragma unroll
        for (int qt = 0; qt < 2; ++qt) oa[dt][qt] = (f32x4){0.f, 0.f, 0.f, 0.f};
    const int kg0 = n >= 2 ? 0 : 2 - n;
#pragma unroll 1
    for (int kg = kg0; kg < 3; ++kg) {
        float ini[2];
#pragma unroll
        for (int qt = 0; qt < 2; ++qt) ini[qt] = kg < 2 ? -M2 - slope * (fb[qt] - (float)(kg * 64)) : -M2;
        f32x4 sc[4][2];
#pragma unroll
        for (int k4 = 0; k4 < 4; ++k4) { const LAS bf16_t* kr = Kn + (kg * 64 + k4 * 16 + fr) * 72 + fq * 8;
            const bf16x8 ak0 = *(const LAS bf16x8*)(kr), ak1 = *(const LAS bf16x8*)(kr + 32);
#pragma unroll
            for (int qt = 0; qt < 2; ++qt) { f32x4 a = (f32x4){ini[qt], ini[qt], ini[qt], ini[qt]}; a = MFMA16(ak0, bq[qt][0], a); a = MFMA16(ak1, bq[qt][1], a); sc[k4][qt] = a; } }
        if (kg < 2) {
#pragma unroll
            for (int k4 = 0; k4 < 4; ++k4)
#pragma unroll
                for (int qt = 0; qt < 2; ++qt)
#pragma unroll
                    for (int i = 0; i < 4; ++i) sc[k4][qt][i] = fmaf(slope, (float)(k4 * 16 + i), sc[k4][qt][i]);
        } else {
#pragma unroll
            for (int k4 = 0; k4 < 4; ++k4)
#pragma unroll
                for (int qt = 0; qt < 2; ++qt)
#pragma unroll
                    for (int i = 0; i < 4; ++i) sc[k4][qt][i] = sc[k4][qt][i] - slope * fabsf((fb[qt] - 128.0f) - (float)(k4 * 16 + i));
        }
#pragma unroll
        for (int k4 = 0; k4 < 4; ++k4)
#pragma unroll
            for (int qt = 0; qt < 2; ++qt)
#pragma unroll
                for (int i = 0; i < 4; ++i) { const float p = __builtin_amdgcn_exp2f(sc[k4][qt][i]); sc[k4][qt][i] = p; l[qt] += p; }
#pragma unroll
        for (int s2 = 0; s2 < 2; ++s2) {
            bf16x8 bp[2];
#pragma unroll
            for (int qt = 0; qt < 2; ++qt) { u32x4 pw; pw.x = pk2v(sc[2 * s2][qt][0], sc[2 * s2][qt][1]); pw.y = pk2v(sc[2 * s2][qt][2], sc[2 * s2][qt][3]);
                pw.z = pk2v(sc[2 * s2 + 1][qt][0], sc[2 * s2 + 1][qt][1]); pw.w = pk2v(sc[2 * s2 + 1][qt][2], sc[2 * s2 + 1][qt][3]); bp[qt] = __builtin_bit_cast(bf16x8, pw); }
#pragma unroll
            for (int dt = 0; dt < 4; ++dt) { const int d = dt * 16 + fr, swz = ((d >> 3) & 7) << 3; const LAS bf16_t* vr = Vt + d * 200; const int j0 = kg * 64 + 32 * s2 + 4 * fq;
                const u32x2 lo = *(const LAS u32x2*)(vr + (j0 ^ swz)), hi = *(const LAS u32x2*)(vr + ((j0 + 16) ^ swz));
                u32x4 w; w.x = lo.x; w.y = lo.y; w.z = hi.x; w.w = hi.y; const bf16x8 av = __builtin_bit_cast(bf16x8, w);
#pragma unroll
                for (int qt = 0; qt < 2; ++qt) oa[dt][qt] = MFMA16(av, bp[qt], oa[dt][qt]); }
        }
    }
    const float esink = __builtin_amdgcn_exp2f(sink - M2);
#pragma unroll
    for (int qt = 0; qt < 2; ++qt) { float ls = l[qt]; ls += __shfl_xor(ls, 16); ls += __shfl_xor(ls, 32); const float inv = __builtin_amdgcn_rcpf(ls + esink);
        LAS bf16_t* op = (LAS bf16_t*)(lds + SW_OT) + (qh * 32 + qt * 16 + fr) * 264 + g * 64 + 4 * fq;
#pragma unroll
        for (int dt = 0; dt < 4; ++dt) { const f32x4 v = oa[dt][qt] * inv; u32x2 w; w.x = pk2(v[0], v[1]); w.y = pk2(v[2], v[3]); *(LAS u32x2*)(op + dt * 16) = w; } }
}
__device__ __forceinline__ void swa_store(int b, int n, int kh, bf16_t* __restrict__ OS, LAS unsigned char* lds, int tid) {
    asm volatile("" : "+v"(tid));
    const LAS bf16_t* OT = (const LAS bf16_t*)(lds + SW_OT);
    bf16_t* ob = OS + ((size_t)b * SEQ_T + (size_t)n * 64) * 1024 + kh * 256;
#pragma unroll
    for (int i = 0; i < 4; ++i) { const unsigned o = (unsigned)tid + 512u * i, t = o >> 5, oc = o & 31u; *(u32x4*)(ob + (t * 1024u + oc * 8u)) = *(const LAS u32x4*)(OT + t * 264u + oc * 8u); }
}

constexpr int GL_CUM = 0, GL_QD = 34816, GL_KD = 52224, GL_KT = 69632, GL_VT = 88064, GL_P = 124928, GL_SSQ = 134144, GL_DEC = 136192, GL_QT = 137216, GL_ALR = 139264, GL_END = 143360;
static_assert(GL_END <= LDS_BYTES, "GLA LDS map");
constexpr int GLA_NSEG = 8, GLA_SEGC = 64 / GLA_NSEG;
template <bool FULL>
__device__ __forceinline__ void gla_seg(int b, int h, int seg, const bf16_t* __restrict__ QK, const bf16_t* __restrict__ GV, const bf16_t* __restrict__ GG, const float* __restrict__ ALR,
                                        const float* __restrict__ w2, const float* __restrict__ balpha, const float* __restrict__ gnorm, bf16_t* __restrict__ OG,
                                        float* __restrict__ Lws, float* __restrict__ Dws, LAS unsigned char* lds, int tid) {
    asm volatile("" : "+v"(tid));
    const int lane = tid & 63, wave = tid >> 6, fr = lane & 15, fq = lane >> 4;
    LAS float* CUM = (LAS float*)(lds + GL_CUM); LAS bf16_t* OB = (LAS bf16_t*)(lds + GL_QD);
    LAS bf16_t* QD = (LAS bf16_t*)(lds + GL_QD); LAS bf16_t* KD = (LAS bf16_t*)(lds + GL_KD); LAS bf16_t* KT = (LAS bf16_t*)(lds + GL_KT); LAS bf16_t* VT = (LAS bf16_t*)(lds + GL_VT);
    LAS bf16_t* PB = (LAS bf16_t*)(lds + GL_P); LAS float* SSQ = (LAS float*)(lds + GL_SSQ); LAS float* DEC = (LAS float*)(lds + GL_DEC); LAS float* QT = (LAS float*)(lds + GL_QT);
    LAS float* ALRS = (LAS float*)(lds + GL_ALR);
    const int lt = (lane >> 3) + 8 * wave, lo = lane & 7, lsw = lt ^ (lo << 3);
    const int seq = b * 4 + h;
    f32x4 S[8][2];
#pragma unroll
    for (int a = 0; a < 8; ++a)
#pragma unroll
        for (int c = 0; c < 2; ++c) S[a][c] = (f32x4){0.f, 0.f, 0.f, 0.f};
    if (FULL) {
        const float* Lb0 = Lws + (size_t)(seq * GLA_NSEG) * 32768 + (size_t)wave * 4096 + lane * 4; const float* Db0 = Dws + (seq * GLA_NSEG) * 128;
        f32x4 La[16], Lb[16];
#define GLA_LOADL(DST, J) do { _Pragma("unroll") for (int q_ = 0; q_ < 16; ++q_) DST[q_] = *(const f32x4*)(Lb0 + (size_t)(J) * 32768 + q_ * 256); } while (0)
#define GLA_FOLD(SRC, J) do { _Pragma("unroll") for (int dkt = 0; dkt < 8; ++dkt) { const f32x4 dc = *(const f32x4*)(Db0 + (J) * 128 + dkt * 16 + 4 * fq); \
            _Pragma("unroll") for (int dvt = 0; dvt < 2; ++dvt) S[dkt][dvt] = S[dkt][dvt] * dc + SRC[dkt * 2 + dvt]; } } while (0)
        if (seg > 0) GLA_LOADL(La, 0);
#pragma unroll 1
        for (int j = 0; j < seg; j += 2) {
            if (j + 1 < seg) GLA_LOADL(Lb, j + 1);
            GLA_FOLD(La, j);
            if (j + 1 < seg) { if (j + 2 < seg) GLA_LOADL(La, j + 2); GLA_FOLD(Lb, j + 1); }
        }
#undef GLA_LOADL
#undef GLA_FOLD
    }
    const int dkc = wave * 16 + fr;
    bf16x8 w2f; { float w[8];
#pragma unroll
        for (int j = 0; j < 8; ++j) w[j] = w2[((fq & 1) * 8 + j) * 512 + h * 128 + dkc];
        w2f = __builtin_bit_cast(bf16x8, pack8v(w)); }
    const float bz = balpha[h * 128 + dkc];
    const size_t tokb = (size_t)b * SEQ_T + (size_t)seg * (GLA_SEGC * 64);
    if (tid < 256) *(LAS f32x4*)(ALRS + tid * 4) = *(const f32x4*)(ALR + tokb * 16 + tid * 4);
    float segtot = 0.f;
    u32x4 qw[2], kw[2], vw[4];
#define GLA_LOAD_QKV(T0) do { _Pragma("unroll") for (int i_ = 0; i_ < 2; ++i_) { const int oc_ = lo + 8 * i_; \
            kw[i_] = *(const u32x4*)(QK + ((T0) + lt) * 1024 + 512 + h * 128 + oc_ * 8); } \
        _Pragma("unroll") for (int i_ = 0; i_ < 4; ++i_) { const int oc_ = lo + 8 * i_; vw[i_] = *(const u32x4*)(GV + ((T0) + lt) * 1024 + h * 256 + oc_ * 8); } } while (0)
    __syncthreads();
#pragma unroll 1
    for (int c = 0; c < GLA_SEGC; ++c) {
        const size_t tok0 = tokb + (size_t)c * 64;
        GLA_LOAD_QKV(tok0);
        if (FULL) {
#pragma unroll
            for (int i = 0; i < 2; ++i) qw[i] = *(const u32x4*)(QK + (tok0 + lt) * 1024 + h * 128 + (lo + 8 * i) * 8); }
        {
            float carry = 0.f;
#pragma unroll
            for (int tt = 0; tt < 4; ++tt) {
                const LAS f32x4* ar = (const LAS f32x4*)(ALRS + (tt * 16 + fr) * 16 + (fq & 1) * 8); const f32x4 x0 = ar[0], x1 = ar[1];
                float x[8] = {x0.x, x0.y, x0.z, x0.w, x1.x, x1.y, x1.z, x1.w}, xh[8];
                unpack8(pack8v(x), xh);
                if (fq >= 2) {
#pragma unroll
                    for (int e = 0; e < 8; ++e) x[e] -= xh[e];
                }
                const bf16x8 af = __builtin_bit_cast(bf16x8, pack8v(x));
                const f32x4 z4 = MFMA16(af, w2f, ((f32x4){0.f, 0.f, 0.f, 0.f}));
                float v[4];
#pragma unroll
                for (int i = 0; i < 4; ++i) { const float z = z4[i] + bz;
                    v[i] = (fminf(z, 0.f) - 0.6931471805599453f * __builtin_amdgcn_logf(1.0f + __builtin_amdgcn_exp2f(-1.4426950408889634f * fabsf(z)))) * (1.0f / 16.0f); }
                v[1] += v[0]; v[2] += v[1]; v[3] += v[2];
                const float tot4 = v[3];
                const float p1 = __shfl_up(tot4, 16); float sc = tot4 + (fq >= 1 ? p1 : 0.f);
                const float p2 = __shfl_up(sc, 32); sc += (fq >= 2 ? p2 : 0.f);
                const float base = carry + (sc - tot4);
#pragma unroll
                for (int i = 0; i < 4; ++i) CUM[(tt * 16 + 4 * fq + i) * 132 + dkc] = v[i] + base;
                carry += __shfl(sc, 48 + fr);
            }
            if (fq == 0) DEC[dkc] = __builtin_amdgcn_exp2f(1.4426950408889634f * carry);
            segtot += carry;
        }
        __syncthreads();
        if (c + 1 < GLA_SEGC && tid < 256) *(LAS f32x4*)(ALRS + tid * 4) = *(const f32x4*)(ALR + (tok0 + 64) * 16 + tid * 4);
#pragma unroll
        for (int i = 0; i < 2; ++i) { const int oc = lo + 8 * i, t = lt;
            float k8[8]; unpack8(kw[i], k8);
            const f32x4 c0 = *(const LAS f32x4*)(CUM + t * 132 + oc * 8), c1 = *(const LAS f32x4*)(CUM + t * 132 + oc * 8 + 4);
            const f32x4 d0 = *(const LAS f32x4*)(DEC + oc * 8), d1 = *(const LAS f32x4*)(DEC + oc * 8 + 4);
            const float cm[8] = {c0.x, c0.y, c0.z, c0.w, c1.x, c1.y, c1.z, c1.w}; const float dc[8] = {d0.x, d0.y, d0.z, d0.w, d1.x, d1.y, d1.z, d1.w};
            float kd[8], ke[8];
#pragma unroll
            for (int e = 0; e < 8; ++e) { const float em = __builtin_amdgcn_exp2f(-1.4426950408889634f * cm[e]); kd[e] = k8[e] * em; ke[e] = kd[e] * dc[e]; }
            if (FULL) { float q8[8], qd[8]; unpack8(qw[i], q8);
#pragma unroll
                for (int e = 0; e < 8; ++e) qd[e] = q8[e] * __builtin_amdgcn_exp2f(1.4426950408889634f * cm[e]) * 0.08838834764831845f;
                *(LAS u32x4*)(QD + t * 136 + oc * 8) = pack8(qd); *(LAS u32x4*)(KD + t * 136 + oc * 8) = pack8(kd); }
            const u32x4 kp8 = pack8(ke); LAS bf16_t* kp = KT + (oc * 8) * 72 + lsw;
            kp[0 * 72] = (bf16_t)(kp8.x & 0xffffu); kp[1 * 72] = (bf16_t)(kp8.x >> 16); kp[2 * 72] = (bf16_t)(kp8.y & 0xffffu); kp[3 * 72] = (bf16_t)(kp8.y >> 16);
            kp[4 * 72] = (bf16_t)(kp8.z & 0xffffu); kp[5 * 72] = (bf16_t)(kp8.z >> 16); kp[6 * 72] = (bf16_t)(kp8.w & 0xffffu); kp[7 * 72] = (bf16_t)(kp8.w >> 16); }
#pragma unroll
        for (int i = 0; i < 4; ++i) { const int oc = lo + 8 * i; const u32x4 w = vw[i]; LAS bf16_t* vp = VT + (oc * 8) * 72 + lsw;
            vp[0 * 72] = (bf16_t)(w.x & 0xffffu); vp[1 * 72] = (bf16_t)(w.x >> 16); vp[2 * 72] = (bf16_t)(w.y & 0xffffu); vp[3 * 72] = (bf16_t)(w.y >> 16);
            vp[4 * 72] = (bf16_t)(w.z & 0xffffu); vp[5 * 72] = (bf16_t)(w.z >> 16); vp[6 * 72] = (bf16_t)(w.w & 0xffffu); vp[7 * 72] = (bf16_t)(w.w >> 16); }
        __syncthreads();
        f32x4 o[4][2];
        u32x4 gw[4];
        if (FULL) {
            {
                const int tt = wave >> 1;
#pragma unroll
                for (int u2 = 0; u2 < 2; ++u2) { const int st = (wave & 1) * 2 + u2; f32x4 a = (f32x4){0.f, 0.f, 0.f, 0.f};
                    if (st <= tt) {
#pragma unroll
                        for (int ks = 0; ks < 4; ++ks) { const bf16x8 ak = *(const LAS bf16x8*)(KD + (st * 16 + fr) * 136 + ks * 32 + fq * 8), bq = *(const LAS bf16x8*)(QD + (tt * 16 + fr) * 136 + ks * 32 + fq * 8);
                            a = MFMA16(ak, bq, a); }
                    }
                    const int t = tt * 16 + fr, s0 = st * 16 + 4 * fq;
                    const float p0 = (s0 + 0 <= t) ? a[0] : 0.f, p1 = (s0 + 1 <= t) ? a[1] : 0.f, p2 = (s0 + 2 <= t) ? a[2] : 0.f, p3 = (s0 + 3 <= t) ? a[3] : 0.f;
                    u32x2 w; w.x = pk2(p0, p1); w.y = pk2(p2, p3); *(LAS u32x2*)(PB + t * 72 + s0) = w; }
            }
#pragma unroll
            for (int a = 0; a < 4; ++a)
#pragma unroll
                for (int d = 0; d < 2; ++d) o[a][d] = (f32x4){0.f, 0.f, 0.f, 0.f};
#pragma unroll
            for (int ks = 0; ks < 4; ++ks) {
                bf16x8 bs[2];
#pragma unroll
                for (int dvt = 0; dvt < 2; ++dvt) { u32x4 w; w.x = pk2v(S[2 * ks][dvt][0], S[2 * ks][dvt][1]); w.y = pk2v(S[2 * ks][dvt][2], S[2 * ks][dvt][3]);
                    w.z = pk2v(S[2 * ks + 1][dvt][0], S[2 * ks + 1][dvt][1]); w.w = pk2v(S[2 * ks + 1][dvt][2], S[2 * ks + 1][dvt][3]); bs[dvt] = __builtin_bit_cast(bf16x8, w); }
#pragma unroll
                for (int tt = 0; tt < 4; ++tt) { const LAS bf16_t* qp = QD + (tt * 16 + fr) * 136 + 32 * ks + 4 * fq;
                    const u32x2 lo = *(const LAS u32x2*)(qp), hi = *(const LAS u32x2*)(qp + 16);
                    u32x4 w; w.x = lo.x; w.y = lo.y; w.z = hi.x; w.w = hi.y; const bf16x8 aq = __builtin_bit_cast(bf16x8, w);
#pragma unroll
                    for (int dvt = 0; dvt < 2; ++dvt) o[tt][dvt] = MFMA16(aq, bs[dvt], o[tt][dvt]); }
            }
        }
        bf16x8 bv[2][2];
#pragma unroll
        for (int dvt = 0; dvt < 2; ++dvt)
#pragma unroll
            for (int ks = 0; ks < 2; ++ks) { const int dv = wave * 32 + dvt * 16 + fr; bv[dvt][ks] = *(const LAS bf16x8*)(VT + dv * 72 + ((ks * 32 + fq * 8) ^ (((dv >> 3) & 7) << 3))); }
#pragma unroll
        for (int dkt = 0; dkt < 8; ++dkt) { const f32x4 dc = *(const LAS f32x4*)(DEC + dkt * 16 + 4 * fq);
#pragma unroll
            for (int dvt = 0; dvt < 2; ++dvt) S[dkt][dvt] = S[dkt][dvt] * dc;
#pragma unroll
            for (int ks = 0; ks < 2; ++ks) { const int dkr = dkt * 16 + fr; const bf16x8 ak = *(const LAS bf16x8*)(KT + dkr * 72 + ((ks * 32 + fq * 8) ^ (((dkr >> 3) & 7) << 3)));
#pragma unroll
                for (int dvt = 0; dvt < 2; ++dvt) S[dkt][dvt] = MFMA16(ak, bv[dvt][ks], S[dkt][dvt]); } }
        if (FULL) {
#pragma unroll
            for (int i = 0; i < 4; ++i) { const int oid = tid + 512 * i, t = oid >> 5, oc = oid & 31; gw[i] = *(const u32x4*)(GG + (tok0 + t) * 1024 + h * 256 + oc * 8); }
        }
        __syncthreads();
        if (FULL) {
#pragma unroll
            for (int ks = 0; ks < 2; ++ks)
#pragma unroll
                for (int tt = 0; tt < 4; ++tt) { if (ks == 1 && tt < 2) continue;
                    const bf16x8 ap = *(const LAS bf16x8*)(PB + (tt * 16 + fr) * 72 + ks * 32 + fq * 8);
#pragma unroll
                    for (int dvt = 0; dvt < 2; ++dvt) o[tt][dvt] = MFMA16(ap, bv[dvt][ks], o[tt][dvt]); }
#pragma unroll
            for (int tt = 0; tt < 4; ++tt)
#pragma unroll
                for (int i = 0; i < 4; ++i) { const int t = tt * 16 + 4 * fq + i; const float v0 = o[tt][0][i], v1 = o[tt][1][i];
                    const unsigned w = pk2(v0, v1);
                    OB[t * 272 + wave * 32 + fr] = (bf16_t)(w & 0xffffu); OB[t * 272 + wave * 32 + 16 + fr] = (bf16_t)(w >> 16);
                    const float q = sum16_dpp(v0 * v0 + v1 * v1);
                    if (fr == 0) SSQ[wave * 64 + t] = q; }
            __syncthreads();
#pragma unroll
            for (int i = 0; i < 4; ++i) { const int oid = tid + 512 * i, t = oid >> 5, oc = oid & 31;
                float ss = 0.f;
#pragma unroll
                for (int w = 0; w < 8; ++w) ss += SSQ[w * 64 + t];
                const float rs = __builtin_amdgcn_rsqf(ss * (1.0f / 256.0f) + 1e-6f);
                float ov[8], gv[8]; unpack8(*(const LAS u32x4*)(OB + t * 272 + oc * 8), ov); unpack8(gw[i], gv);
                const f32x4 n0 = *(const f32x4*)(gnorm + oc * 8), n1 = *(const f32x4*)(gnorm + oc * 8 + 4); const float gn[8] = {n0.x, n0.y, n0.z, n0.w, n1.x, n1.y, n1.z, n1.w};
#pragma unroll
                for (int e = 0; e < 8; ++e) ov[e] = ov[e] * rs * gn[e] * gv[e];
                *(u32x4*)(OG + (tok0 + t) * 1024 + h * 256 + oc * 8) = pack8(ov); }
        }
    }
    if (!FULL) {
        float* Lj = Lws + (size_t)(seq * GLA_NSEG + seg) * 32768 + (size_t)wave * 4096 + lane * 4;
#pragma unroll
        for (int dkt = 0; dkt < 8; ++dkt)
#pragma unroll
            for (int dvt = 0; dvt < 2; ++dvt) *(f32x4*)(Lj + (dkt * 2 + dvt) * 256) = S[dkt][dvt];
        if (fq == 0) Dws[(seq * GLA_NSEG + seg) * 128 + dkc] = __builtin_amdgcn_exp2f(1.4426950408889634f * segtot);
    }
#undef GLA_LOAD_QKV
}

#define XB_TMO      128
#define XB_XCNT(j)  (256  + 64 * (j))
#define XB_XSUB(j)  (1280 + 64 * (j))
#define XB_XGEN(j)  (2304 + 64 * (j))
#define XB_TOP      3328
#define XB_TOPGEN   3392
#define XCD_BAR_WORDS 3456
#define XB_SPIN_CAP (1u << 18)

__device__ __forceinline__ unsigned xb_ld(unsigned* p)              { return __hip_atomic_load(p, __ATOMIC_RELAXED, __HIP_MEMORY_SCOPE_AGENT); }
__device__ __forceinline__ unsigned xb_add(unsigned* p, unsigned v) { return __hip_atomic_fetch_add(p, v, __ATOMIC_RELAXED, __HIP_MEMORY_SCOPE_AGENT); }
__device__ __forceinline__ unsigned xb_xcc_id() { return (unsigned)__builtin_amdgcn_s_getreg((3 << 11) | 20) & 0xFu; }
#define XB_SPIN(cond, bar) do { unsigned _sp = 0; while (cond) { __builtin_amdgcn_s_sleep(1); \
    if ((++_sp & 255u) == 0u) { if (xb_ld(&(bar)[XB_TMO])) break; if (_sp > XB_SPIN_CAP) { atomicAdd(&(bar)[XB_TMO], 1u); break; } } } } while (0)

struct XcdBarrier {
    unsigned* bar; unsigned x;
    volatile LAS unsigned* st;
};

__device__ __forceinline__ XcdBarrier xcd_barrier_post(unsigned* bar, volatile LAS unsigned* st) {
    XcdBarrier b; b.bar = bar; b.x = xb_xcc_id(); b.st = st;
    if (threadIdx.x == 0) (void)xb_add(&bar[XB_XCNT(b.x)], 1u);
    return b;
}
__device__ __forceinline__ void xcd_barrier_complete(unsigned* bar, unsigned x, unsigned& nloc, unsigned& nx) {
    const unsigned G = gridDim.x * gridDim.y * gridDim.z;
    unsigned sum, cnt, mine, sp = 0u;
    for (;;) {
        sum = 0u; cnt = 0u; mine = 0u;
#pragma unroll
        for (unsigned j = 0; j < 16; ++j) { const unsigned c = xb_ld(&bar[XB_XCNT(j)]); sum += c; cnt += (c > 0u) ? 1u : 0u; mine = (j == x) ? c : mine; }
        if (sum == G) break;
        __builtin_amdgcn_s_sleep(1);
        if ((++sp & 255u) == 0u) { if (xb_ld(&bar[XB_TMO])) break; if (sp > XB_SPIN_CAP) { atomicAdd(&bar[XB_TMO], 1u); break; } }
    }
    nloc = mine > 0u ? mine : 1u; nx = cnt > 0u ? cnt : 1u;
}

__device__ __forceinline__ void xcd_barrier(const XcdBarrier& b) {
    asm volatile("s_waitcnt vmcnt(0)" ::: "memory");
    __syncthreads();
    if (threadIdx.x == 0) {
        unsigned* bar = b.bar;
        __builtin_amdgcn_s_waitcnt(0);
        unsigned nloc = b.st[0], nx = b.st[1];
        if (nloc == 0u) { xcd_barrier_complete(bar, b.x, nloc, nx); b.st[0] = nloc; b.st[1] = nx; }
        const unsigned old = xb_add(&bar[XB_XSUB(b.x)], 1u);
        const unsigned gen = old / nloc;
        if (old + 1u == (gen + 1u) * nloc) {
            __builtin_amdgcn_fence(__ATOMIC_RELEASE, "agent");
            asm volatile("s_waitcnt vmcnt(0)" ::: "memory");
            const unsigned og = xb_add(&bar[XB_TOP], 1u);
            const unsigned tg = og / nx;
            if (og + 1u == (tg + 1u) * nx) xb_add(&bar[XB_TOPGEN], 1u);
            else XB_SPIN(xb_ld(&bar[XB_TOPGEN]) == tg, bar);
            __builtin_amdgcn_fence(__ATOMIC_ACQUIRE, "agent");
            xb_add(&bar[XB_XGEN(b.x)], 1u);
            asm volatile("s_waitcnt vmcnt(0)" ::: "memory");
        } else {
            XB_SPIN(xb_ld(&bar[XB_XGEN(b.x)]) == gen, bar);
            __builtin_amdgcn_fence(__ATOMIC_ACQUIRE, "agent");
            asm volatile("s_waitcnt vmcnt(0)" ::: "memory");
        }
    }
    __syncthreads();
}


struct Args { const float* in[15]; float* out; unsigned char* ws; };
__global__ void __launch_bounds__(512) mk_fwd(Args a) {
    extern __shared__ __attribute__((aligned(16))) unsigned char lds_raw[];
    cg::grid_group grid = cg::this_grid();
    LAS unsigned char* lds = (LAS unsigned char*)lds_raw;
    const int tid = threadIdx.x, G = gridDim.x, blk = blockIdx.x;
    Ptrs P; P.x = a.in[0]; P.norm_mix = a.in[1]; P.w_in = a.in[2]; P.w_alpha2 = a.in[3]; P.b_alpha = a.in[4]; P.gla_norm = a.in[5]; P.swa_qn = a.in[6]; P.swa_kn = a.in[7]; P.sinks = a.in[8];
    P.w_bg = a.in[9]; P.w_bs = a.in[10]; P.w_out = a.in[11]; P.norm_mlp = a.in[12]; P.w_up = a.in[13]; P.w_down = a.in[14]; P.out = a.out; P.ws = a.ws;
    unsigned char* ws = a.ws;
    bf16_t* OGLA = (bf16_t*)a.out; bf16_t* OSWA = (bf16_t*)a.out + (size_t)M_TOK * 1024;
    float* SSQ = (float*)(ws + WS_SSQ); float* ALR = (float*)(ws + WS_ALR);

    volatile LAS unsigned* xst = (volatile LAS unsigned*)(lds + LDS_BYTES - 16);
    if (tid < 4) xst[tid] = 0u;
    __syncthreads();
    const XcdBarrier xbar = xcd_barrier_post((unsigned*)(ws + WS_BAR), xst);
    const bool use_cg = G > 1024;
#define GRID_BAR() xcd_barrier(xbar)
    if (PH_MASK & 1) for (int rep = 0; rep < REP_P0; ++rep) p0_prologue(P, lds, tid, G, blk);
    if (use_cg) grid.sync(); else xcd_barrier(xbar);
    if (PH_MASK & 2) {
        pg8::Gemm g{(const bf16_t*)a.out, (const bf16_t*)(ws + WS_WIN), M_TOK, NPROJ, 1024}; pg8::StaticOrder S; S.init(M_TOK, NPROJ, G, blk);
        pg8::EpiProj E{ws};
        for (int rep = 0; rep < REP_P1; ++rep)
        pg8::gemm_phase<pg8::EpiProj, pg8::StaticOrder, true, true>(lds, g, S, E);
    }
    GRID_BAR();
    {
        const bf16_t* QKp = (const bf16_t*)(ws + WS_QK); const bf16_t* GVp = (const bf16_t*)(ws + WS_GV); const bf16_t* GGp = (const bf16_t*)(ws + WS_GG);
        float* Lws = (float*)(ws + WS_GLAL); float* Dws = (float*)(ws + WS_GLAD);
        constexpr int NA = 32 * (GLA_NSEG - 1);
        for (int rep = 0; rep < REP_P2A; ++rep) {
        for (int rpa = 0; rpa < REP_PA; ++rpa)
        if (PH_MASK & 64) for (int it = blk; it < NA; it += G) { const int seq = it / (GLA_NSEG - 1), seg = it % (GLA_NSEG - 1);
            gla_seg<false>(seq >> 2, seq & 3, seg, QKp, GVp, GGp, ALR, P.w_alpha2, P.b_alpha, P.gla_norm, OGLA, Lws, Dws, lds, tid); }
        for (int rsw = 0; rsw < REP_SWA; ++rsw)
        if (PH_MASK & 128) {
            int u0, u1, ustep;
            if (G == 256) { if (blk >= NA) { u0 = (blk - NA) * 12; u1 = u0 + 12; } else if (blk < 96) { u0 = 384 + blk * 8; u1 = u0 + 8; } else { u0 = 1152 + (blk - 96) * 7; u1 = u0 + 7; } ustep = 1; }
            else { u0 = blk; u1 = 2048; ustep = G; }
            int tl = tid; asm volatile("" : "+v"(tl));
            const bf16_t* SQp = (const bf16_t*)(ws + WS_SQ); const bf16_t* SKVp = (const bf16_t*)(ws + WS_SKV);
            SwaRegs R;
            if (u0 < u1) swa_load(R, u0 >> 8, u0 & 63, (u0 >> 6) & 3, SQp, SKVp, tl);
#pragma unroll 1
            for (int u = u0; u < u1; u += ustep) { const int n = u & 63, kh = (u >> 6) & 3, b = u >> 8;
                const float M2 = swa_stage(R, P.swa_qn, P.swa_kn, lds, tl);
                __syncthreads();
                const int un = u + ustep;
                if (un < u1) swa_load(R, un >> 8, un & 63, (un >> 6) & 3, SQp, SKVp, tl);
                swa_compute(M2, b, n, kh, OSWA, P.sinks, lds, tl);
                __syncthreads();
                swa_store(b, n, kh, OSWA, lds, tl); }
            if (G == 256 && blk >= 96 && blk < NA && rsw == 0) {
                __syncthreads();
                const int wv = tl >> 6; LAS float* scr = (LAS float*)(lds + wv * 12288);
                for (int q = wv; q < 44; q += 8) transpose_rest_item(P, (blk - 96) * 44 + q, scr, tl & 63);
            }
        }
        }
        GRID_BAR();
        for (int rep = 0; rep < REP_P2B; ++rep)
        if (PH_MASK & 64) for (int it = blk; it < 32 * GLA_NSEG; it += G) { const int seq = it / GLA_NSEG, seg = it % GLA_NSEG;
            gla_seg<true>(seq >> 2, seq & 3, seg, QKp, GVp, GGp, ALR, P.w_alpha2, P.b_alpha, P.gla_norm, OGLA, Lws, Dws, lds, tid); }
    }
    GRID_BAR();
    if (PH_MASK & 8) {
        static_assert(WS_WBS == WS_WBG + (size_t)1024 * 1024 * 2, "Wbg^T and Wbs^T are one [2048][1024] matrix");
        pg8::PairOrder S; S.init(M_TOK, 1024, G, blk);
        pg8::Gemm g{OGLA, (const bf16_t*)(ws + WS_WBG), 2 * M_TOK, 2048, 1024};
        pg8::EpiGatePair E{{(const bf16_t*)(ws + WS_GA), (bf16_t*)(ws + WS_MERGED)}, {(const bf16_t*)(ws + WS_GB), (bf16_t*)(ws + WS_MERGED)}};
        pg8::gemm_phase<pg8::EpiGatePair, pg8::PairOrder, true, true>(lds, g, S, E);
    }
    GRID_BAR();
    if (PH_MASK & 16) {
        pg8::Gemm g{(const bf16_t*)(ws + WS_MERGED), (const bf16_t*)(ws + WS_WOUT), M_TOK, 1024, 1024}; pg8::StaticOrder S; S.init(M_TOK, 1024, G, blk);
        pg8::EpiRes E{P.x, (bf16_t*)(ws + WS_H1B), SSQ};
        pg8::gemm_phase<pg8::EpiRes, pg8::StaticOrder, true, true>(lds, g, S, E);
    }
    GRID_BAR();
    if (PH_MASK & 32) {
        pg8::Gemm g{(const bf16_t*)(ws + WS_H1B), (const bf16_t*)(ws + WS_WUP), M_TOK, DFF, 1024}; pg8::StaticOrder S; S.init(M_TOK, DFF, G, blk);
        pg8::EpiUp E{SSQ, (bf16_t*)(ws + WS_U)};
        pg8::gemm_phase<pg8::EpiUp, pg8::StaticOrder, true, true>(lds, g, S, E);
    }
    GRID_BAR();
    if (PH_MASK & 256) {
        pg8::Gemm g{(const bf16_t*)(ws + WS_U), (const bf16_t*)(ws + WS_WDN), M_TOK, 1024, DFF}; pg8::StaticOrder S; S.init(M_TOK, 1024, G, blk);
        pg8::EpiDown E{(const bf16_t*)(ws + WS_H1B), a.out};
        pg8::gemm_phase<pg8::EpiDown, pg8::StaticOrder, true, true>(lds, g, S, E);
    }
}

extern "C" void kernel_launch(void* const* d_in, const int* in_sizes, int n_in, void* d_out, int out_size, void* d_ws, size_t ws_size, hipStream_t stream) {
    static int grid = 0;
    if (grid == 0) {
        if (n_in != 15 || out_size != M_TOK * DM || ws_size < WS_END) { fprintf(stderr, "kernel_launch: unexpected shapes (n_in %d out %d ws %zu)\n", n_in, out_size, ws_size); grid = -1; return; }
        int dev = 0, cus = 0, per_cu = 0;
        hipGetDevice(&dev); hipDeviceGetAttribute(&cus, hipDeviceAttributeMultiprocessorCount, dev);
        if (hipFuncSetAttribute((const void*)mk_fwd, hipFuncAttributeMaxDynamicSharedMemorySize, LDS_BYTES) != hipSuccess) { fprintf(stderr, "kernel_launch: hipFuncSetAttribute failed\n"); grid = -1; return; }
        if (hipOccupancyMaxActiveBlocksPerMultiprocessor(&per_cu, (const void*)mk_fwd, 512, LDS_BYTES) != hipSuccess || per_cu < 1) { fprintf(stderr, "kernel_launch: occupancy query says %d\n", per_cu); per_cu = 1; }
        (void)hipGetLastError();
        grid = cus > 1024 ? 1024 : cus;
        if (grid < 64) { fprintf(stderr, "kernel_launch: only %d CUs\n", cus); grid = -1; return; }
    }
    if (grid < 0) return;
    if (hipMemsetAsync((char*)d_ws + WS_BAR, 0, BAR_BYTES, stream) != hipSuccess) { fprintf(stderr, "kernel_launch: hipMemsetAsync failed\n"); return; }
    Args a{};
    for (int i = 0; i < 15; ++i) a.in[i] = (const float*)d_in[i];
    a.out = (float*)d_out; a.ws = (unsigned char*)d_ws;
    void* args[] = {&a};
    hipError_t e = hipLaunchCooperativeKernel((const void*)mk_fwd, dim3(grid), dim3(512), args, LDS_BYTES, stream);
    if (e != hipSuccess) fprintf(stderr, "kernel_launch: cooperative launch failed: %s (grid %d)\n", hipGetErrorString(e), grid);
}
```

```cpp
#include <hip/hip_runtime.h>
#include <hip/hip_cooperative_groups.h>
#include <cstdio>
#include <cstdint>
namespace cg = cooperative_groups;

constexpr int M_TOK = 32768, DM = 1024, SEQ_T = 4096, NPROJ = 6656, DFF = 4096;
constexpr size_t MiB = 1u << 20;
constexpr size_t WS_SSQ = 0;
constexpr size_t WS_BAR = 1 * MiB, BAR_BYTES = 16384;
constexpr size_t WS_WIN = 2 * MiB, WS_WBG = 16 * MiB, WS_WBS = 18 * MiB, WS_WOUT = 20 * MiB, WS_WUP = 22 * MiB, WS_WDN = 30 * MiB;
constexpr size_t WS_ALR = 38 * MiB;
constexpr size_t WS_QK = 40 * MiB, WS_GV = 104 * MiB, WS_GG = 168 * MiB, WS_SQ = 232 * MiB;
constexpr size_t WS_SKV = 296 * MiB;
constexpr size_t WS_GA = 328 * MiB, WS_GB = 392 * MiB;
constexpr size_t WS_MERGED = 40 * MiB;
constexpr size_t WS_H1B = 104 * MiB;
constexpr size_t WS_U = 168 * MiB;
constexpr size_t WS_GLAL = 456 * MiB, WS_GLAD = 488 * MiB;
constexpr size_t WS_END = 489 * MiB;
constexpr int LDS_BYTES = 147456;
#ifndef REP_P0
#define REP_P0 1
#endif
#ifndef REP_P1
#define REP_P1 1
#endif
#ifndef REP_PA
#define REP_PA 1
#endif
#ifndef REP_SWA
#define REP_SWA 1
#endif
#ifndef REP_P2A
#define REP_P2A 1
#endif
#ifndef REP_P2B
#define REP_P2B 1
#endif
#ifndef PH_MASK
#define PH_MASK 0x1ff
#endif
#define LAS __attribute__((address_space(3)))
namespace pg8 {
#define PG8_LAS __attribute__((address_space(3)))
typedef unsigned short bf16_t;
typedef short bf16x8 __attribute__((ext_vector_type(8)));
typedef float f32x4 __attribute__((ext_vector_type(4)));
typedef unsigned u32x4 __attribute__((ext_vector_type(4)));
constexpr int BM = 256, BK = 64, HALF = 128, HTB = HALF * BK * 2  , STAGE_BYTES = 8 * HTB, NXCD = 8, WGM = 8;

__host__ __device__ __forceinline__ int lds_byte(int r, int c) { const int st = (r >> 4) * 2 + (c >> 5), rr = r & 15, cc = c & 31, ob = rr * 64 + cc * 2; return st * 1024 + (ob ^ (((ob >> 9) & 1) << 5)); }
__host__ __device__ __forceinline__ void stage_rc(int b, int& R, int& C) { const int st = b / 1024, sb = b % 1024, swz = sb ^ (((sb >> 9) & 1) << 5); R = (st >> 1) * 16 + swz / 64; C = (st & 1) * 32 + (swz % 64) / 2; }
__host__ __device__ __forceinline__ int perm32(int rho) { const int n = rho >> 4, i = rho & 15; return 8 * (i >> 2) + 4 * n + (i & 3); }

struct Unit { int pm, pn; };
struct Gemm { const bf16_t* A; const bf16_t* Bt; int M, N, K; };

struct StaticOrder {
    int nM, nN, nwg, G, c;
    __host__ __device__ void init(int M, int N, int G_, int c_) { nM = M / BM; nN = N / BM; nwg = nM * nN; G = G_; c = c_; }
    __host__ __device__ bool next(int i, Unit& u) const {
        const long L = (long)i * G + c; if (L >= nwg) return false;
        int wgid = (int)L; { const int q = nwg / NXCD, r = nwg % NXCD, xcd = wgid % NXCD, off = wgid / NXCD; wgid = (xcd < r ? xcd * (q + 1) : r * (q + 1) + (xcd - r) * q) + off; }
        const int nig = WGM * nN, gid = wgid / nig, fm = gid * WGM, gsz = (nM - fm) < WGM ? (nM - fm) : WGM;
        u.pm = fm + ((wgid % nig) % gsz); u.pn = (wgid % nig) / gsz; return true;
    }
    __device__ __forceinline__ void a_ready(const Unit&) const {}
    __device__ __forceinline__ void done(const Unit&) const {}
};
__device__ __forceinline__ unsigned cvt_pk_bf16(float lo, float hi) { unsigned r; asm volatile("v_cvt_pk_bf16_f32 %0, %1, %2" : "=v"(r) : "v"(lo), "v"(hi)); return r; }
typedef float f32x2c __attribute__((ext_vector_type(2))); typedef __bf16 bf16x2c __attribute__((ext_vector_type(2)));
__device__ __forceinline__ unsigned cvt_pk_bf16_v(float lo, float hi) { const f32x2c v = {lo, hi}; const bf16x2c b = __builtin_convertvector(v, bf16x2c); return __builtin_bit_cast(unsigned, b); }
__device__ __forceinline__ float bflo(unsigned w) { return __uint_as_float(w << 16); }
__device__ __forceinline__ float bfhi(unsigned w) { return __uint_as_float(w & 0xffff0000u); }
__device__ __forceinline__ void unpack8(const u32x4 w, float (&f)[8]) { f[0] = bflo(w.x); f[1] = bfhi(w.x); f[2] = bflo(w.y); f[3] = bfhi(w.y); f[4] = bflo(w.z); f[5] = bfhi(w.z); f[6] = bflo(w.w); f[7] = bfhi(w.w); }
__device__ __forceinline__ u32x4 pack8(const float (&f)[8]) { u32x4 w; w.x = cvt_pk_bf16(f[0], f[1]); w.y = cvt_pk_bf16(f[2], f[3]); w.z = cvt_pk_bf16(f[4], f[5]); w.w = cvt_pk_bf16(f[6], f[7]); return w; }
__device__ __forceinline__ float sigm(float x) { return __builtin_amdgcn_rcpf(1.f + __builtin_amdgcn_exp2f(-1.4426950408889634f * x)); }

struct EpiProj {
    static constexpr bool PERM = true, AFTER_DRAIN = false;
    unsigned char* ws;
    __device__ __forceinline__ void operator()(const f32x4 (&acc)[2][2][4][2], const Unit& u, int wr, int wc, int fr, int fq) const {
        const int pn = u.pn; const int row0 = u.pm * BM + wr * 64 + fr;
        size_t off; int ldc = 1024, colt, act = 0;
        if (pn < 16) { off = WS_QK + (size_t)(pn >> 2) * (64 * MiB); colt = (pn & 3) * 256; if ((pn >> 2) == 2) act = 2; }
        else if (pn < 18) { off = WS_SKV; ldc = 512; colt = (pn - 16) * 256; }
        else if (pn < 22) { off = WS_GA; colt = (pn - 18) * 256; act = 1; }
        else { off = WS_GB; colt = (pn - 22) * 256; act = 1; }
        bf16_t* base = (bf16_t*)(ws + off);
        const int col0 = colt + wc * 32 + 8 * fq;
#pragma unroll
        for (int ai = 0; ai < 2; ++ai)
#pragma unroll
            for (int m = 0; m < 4; ++m) { bf16_t* rowp = base + (size_t)(row0 + ai * HALF + m * 16) * ldc + col0;
#pragma unroll
                for (int bj = 0; bj < 2; ++bj) { const f32x4 v0 = acc[ai][bj][m][0], v1 = acc[ai][bj][m][1];
                    float f[8] = {v0[0], v0[1], v0[2], v0[3], v1[0], v1[1], v1[2], v1[3]};
                    if (act == 1) {
#pragma unroll
                        for (int e = 0; e < 8; ++e) f[e] = sigm(f[e]);
                    } else if (act == 2) {
#pragma unroll
                        for (int e = 0; e < 8; ++e) f[e] = f[e] * sigm(f[e]);
                    }
                    __builtin_nontemporal_store(pack8(f), (u32x4*)(rowp + bj * HALF)); } }
    }
};
template <bool FIRST> struct EpiGate {
    static constexpr bool PERM = true, AFTER_DRAIN = false;
    const bf16_t* gate; bf16_t* merged;
    __device__ __forceinline__ void operator()(const f32x4 (&acc)[2][2][4][2], const Unit& u, int wr, int wc, int fr, int fq) const {
        const int row0 = u.pm * BM + wr * 64 + fr, col0 = u.pn * BM + wc * 32 + 8 * fq;
#pragma unroll
        for (int ai = 0; ai < 2; ++ai)
#pragma unroll
            for (int m = 0; m < 4; ++m) { const size_t idx = (size_t)(row0 + ai * HALF + m * 16) * 1024 + col0;
#pragma unroll
                for (int bj = 0; bj < 2; ++bj) { const f32x4 v0 = acc[ai][bj][m][0], v1 = acc[ai][bj][m][1];
                    float f[8] = {v0[0], v0[1], v0[2], v0[3], v1[0], v1[1], v1[2], v1[3]}; float g[8];
                    unpack8(__builtin_nontemporal_load((const u32x4*)(gate + idx + bj * HALF)), g);
#pragma unroll
                    for (int e = 0; e < 8; ++e) f[e] *= g[e];
                    if (!FIRST) { float p[8]; unpack8(*(const u32x4*)(merged + idx + bj * HALF), p);
#pragma unroll
                        for (int e = 0; e < 8; ++e) f[e] += p[e]; }
                    *(u32x4*)(merged + idx + bj * HALF) = pack8(f); } }
    }
};
struct PairOrder {
    StaticOrder base;
    __host__ __device__ void init(int M, int N, int G_, int c_) { base.init(M, N, G_, c_); }
    __host__ __device__ bool next(int i, Unit& u) const { Unit v; if (!base.next(i >> 1, v)) return false; u.pm = v.pm + ((i & 1) ? 128 : 0); u.pn = v.pn + ((i & 1) ? 4 : 0); return true; }
    __device__ __forceinline__ void a_ready(const Unit&) const {}
    __device__ __forceinline__ void done(const Unit&) const {}
};
struct EpiGatePair {
    static constexpr bool PERM = true, AFTER_DRAIN = false;
    EpiGate<true> e0; EpiGate<false> e1;
    __device__ __forceinline__ void operator()(const f32x4 (&acc)[2][2][4][2], const Unit& u, int wr, int wc, int fr, int fq) const {
        if (u.pm < 128) e0(acc, u, wr, wc, fr, fq); else { const Unit v{u.pm - 128, u.pn - 4}; e1(acc, v, wr, wc, fr, fq); }
    }
};
struct EpiRes {
    static constexpr bool PERM = true, AFTER_DRAIN = false;
    const float* x; bf16_t* h1b; float* ssq;
    __device__ __forceinline__ void operator()(const f32x4 (&acc)[2][2][4][2], const Unit& u, int wr, int wc, int fr, int fq) const {
        const int row0 = u.pm * BM + wr * 64 + fr, col0 = u.pn * BM + wc * 32 + 8 * fq;
#pragma unroll
        for (int ai = 0; ai < 2; ++ai)
#pragma unroll
            for (int m = 0; m < 4; ++m) { const int row = row0 + ai * HALF + m * 16; const size_t idx = (size_t)row * 1024 + col0; float ss = 0.f;
#pragma unroll
                for (int bj = 0; bj < 2; ++bj) { const f32x4 x0 = __builtin_nontemporal_load((const f32x4*)(x + idx + bj * HALF)), x1 = __builtin_nontemporal_load((const f32x4*)(x + idx + bj * HALF + 4));
                    const f32x4 h0 = x0 + acc[ai][bj][m][0], h1v = x1 + acc[ai][bj][m][1];
                    float f[8] = {h0[0], h0[1], h0[2], h0[3], h1v[0], h1v[1], h1v[2], h1v[3]};
#pragma unroll
                    for (int e = 0; e < 8; ++e) ss += f[e] * f[e];
                    *(u32x4*)(h1b + idx + bj * HALF) = pack8(f); }
                ss += __shfl_xor(ss, 16); ss += __shfl_xor(ss, 32);
                if (fq == 0) atomicAdd(ssq + row, ss); }
    }
};
struct EpiUp {
    static constexpr bool PERM = true, AFTER_DRAIN = false;
    const float* ssq; bf16_t* U;
    __device__ __forceinline__ void operator()(const f32x4 (&acc)[2][2][4][2], const Unit& u, int wr, int wc, int fr, int fq) const {
        const int row0 = u.pm * BM + wr * 64 + fr, col0 = u.pn * BM + wc * 32 + 8 * fq;
#pragma unroll
        for (int ai = 0; ai < 2; ++ai)
#pragma unroll
            for (int m = 0; m < 4; ++m) { const int row = row0 + ai * HALF + m * 16; const float rs = __builtin_amdgcn_rsqf(ssq[row] * (1.0f / 1024.0f) + 1e-6f); bf16_t* rowp = U + (size_t)row * 4096 + col0;
#pragma unroll
                for (int bj = 0; bj < 2; ++bj) { const f32x4 v0 = acc[ai][bj][m][0], v1 = acc[ai][bj][m][1];
                    float f[8] = {v0[0], v0[1], v0[2], v0[3], v1[0], v1[1], v1[2], v1[3]};
#pragma unroll
                    for (int e = 0; e < 8; ++e) { const float r = fmaxf(f[e] * rs, 0.f); f[e] = r * r; }
                    *(u32x4*)(rowp + bj * HALF) = pack8(f); } }
    }
};
struct EpiDown {
    static constexpr bool PERM = true, AFTER_DRAIN = false;
    const bf16_t* h1b; float* out;
    __device__ __forceinline__ void operator()(const f32x4 (&acc)[2][2][4][2], const Unit& u, int wr, int wc, int fr, int fq) const {
        const int row0 = u.pm * BM + wr * 64 + fr, col0 = u.pn * BM + wc * 32 + 8 * fq;
#pragma unroll
        for (int ai = 0; ai < 2; ++ai)
#pragma unroll
            for (int m = 0; m < 4; ++m) { const size_t idx = (size_t)(row0 + ai * HALF + m * 16) * 1024 + col0;
#pragma unroll
                for (int bj = 0; bj < 2; ++bj) { float h[8]; unpack8(__builtin_nontemporal_load((const u32x4*)(h1b + idx + bj * HALF)), h);
                    const f32x4 a0 = acc[ai][bj][m][0], a1 = acc[ai][bj][m][1];
                    __builtin_nontemporal_store(((f32x4){h[0] + a0[0], h[1] + a0[1], h[2] + a0[2], h[3] + a0[3]}), (f32x4*)(out + idx + bj * HALF));
                    __builtin_nontemporal_store(((f32x4){h[4] + a1[0], h[5] + a1[1], h[6] + a1[2], h[7] + a1[3]}), (f32x4*)(out + idx + bj * HALF + 4)); } }
    }
};
template <class Epi, class Sched, bool ALIGN_EPI = false, bool SP2 = false>
__device__ __forceinline__ void gemm_phase(PG8_LAS unsigned char* lds, const Gemm g, const Sched& S, const Epi& E) {
    int tid_ = threadIdx.x; asm volatile("" : "+v"(tid_));
    const int tid = tid_, wid = __builtin_amdgcn_readfirstlane(tid >> 6), lane = tid & 63, wr = wid >> 2, wc = wid & 3, fr = lane & 15, fq = lane >> 4;
    const int K = g.K, nt = K / BK;
    unsigned voffA[2], voffB[2];
#pragma unroll
    for (int i = 0; i < 2; ++i) { int R, C; stage_rc(tid * 16 + i * 8192, R, C); const int Rb = Epi::PERM ? ((R & ~31) + perm32(R & 31)) : R;
        voffA[i] = (unsigned)(R * K + C) * 2u; voffB[i] = (unsigned)(Rb * K + C) * 2u; }
    const size_t kstep = (size_t)(BK * 2);
    const size_t hstep = (size_t)HALF * K * 2;
    const size_t tstep = 2 * hstep;
    const unsigned ldsw = (unsigned)wid * 1024u;
    const int aoff = lds_byte(wr * 64 + fr, fq * 8), boff = lds_byte(wc * 32 + fr, fq * 8);
#define PG8_SA(b, h) (((b) * 2 + (h)) * HTB)
#define PG8_SB(b, h) ((4 + (b) * 2 + (h)) * HTB)
#define PG8_STAGE(bufoff, gbase, voff) do { _Pragma("unroll") for (int _i = 0; _i < 2; ++_i) \
        __builtin_amdgcn_global_load_lds((const unsigned*)((const char*)(gbase) + (voff)[_i]), (PG8_LAS unsigned*)(lds + (bufoff) + ldsw + _i * 8192), 16, 0, 0); } while (0)
#define PG8_LDA(dst, b, h) do { _Pragma("unroll") for (int m = 0; m < 4; ++m) _Pragma("unroll") for (int k = 0; k < 2; ++k) dst[m][k] = *(const PG8_LAS bf16x8*)(lds + PG8_SA(b, h) + aoff + m * 2048 + k * 1024); } while (0)
#define PG8_LDB(dst, b, h) do { _Pragma("unroll") for (int n = 0; n < 2; ++n) _Pragma("unroll") for (int k = 0; k < 2; ++k) dst[n][k] = *(const PG8_LAS bf16x8*)(lds + PG8_SB(b, h) + boff + n * 2048 + k * 1024); } while (0)
#define PG8_MMA(ai, bj, At, Bt) do { __builtin_amdgcn_s_setprio(1); _Pragma("unroll") for (int m = 0; m < 4; ++m) _Pragma("unroll") for (int n = 0; n < 2; ++n) _Pragma("unroll") for (int k = 0; k < 2; ++k) \
        acc[ai][bj][m][n] = __builtin_amdgcn_mfma_f32_16x16x32_bf16(Bt[n][k], At[m][k], acc[ai][bj][m][n], 0, 0, 0); __builtin_amdgcn_s_setprio(0); } while (0)
#define PG8_WAIT_V(n) asm volatile("s_waitcnt vmcnt(" #n ")" ::: "memory")
#define PG8_WAIT_L(n) asm volatile("s_waitcnt lgkmcnt(" #n ")" ::: "memory")
#define PG8_BAR __builtin_amdgcn_s_barrier()
#define PG8_SCHED __builtin_amdgcn_sched_barrier(0)
    Unit cur, nxt; int ui = 0;
    if (!S.next(0, cur)) return;
    f32x4 acc[2][2][4][2];
#pragma unroll
    for (int a = 0; a < 2; ++a)
#pragma unroll
        for (int b = 0; b < 2; ++b)
#pragma unroll
            for (int m = 0; m < 4; ++m)
#pragma unroll
                for (int n = 0; n < 2; ++n) acc[a][b][m][n] = (f32x4){0.f, 0.f, 0.f, 0.f};
    bf16x8 At[4][2], B0[2][2], B1[2][2];
    const char* cA = (const char*)g.A + (size_t)cur.pm * tstep; const char* cB = (const char*)g.Bt + (size_t)cur.pn * tstep;
    S.a_ready(cur);
    if constexpr (SP2) {
        PG8_STAGE(PG8_SB(0, 0), cB, voffB); PG8_STAGE(PG8_SB(0, 1), cB + hstep, voffB); PG8_STAGE(PG8_SA(0, 0), cA, voffA); PG8_STAGE(PG8_SA(0, 1), cA + hstep, voffA);
        if (wr == 1) PG8_BAR;
        PG8_WAIT_V(2); PG8_BAR;
        PG8_STAGE(PG8_SB(1, 0), cB + kstep, voffB); PG8_STAGE(PG8_SA(1, 0), cA + kstep, voffA); PG8_STAGE(PG8_SB(1, 1), cB + hstep + kstep, voffB);
        PG8_WAIT_V(6); PG8_BAR;
    } else {
        PG8_STAGE(PG8_SB(0, 0), cB, voffB); PG8_STAGE(PG8_SA(0, 0), cA, voffA); PG8_STAGE(PG8_SB(0, 1), cB + hstep, voffB); PG8_STAGE(PG8_SA(0, 1), cA + hstep, voffA);
        if (wr == 1) PG8_BAR;
        PG8_WAIT_V(4); PG8_BAR;
        PG8_STAGE(PG8_SB(1, 0), cB + kstep, voffB); PG8_STAGE(PG8_SA(1, 0), cA + kstep, voffA); PG8_STAGE(PG8_SB(1, 1), cB + hstep + kstep, voffB);
        PG8_WAIT_V(6); PG8_BAR;
    }
    for (;;) {
        const bool has_next = S.next(ui + 1, nxt);
        const char* nA = has_next ? (const char*)g.A + (size_t)nxt.pm * tstep : cA; const char* nB = has_next ? (const char*)g.Bt + (size_t)nxt.pn * tstep : cB;
        for (int t = 0; t < nt; t += 2) {
            const bool last = (t == nt - 2);
            const char* a1 = cA + (size_t)(t + 1) * kstep;
            const char* a2 = last ? nA : cA + (size_t)(t + 2) * kstep; const char* b2 = last ? nB : cB + (size_t)(t + 2) * kstep;
            const char* a3 = a2 + kstep; const char* b3 = b2 + kstep;
            if (last && has_next) S.a_ready(nxt);
            if constexpr (SP2) {
            PG8_LDB(B0, 0, 0); PG8_LDB(B1, 0, 1); PG8_SCHED; PG8_LDA(At, 0, 0); PG8_STAGE(PG8_SA(1, 1), a1 + hstep, voffA);
            PG8_WAIT_V(8); PG8_WAIT_L(0); PG8_BAR; PG8_MMA(0, 0, At, B0); PG8_MMA(0, 1, At, B1); PG8_BAR; PG8_SCHED;
            PG8_LDA(At, 0, 1); PG8_STAGE(PG8_SB(0, 0), b2, voffB); PG8_STAGE(PG8_SB(0, 1), b2 + hstep, voffB); PG8_STAGE(PG8_SA(0, 0), a2, voffA);
            PG8_WAIT_V(8); PG8_WAIT_L(0); PG8_BAR; PG8_MMA(1, 0, At, B0); PG8_MMA(1, 1, At, B1); PG8_BAR; PG8_SCHED;
            PG8_LDB(B0, 1, 0); PG8_LDB(B1, 1, 1); PG8_SCHED; PG8_LDA(At, 1, 0); PG8_STAGE(PG8_SA(0, 1), a2 + hstep, voffA);
            PG8_WAIT_V(8); PG8_WAIT_L(0); PG8_BAR; PG8_MMA(0, 0, At, B0); PG8_MMA(0, 1, At, B1); PG8_BAR; PG8_SCHED;
            PG8_LDA(At, 1, 1); PG8_STAGE(PG8_SB(1, 0), b3, voffB); PG8_STAGE(PG8_SB(1, 1), b3 + hstep, voffB); PG8_STAGE(PG8_SA(1, 0), a3, voffA);
            PG8_WAIT_V(8); PG8_WAIT_L(0); PG8_BAR; PG8_MMA(1, 0, At, B0); PG8_MMA(1, 1, At, B1); PG8_BAR; PG8_SCHED;
            } else {
            PG8_LDB(B0, 0, 0); PG8_SCHED; PG8_LDA(At, 0, 0); PG8_STAGE(PG8_SA(1, 1), a1 + hstep, voffA);
            PG8_WAIT_L(8); PG8_BAR; PG8_WAIT_L(0); PG8_MMA(0, 0, At, B0); PG8_BAR; PG8_SCHED;
            PG8_LDB(B1, 0, 1); PG8_STAGE(PG8_SB(0, 0), b2, voffB);
            PG8_BAR; PG8_WAIT_L(0); PG8_MMA(0, 1, At, B1); PG8_BAR;
            PG8_LDA(At, 0, 1); PG8_STAGE(PG8_SA(0, 0), a2, voffA);
            PG8_BAR; PG8_WAIT_L(0); PG8_MMA(1, 0, At, B0); PG8_BAR; PG8_SCHED;
            PG8_STAGE(PG8_SB(0, 1), b2 + hstep, voffB);
            PG8_WAIT_V(6); PG8_BAR; PG8_MMA(1, 1, At, B1); PG8_BAR;
            PG8_LDB(B0, 1, 0); PG8_SCHED; PG8_LDA(At, 1, 0); PG8_STAGE(PG8_SA(0, 1), a2 + hstep, voffA);
            PG8_WAIT_L(8); PG8_BAR; PG8_WAIT_L(0); PG8_MMA(0, 0, At, B0); PG8_BAR; PG8_SCHED;
            PG8_LDB(B1, 1, 1); PG8_STAGE(PG8_SB(1, 0), b3, voffB);
            PG8_BAR; PG8_WAIT_L(0); PG8_MMA(0, 1, At, B1); PG8_BAR;
            PG8_LDA(At, 1, 1); PG8_STAGE(PG8_SA(1, 0), a3, voffA);
            PG8_BAR; PG8_WAIT_L(0); PG8_MMA(1, 0, At, B0); PG8_BAR; PG8_SCHED;
            PG8_STAGE(PG8_SB(1, 1), b3 + hstep, voffB);
            PG8_WAIT_V(6); PG8_BAR; PG8_MMA(1, 1, At, B1); PG8_BAR;
            }
        }
        if constexpr (ALIGN_EPI) { if (wr == 0) PG8_BAR; }
        if constexpr (!Epi::AFTER_DRAIN) { E(acc, cur, wr, wc, fr, fq); S.done(cur); }
        if (!has_next) break;
#pragma unroll
        for (int a = 0; a < 2; ++a)
#pragma unroll
            for (int b = 0; b < 2; ++b)
#pragma unroll
                for (int m = 0; m < 4; ++m)
#pragma unroll
                    for (int n = 0; n < 2; ++n) acc[a][b][m][n] = (f32x4){0.f, 0.f, 0.f, 0.f};
        cur = nxt; cA = nA; cB = nB; ++ui;
        if constexpr (ALIGN_EPI) { if (wr == 1) PG8_BAR; }
    }
    PG8_WAIT_V(0);
    if constexpr (!ALIGN_EPI) { if (wr == 0) PG8_BAR; }
    PG8_BAR;
    if constexpr (Epi::AFTER_DRAIN) { E.fused(acc, cur, wr, wc, fr, fq, lds, wid, lane); S.done(cur); }
#undef PG8_SA
#undef PG8_SB
#undef PG8_STAGE
#undef PG8_LDA
#undef PG8_LDB
#undef PG8_MMA
#undef PG8_WAIT_V
#undef PG8_WAIT_L
#undef PG8_BAR
#undef PG8_SCHED
}
}

using pg8::bf16_t; using pg8::bf16x8; using pg8::f32x4; using pg8::u32x4; using pg8::unpack8; using pg8::pack8;
typedef unsigned u32x2 __attribute__((ext_vector_type(2)));
#define MFMA16(a, b, c) __builtin_amdgcn_mfma_f32_16x16x32_bf16((a), (b), (c), 0, 0, 0)
__device__ __forceinline__ unsigned pk2(float lo, float hi) { return pg8::cvt_pk_bf16(lo, hi); }
__device__ __forceinline__ unsigned pk2v(float lo, float hi) { return pg8::cvt_pk_bf16_v(lo, hi); }
__device__ __forceinline__ u32x4 pack8v(const float (&f)[8]) { u32x4 w; w.x = pk2v(f[0], f[1]); w.y = pk2v(f[2], f[3]); w.z = pk2v(f[4], f[5]); w.w = pk2v(f[6], f[7]); return w; }
__device__ __forceinline__ float wave_sum(float v) {
#pragma unroll
    for (int o = 1; o < 64; o <<= 1) v += __shfl_xor(v, o);
    return v;
}
#define LDS_WAIT() asm volatile("s_waitcnt lgkmcnt(0)" ::: "memory")
template <int CTRL> __device__ __forceinline__ float dpp_mov(float v) { return __builtin_bit_cast(float, __builtin_amdgcn_update_dpp(0, __builtin_bit_cast(int, v), CTRL, 0xf, 0xf, true)); }
__device__ __forceinline__ float sum8_dpp(float v) { v += dpp_mov<0xB1>(v); v += dpp_mov<0x4E>(v); v += dpp_mov<0x141>(v); return v; }
__device__ __forceinline__ float max8_dpp(float v) { v = fmaxf(v, dpp_mov<0xB1>(v)); v = fmaxf(v, dpp_mov<0x4E>(v)); v = fmaxf(v, dpp_mov<0x141>(v)); return v; }
__device__ __forceinline__ float sum16_dpp(float v) { v = sum8_dpp(v); v += dpp_mov<0x140>(v); return v; }

__device__ __forceinline__ void transpose_item(const float* __restrict__ W, int ldw, int K, bf16_t* WT, int dst_row0, int src_col0, int nvalid, const float* __restrict__ kscale, int k0, LAS float* scr, int lane) {
    const int c4 = lane & 7, kr = lane >> 3;
    f32x4 v[8];
#pragma unroll
    for (int i = 0; i < 8; ++i) { v[i] = (f32x4){0.f, 0.f, 0.f, 0.f};
        if (4 * c4 < nvalid) v[i] = __builtin_nontemporal_load((const f32x4*)(W + (size_t)(k0 + kr + 8 * i) * ldw + src_col0 + 4 * c4)); }
    if (kscale) {
#pragma unroll
        for (int i = 0; i < 8; ++i) v[i] = v[i] * kscale[k0 + kr + 8 * i];
    }
#pragma unroll
    for (int i = 0; i < 8; ++i) { LAS float* d = scr + (kr + 8 * i) * 33 + 4 * c4; d[0] = v[i].x; d[1] = v[i].y; d[2] = v[i].z; d[3] = v[i].w; }
    LDS_WAIT(); asm volatile("" ::: "memory");
    const int ch = lane & 7;
#pragma unroll
    for (int j = 0; j < 4; ++j) { const int n = (lane >> 3) + 8 * j; const LAS float* s = scr + (8 * ch) * 33 + n;
        u32x4 o; o.x = pk2(s[0 * 33], s[1 * 33]); o.y = pk2(s[2 * 33], s[3 * 33]); o.z = pk2(s[4 * 33], s[5 * 33]); o.w = pk2(s[6 * 33], s[7 * 33]);
        *(u32x4*)(WT + (size_t)(dst_row0 + n) * K + k0 + 8 * ch) = o; }
    LDS_WAIT(); asm volatile("" ::: "memory");
}
struct Ptrs {
    const float *x, *norm_mix, *w_in, *w_alpha2, *b_alpha, *gla_norm, *swa_qn, *swa_kn, *sinks, *w_bg, *w_bs, *w_out, *norm_mlp, *w_up, *w_down;
    float* out; unsigned char* ws;
};
constexpr int P0_I_SQ = 16 * 32, P0_I_UP = 16 * 128, P0_I_DN = 64 * 32, P0_REST_ITEMS = 3 * P0_I_SQ + P0_I_UP + P0_I_DN;
__device__ __forceinline__ void transpose_rest_item(const Ptrs& P, int r, LAS float* scr, int lane) {
    if (r < P0_I_SQ) { transpose_item(P.w_bg, 1024, 1024, (bf16_t*)(P.ws + WS_WBG), 32 * (r % 32), 32 * (r % 32), 32, nullptr, 64 * (r / 32), scr, lane); return; } r -= P0_I_SQ;
    if (r < P0_I_SQ) { transpose_item(P.w_bs, 1024, 1024, (bf16_t*)(P.ws + WS_WBS), 32 * (r % 32), 32 * (r % 32), 32, nullptr, 64 * (r / 32), scr, lane); return; } r -= P0_I_SQ;
    if (r < P0_I_SQ) { transpose_item(P.w_out, 1024, 1024, (bf16_t*)(P.ws + WS_WOUT), 32 * (r % 32), 32 * (r % 32), 32, nullptr, 64 * (r / 32), scr, lane); return; } r -= P0_I_SQ;
    if (r < P0_I_UP) { transpose_item(P.w_up, 4096, 1024, (bf16_t*)(P.ws + WS_WUP), 32 * (r % 128), 32 * (r % 128), 32, P.norm_mlp, 64 * (r / 128), scr, lane); return; } r -= P0_I_UP;
    transpose_item(P.w_down, 1024, 4096, (bf16_t*)(P.ws + WS_WDN), 32 * (r % 32), 32 * (r % 32), 32, nullptr, 64 * (r / 32), scr, lane);
}
__device__ __forceinline__ void p0_prologue(const Ptrs& P, LAS unsigned char* lds, int tid, int G, int blk) {
    const int lane = tid & 63, wave = tid >> 6;
    LAS float* scr = (LAS float*)(lds + wave * 12288);
    const int gw = blk * 8 + wave, NGW = G * 8;
    LAS bf16_t* WA = (LAS bf16_t*)(lds + 98304);
    for (int idx = tid; idx < 4096; idx += 512) { const int k = idx >> 2, c = (idx & 3) * 4; const f32x4 w = *(const f32x4*)(P.w_in + (size_t)k * 6672 + 3072 + c); const unsigned p0 = pk2(w.x, w.y), p1 = pk2(w.z, w.w);
        WA[(c + 0) * 1032 + k] = (bf16_t)(p0 & 0xffffu); WA[(c + 1) * 1032 + k] = (bf16_t)(p0 >> 16); WA[(c + 2) * 1032 + k] = (bf16_t)(p1 & 0xffffu); WA[(c + 3) * 1032 + k] = (bf16_t)(p1 >> 16); }
    __syncthreads();
    constexpr int I_IN = 16 * (NPROJ / 32);
    const int nitems = (G == 256) ? I_IN : I_IN + P0_REST_ITEMS;
    for (int it = gw; it < nitems; it += NGW) {
        if (it < I_IN) { const int nblk = NPROJ / 32, kb = it / nblk, nb = it % nblk, d = 32 * nb; int src, nv;
            if (d < 3072) { src = d; nv = 32; } else { src = d + 16; nv = 32; }
            transpose_item(P.w_in, 6672, 1024, (bf16_t*)(P.ws + WS_WIN), d, src, nv, nullptr, 64 * kb, scr, lane); continue; }
        transpose_rest_item(P, it - I_IN, scr, lane);
    }
    bf16_t* hn = (bf16_t*)P.out; float* alr = (float*)(P.ws + WS_ALR);
    LAS bf16_t* SR = (LAS bf16_t*)scr;
    const int fr = lane & 15, fq = lane >> 4;
    f32x4 gm[4];
#pragma unroll
    for (int j = 0; j < 4; ++j) gm[j] = *(const f32x4*)(P.norm_mix + 4 * lane + 256 * j);
    for (int m0 = gw * 4; m0 < M_TOK; m0 += NGW * 4) {
        f32x4 v[4][4];
#pragma unroll
        for (int r = 0; r < 4; ++r) { const f32x4* xr = (const f32x4*)(P.x + (size_t)(m0 + r) * DM) + lane;
#pragma unroll
            for (int j = 0; j < 4; ++j) v[r][j] = __builtin_nontemporal_load(xr + 64 * j); }
#pragma unroll
        for (int r = 0; r < 4; ++r) { float s = 0.f;
#pragma unroll
            for (int j = 0; j < 4; ++j) s += (v[r][j].x * v[r][j].x + v[r][j].y * v[r][j].y) + (v[r][j].z * v[r][j].z + v[r][j].w * v[r][j].w);
            const float rs = __builtin_amdgcn_rsqf(wave_sum(s) * (1.0f / DM) + 1e-6f);
            unsigned long long* o8 = (unsigned long long*)(hn + (size_t)(m0 + r) * DM) + lane;
#pragma unroll
            for (int j = 0; j < 4; ++j) { const f32x4 y = v[r][j] * rs * gm[j]; const unsigned long long pk = (unsigned long long)pk2(y.x, y.y) | ((unsigned long long)pk2(y.z, y.w) << 32);
                o8[64 * j] = pk; *(LAS unsigned long long*)(SR + r * 1032 + 4 * lane + 256 * j) = pk; } }
        LDS_WAIT(); asm volatile("" ::: "memory");
        f32x4 ac0 = (f32x4){0.f, 0.f, 0.f, 0.f}, ac1 = ac0;
#pragma unroll 8
        for (int ks = 0; ks < 32; ks += 2) {
            const bf16x8 a0 = *(const LAS bf16x8*)(SR + (fr & 3) * 1032 + ks * 32 + fq * 8), b0 = *(const LAS bf16x8*)(WA + fr * 1032 + ks * 32 + fq * 8);
            const bf16x8 a1 = *(const LAS bf16x8*)(SR + (fr & 3) * 1032 + ks * 32 + 32 + fq * 8), b1 = *(const LAS bf16x8*)(WA + fr * 1032 + ks * 32 + 32 + fq * 8);
            ac0 = MFMA16(a0, b0, ac0); ac1 = MFMA16(a1, b1, ac1); }
        ac0 = ac0 + ac1;
        if (fq == 0) {
#pragma unroll
            for (int i = 0; i < 4; ++i) alr[(size_t)(m0 + i) * 16 + fr] = ac0[i]; }
        LDS_WAIT(); asm volatile("" ::: "memory");
    }
    float* ssq = (float*)(P.ws + WS_SSQ);
    for (int i = blk * 512 + tid; i < M_TOK; i += G * 512) ssq[i] = 0.f;
}

constexpr int SW_QN = 0, SW_KN = 36864, SW_VT = 64512, SW_OT = 90112;
struct SwaRegs { u32x4 q[4], k[3], v[3]; };
__device__ __forceinline__ void swa_load(SwaRegs& R, int b, int n, int kh, const bf16_t* __restrict__ SQ, const bf16_t* __restrict__ SKV, int tid) {
    asm volatile("" : "+v"(tid));
    const int lane = tid & 63, wave = tid >> 6, dq = tid & 7;
    const bf16_t* qb = SQ + ((size_t)b * SEQ_T + (size_t)n * 64) * 1024 + kh * 256;
    const bf16_t* kb = SKV + (size_t)b * SEQ_T * 512 + kh * 64;
    const int p0 = n * 64 - 128;
#pragma unroll
    for (int i = 0; i < 4; ++i) { const unsigned o = (unsigned)tid + 512u * i; R.q[i] = *(const u32x4*)(qb + ((o >> 5) * 1024u + (o & 31u) * 8u)); }
#pragma unroll
    for (int i = 0; i < 3; ++i) { const int j = (int)(((unsigned)tid + 512u * i) >> 3); const int pos = p0 + j;
        R.k[i] = (u32x4){0u, 0u, 0u, 0u};
        if (pos >= 0) R.k[i] = *(const u32x4*)(kb + ((unsigned)pos * 512u + (unsigned)dq * 8u)); }
#pragma unroll
    for (int i = 0; i < 3; ++i) { const int j = (lane >> 3) + 8 * wave + 64 * i; const int pos = p0 + j;
        R.v[i] = (u32x4){0u, 0u, 0u, 0u};
        if (pos >= 0) R.v[i] = *(const u32x4*)(kb + ((unsigned)pos * 512u + 256u + (unsigned)dq * 8u)); }
}
__device__ __forceinline__ float swa_stage(const SwaRegs& R, const float* __restrict__ qn, const float* __restrict__ kn, LAS unsigned char* lds, int tid) {
    asm volatile("" : "+v"(tid));
    const int lane = tid & 63, wave = tid >> 6, dq = tid & 7;
    LAS bf16_t* Qn = (LAS bf16_t*)(lds + SW_QN); LAS bf16_t* Kn = (LAS bf16_t*)(lds + SW_KN); LAS bf16_t* Vt = (LAS bf16_t*)(lds + SW_VT);
    float gqmax, gkmax;
    {
        float g8[8]; { const f32x4 a = *(const f32x4*)(qn + dq * 8), c = *(const f32x4*)(qn + dq * 8 + 4); g8[0] = a.x; g8[1] = a.y; g8[2] = a.z; g8[3] = a.w; g8[4] = c.x; g8[5] = c.y; g8[6] = c.z; g8[7] = c.w; }
#pragma unroll
        for (int i = 0; i < 4; ++i) { const int o = tid + 512 * i, t = o >> 5, oc = o & 31, g = oc >> 3;
            float f[8]; unpack8(R.q[i], f);
            float ss = 0.f;
#pragma unroll
            for (int e = 0; e < 8; ++e) ss += f[e] * f[e];
            ss = sum8_dpp(ss);
            const float rs = __builtin_amdgcn_rsqf(ss * (1.0f / 64.0f) + 1e-6f) * (0.125f * 1.4426950408889634f);
#pragma unroll
            for (int e = 0; e < 8; ++e) f[e] = f[e] * rs * g8[e];
            *(LAS u32x4*)(Qn + (g * 64 + t) * 72 + dq * 8) = pack8(f); __builtin_amdgcn_sched_barrier(0); }
        float m = 0.f;
#pragma unroll
        for (int e = 0; e < 8; ++e) m = fmaxf(m, fabsf(g8[e]));
        gqmax = max8_dpp(m);
    }
    {
        float g8[8]; { const f32x4 a = *(const f32x4*)(kn + dq * 8), c = *(const f32x4*)(kn + dq * 8 + 4); g8[0] = a.x; g8[1] = a.y; g8[2] = a.z; g8[3] = a.w; g8[4] = c.x; g8[5] = c.y; g8[6] = c.z; g8[7] = c.w; }
#pragma unroll
        for (int i = 0; i < 3; ++i) { const int o = tid + 512 * i, j = o >> 3;
            float f[8]; unpack8(R.k[i], f);
            float ss = 0.f;
#pragma unroll
            for (int e = 0; e < 8; ++e) ss += f[e] * f[e];
            ss = sum8_dpp(ss);
            const float rs = __builtin_amdgcn_rsqf(ss * (1.0f / 64.0f) + 1e-6f);
#pragma unroll
            for (int e = 0; e < 8; ++e) f[e] = f[e] * rs * g8[e];
            *(LAS u32x4*)(Kn + j * 72 + dq * 8) = pack8(f); __builtin_amdgcn_sched_barrier(0); }
        float m = 0.f;
#pragma unroll
        for (int e = 0; e < 8; ++e) m = fmaxf(m, fabsf(g8[e]));
        gkmax = max8_dpp(m);
    }
#pragma unroll
    for (int i = 0; i < 3; ++i) { const int j = (lane >> 3) + 8 * wave + 64 * i; const u32x4 w = R.v[i];
        LAS bf16_t* vp = Vt + (dq * 8) * 200 + (j ^ (dq << 3));
        vp[0 * 200] = (bf16_t)(w.x & 0xffffu); vp[1 * 200] = (bf16_t)(w.x >> 16); vp[2 * 200] = (bf16_t)(w.y & 0xffffu); vp[3 * 200] = (bf16_t)(w.y >> 16);
        vp[4 * 200] = (bf16_t)(w.z & 0xffffu); vp[5 * 200] = (bf16_t)(w.z >> 16); vp[6 * 200] = (bf16_t)(w.w & 0xffffu); vp[7 * 200] = (bf16_t)(w.w >> 16); }
    return 8.0f * 1.4426950408889634f * gqmax * gkmax;
}
__device__ __forceinline__ void swa_compute(float M2, int b, int n, int kh, bf16_t* __restrict__ OS, const float* __restrict__ sinks, LAS unsigned char* lds, int tid) {
    asm volatile("" : "+v"(tid));
    const int lane = tid & 63, wave = tid >> 6, fr = lane & 15, fq = lane >> 4;
    LAS bf16_t* Qn = (LAS bf16_t*)(lds + SW_QN); LAS bf16_t* Kn = (LAS bf16_t*)(lds + SW_KN); LAS bf16_t* Vt = (LAS bf16_t*)(lds + SW_VT);
    const int g = wave >> 1, qh = wave & 1;
    const int hh = kh * 4 + g; const float slope = exp2f(-0.5f * (float)(hh + 1)) * 1.4426950408889634f; const float sink = sinks[hh] * 1.4426950408889634f;
    bf16x8 bq[2][2]; float fb[2];
#pragma unroll
    for (int qt = 0; qt < 2; ++qt) { const int qrow = qh * 32 + qt * 16 + fr; fb[qt] = (float)(128 + qrow - 4 * fq);
#pragma unroll
        for (int ks = 0; ks < 2; ++ks) bq[qt][ks] = *(const LAS bf16x8*)(Qn + (g * 64 + qrow) * 72 + ks * 32 + fq * 8); }
    float l[2] = {0.f, 0.f};
    f32x4 oa[4][2];
#pragma unroll
    for (int dt = 0; dt < 4; ++dt)
#pragma unroll
        for (int qt = 0; qt < 2; ++qt) oa[dt][qt] = (f32x4){0.f, 0.f, 0.f, 0.f};
    const int kg0 = n >= 2 ? 0 : 2 - n;
#pragma unroll 1
    for (int kg = kg0; kg < 3; ++kg) {
        float ini[2];
#pragma unroll
        for (int qt = 0; qt < 2; ++qt) ini[qt] = kg < 2 ? -M2 - slope * (fb[qt] - (float)(kg * 64)) : -M2;
        f32x4 sc[4][2];
#pragma unroll
        for (int k4 = 0; k4 < 4; ++k4) { const LAS bf16_t* kr = Kn + (kg * 64 + k4 * 16 + fr) * 72 + fq * 8;
            const bf16x8 ak0 = *(const LAS bf16x8*)(kr), ak1 = *(const LAS bf16x8*)(kr + 32);
#pragma unroll
            for (int qt = 0; qt < 2; ++qt) { f32x4 a = (f32x4){ini[qt], ini[qt], ini[qt], ini[qt]}; a = MFMA16(ak0, bq[qt][0], a); a = MFMA16(ak1, bq[qt][1], a); sc[k4][qt] = a; } }
        if (kg < 2) {
#pragma unroll
            for (int k4 = 0; k4 < 4; ++k4)
#pragma unroll
                for (int qt = 0; qt < 2; ++qt)
#pragma unroll
                    for (int i = 0; i < 4; ++i) sc[k4][qt][i] = fmaf(slope, (float)(k4 * 16 + i), sc[k4][qt][i]);
        } else {
#pragma unroll
            for (int k4 = 0; k4 < 4; ++k4)
#pragma unroll
                for (int qt = 0; qt < 2; ++qt)
#pragma unroll
                    for (int i = 0; i < 4; ++i) sc[k4][qt][i] = sc[k4][qt][i] - slope * fabsf((fb[qt] - 128.0f) - (float)(k4 * 16 + i));
        }
#pragma unroll
        for (int k4 = 0; k4 < 4; ++k4)
#pragma unroll
            for (int qt = 0; qt < 2; ++qt)
#pragma unroll
                for (int i = 0; i < 4; ++i) { const float p = __builtin_amdgcn_exp2f(sc[k4][qt][i]); sc[k4][qt][i] = p; l[qt] += p; }
#pragma unroll
        for (int s2 = 0; s2 < 2; ++s2) {
            bf16x8 bp[2];
#pragma unroll
            for (int qt = 0; qt < 2; ++qt) { u32x4 pw; pw.x = pk2v(sc[2 * s2][qt][0], sc[2 * s2][qt][1]); pw.y = pk2v(sc[2 * s2][qt][2], sc[2 * s2][qt][3]);
                pw.z = pk2v(sc[2 * s2 + 1][qt][0], sc[2 * s2 + 1][qt][1]); pw.w = pk2v(sc[2 * s2 + 1][qt][2], sc[2 * s2 + 1][qt][3]); bp[qt] = __builtin_bit_cast(bf16x8, pw); }
#pragma unroll
            for (int dt = 0; dt < 4; ++dt) { const int d = dt * 16 + fr, swz = ((d >> 3) & 7) << 3; const LAS bf16_t* vr = Vt + d * 200; const int j0 = kg * 64 + 32 * s2 + 4 * fq;
                const u32x2 lo = *(const LAS u32x2*)(vr + (j0 ^ swz)), hi = *(const LAS u32x2*)(vr + ((j0 + 16) ^ swz));
                u32x4 w; w.x = lo.x; w.y = lo.y; w.z = hi.x; w.w = hi.y; const bf16x8 av = __builtin_bit_cast(bf16x8, w);
#pragma unroll
                for (int qt = 0; qt < 2; ++qt) oa[dt][qt] = MFMA16(av, bp[qt], oa[dt][qt]); }
        }
    }
    const float esink = __builtin_amdgcn_exp2f(sink - M2);
#pragma unroll
    for (int qt = 0; qt < 2; ++qt) { float ls = l[qt]; ls += __shfl_xor(ls, 16); ls += __shfl_xor(ls, 32); const float inv = __builtin_amdgcn_rcpf(ls + esink);
        LAS bf16_t* op = (LAS bf16_t*)(lds + SW_OT) + (qh * 32 + qt * 16 + fr) * 264 + g * 64 + 4 * fq;
#pragma unroll
        for (int dt = 0; dt < 4; ++dt) { const f32x4 v = oa[dt][qt] * inv; u32x2 w; w.x = pk2(v[0], v[1]); w.y = pk2(v[2], v[3]); *(LAS u32x2*)(op + dt * 16) = w; } }
}
__device__ __forceinline__ void swa_store(int b, int n, int kh, bf16_t* __restrict__ OS, LAS unsigned char* lds, int tid) {
    asm volatile("" : "+v"(tid));
    const LAS bf16_t* OT = (const LAS bf16_t*)(lds + SW_OT);
    bf16_t* ob = OS + ((size_t)b * SEQ_T + (size_t)n * 64) * 1024 + kh * 256;
#pragma unroll
    for (int i = 0; i < 4; ++i) { const unsigned o = (unsigned)tid + 512u * i, t = o >> 5, oc = o & 31u; *(u32x4*)(ob + (t * 1024u + oc * 8u)) = *(const LAS u32x4*)(OT + t * 264u + oc * 8u); }
}

constexpr int GL_CUM = 0, GL_QD = 34816, GL_KD = 52224, GL_KT = 69632, GL_VT = 88064, GL_P = 124928, GL_SSQ = 134144, GL_DEC = 136192, GL_QT = 137216, GL_ALR = 139264, GL_END = 143360;
static_assert(GL_END <= LDS_BYTES, "GLA LDS map");
constexpr int GLA_NSEG = 8, GLA_SEGC = 64 / GLA_NSEG;
template <bool FULL>
__device__ __forceinline__ void gla_seg(int b, int h, int seg, const bf16_t* __restrict__ QK, const bf16_t* __restrict__ GV, const bf16_t* __restrict__ GG, const float* __restrict__ ALR,
                                        const float* __restrict__ w2, const float* __restrict__ balpha, const float* __restrict__ gnorm, bf16_t* __restrict__ OG,
                                        float* __restrict__ Lws, float* __restrict__ Dws, LAS unsigned char* lds, int tid) {
    asm volatile("" : "+v"(tid));
    const int lane = tid & 63, wave = tid >> 6, fr = lane & 15, fq = lane >> 4;
    LAS float* CUM = (LAS float*)(lds + GL_CUM); LAS bf16_t* OB = (LAS bf16_t*)(lds + GL_QD);
    LAS bf16_t* QD = (LAS bf16_t*)(lds + GL_QD); LAS bf16_t* KD = (LAS bf16_t*)(lds + GL_KD); LAS bf16_t* KT = (LAS bf16_t*)(lds + GL_KT); LAS bf16_t* VT = (LAS bf16_t*)(lds + GL_VT);
    LAS bf16_t* PB = (LAS bf16_t*)(lds + GL_P); LAS float* SSQ = (LAS float*)(lds + GL_SSQ); LAS float* DEC = (LAS float*)(lds + GL_DEC); LAS float* QT = (LAS float*)(lds + GL_QT);
    LAS float* ALRS = (LAS float*)(lds + GL_ALR);
    const int lt = (lane >> 3) + 8 * wave, lo = lane & 7, lsw = lt ^ (lo << 3);
    const int seq = b * 4 + h;
    f32x4 S[8][2];
#pragma unroll
    for (int a = 0; a < 8; ++a)
#pragma unroll
        for (int c = 0; c < 2; ++c) S[a][c] = (f32x4){0.f, 0.f, 0.f, 0.f};
    if (FULL) {
        const float* Lb0 = Lws + (size_t)(seq * GLA_NSEG) * 32768 + (size_t)wave * 4096 + lane * 4; const float* Db0 = Dws + (seq * GLA_NSEG) * 128;
        f32x4 La[16], Lb[16];
#define GLA_LOADL(DST, J) do { _Pragma("unroll") for (int q_ = 0; q_ < 16; ++q_) DST[q_] = *(const f32x4*)(Lb0 + (size_t)(J) * 32768 + q_ * 256); } while (0)
#define GLA_FOLD(SRC, J) do { _Pragma("unroll") for (int dkt = 0; dkt < 8; ++dkt) { const f32x4 dc = *(const f32x4*)(Db0 + (J) * 128 + dkt * 16 + 4 * fq); \
            _Pragma("unroll") for (int dvt = 0; dvt < 2; ++dvt) S[dkt][dvt] = S[dkt][dvt] * dc + SRC[dkt * 2 + dvt]; } } while (0)
        if (seg > 0) GLA_LOADL(La, 0);
#pragma unroll 1
        for (int j = 0; j < seg; j += 2) {
            if (j + 1 < seg) GLA_LOADL(Lb, j + 1);
            GLA_FOLD(La, j);
            if (j + 1 < seg) { if (j + 2 < seg) GLA_LOADL(La, j + 2); GLA_FOLD(Lb, j + 1); }
        }
#undef GLA_LOADL
#undef GLA_FOLD
    }
    const int dkc = wave * 16 + fr;
    bf16x8 w2f; { float w[8];
#pragma unroll
        for (int j = 0; j < 8; ++j) w[j] = w2[((fq & 1) * 8 + j) * 512 + h * 128 + dkc];
        w2f = __builtin_bit_cast(bf16x8, pack8v(w)); }
    const float bz = balpha[h * 128 + dkc];
    const size_t tokb = (size_t)b * SEQ_T + (size_t)seg * (GLA_SEGC * 64);
    if (tid < 256) *(LAS f32x4*)(ALRS + tid * 4) = *(const f32x4*)(ALR + tokb * 16 + tid * 4);
    float segtot = 0.f;
    u32x4 qw[2], kw[2], vw[4];
#define GLA_LOAD_QKV(T0) do { _Pragma("unroll") for (int i_ = 0; i_ < 2; ++i_) { const int oc_ = lo + 8 * i_; \
            kw[i_] = *(const u32x4*)(QK + ((T0) + lt) * 1024 + 512 + h * 128 + oc_ * 8); } \
        _Pragma("unroll") for (int i_ = 0; i_ < 4; ++i_) { const int oc_ = lo + 8 * i_; vw[i_] = *(const u32x4*)(GV + ((T0) + lt) * 1024 + h * 256 + oc_ * 8); } } while (0)
    __syncthreads();
#pragma unroll 1
    for (int c = 0; c < GLA_SEGC; ++c) {
        const size_t tok0 = tokb + (size_t)c * 64;
        GLA_LOAD_QKV(tok0);
        if (FULL) {
#pragma unroll
            for (int i = 0; i < 2; ++i) qw[i] = *(const u32x4*)(QK + (tok0 + lt) * 1024 + h * 128 + (lo + 8 * i) * 8); }
        {
            float carry = 0.f;
#pragma unroll
            for (int tt = 0; tt < 4; ++tt) {
                const LAS f32x4* ar = (const LAS f32x4*)(ALRS + (tt * 16 + fr) * 16 + (fq & 1) * 8); const f32x4 x0 = ar[0], x1 = ar[1];
                float x[8] = {x0.x, x0.y, x0.z, x0.w, x1.x, x1.y, x1.z, x1.w}, xh[8];
                unpack8(pack8v(x), xh);
                if (fq >= 2) {
#pragma unroll
                    for (int e = 0; e < 8; ++e) x[e] -= xh[e];
                }
                const bf16x8 af = __builtin_bit_cast(bf16x8, pack8v(x));
                const f32x4 z4 = MFMA16(af, w2f, ((f32x4){0.f, 0.f, 0.f, 0.f}));
                float v[4];
#pragma unroll
                for (int i = 0; i < 4; ++i) { const float z = z4[i] + bz;
                    v[i] = (fminf(z, 0.f) - 0.6931471805599453f * __builtin_amdgcn_logf(1.0f + __builtin_amdgcn_exp2f(-1.4426950408889634f * fabsf(z)))) * (1.0f / 16.0f); }
                v[1] += v[0]; v[2] += v[1]; v[3] += v[2];
                const float tot4 = v[3];
                const float p1 = __shfl_up(tot4, 16); float sc = tot4 + (fq >= 1 ? p1 : 0.f);
                const float p2 = __shfl_up(sc, 32); sc += (fq >= 2 ? p2 : 0.f);
                const float base = carry + (sc - tot4);
#pragma unroll
                for (int i = 0; i < 4; ++i) CUM[(tt * 16 + 4 * fq + i) * 132 + dkc] = v[i] + base;
                carry += __shfl(sc, 48 + fr);
            }
            if (fq == 0) DEC[dkc] = __builtin_amdgcn_exp2f(1.4426950408889634f * carry);
            segtot += carry;
        }
        __syncthreads();
        if (c + 1 < GLA_SEGC && tid < 256) *(LAS f32x4*)(ALRS + tid * 4) = *(const f32x4*)(ALR + (tok0 + 64) * 16 + tid * 4);
#pragma unroll
        for (int i = 0; i < 2; ++i) { const int oc = lo + 8 * i, t = lt;
            float k8[8]; unpack8(kw[i], k8);
            const f32x4 c0 = *(const LAS f32x4*)(CUM + t * 132 + oc * 8), c1 = *(const LAS f32x4*)(CUM + t * 132 + oc * 8 + 4);
            const f32x4 d0 = *(const LAS f32x4*)(DEC + oc * 8), d1 = *(const LAS f32x4*)(DEC + oc * 8 + 4);
            const float cm[8] = {c0.x, c0.y, c0.z, c0.w, c1.x, c1.y, c1.z, c1.w}; const float dc[8] = {d0.x, d0.y, d0.z, d0.w, d1.x, d1.y, d1.z, d1.w};
            float kd[8], ke[8];
#pragma unroll
            for (int e = 0; e < 8; ++e) { const float em = __builtin_amdgcn_exp2f(-1.4426950408889634f * cm[e]); kd[e] = k8[e] * em; ke[e] = kd[e] * dc[e]; }
            if (FULL) { float q8[8], qd[8]; unpack8(qw[i], q8);
#pragma unroll
                for (int e = 0; e < 8; ++e) qd[e] = q8[e] * __builtin_amdgcn_exp2f(1.4426950408889634f * cm[e]) * 0.08838834764831845f;
                *(LAS u32x4*)(QD + t * 136 + oc * 8) = pack8(qd); *(LAS u32x4*)(KD + t * 136 + oc * 8) = pack8(kd); }
            const u32x4 kp8 = pack8(ke); LAS bf16_t* kp = KT + (oc * 8) * 72 + lsw;
            kp[0 * 72] = (bf16_t)(kp8.x & 0xffffu); kp[1 * 72] = (bf16_t)(kp8.x >> 16); kp[2 * 72] = (bf16_t)(kp8.y & 0xffffu); kp[3 * 72] = (bf16_t)(kp8.y >> 16);
            kp[4 * 72] = (bf16_t)(kp8.z & 0xffffu); kp[5 * 72] = (bf16_t)(kp8.z >> 16); kp[6 * 72] = (bf16_t)(kp8.w & 0xffffu); kp[7 * 72] = (bf16_t)(kp8.w >> 16); }
#pragma unroll
        for (int i = 0; i < 4; ++i) { const int oc = lo + 8 * i; const u32x4 w = vw[i]; LAS bf16_t* vp = VT + (oc * 8) * 72 + lsw;
            vp[0 * 72] = (bf16_t)(w.x & 0xffffu); vp[1 * 72] = (bf16_t)(w.x >> 16); vp[2 * 72] = (bf16_t)(w.y & 0xffffu); vp[3 * 72] = (bf16_t)(w.y >> 16);
            vp[4 * 72] = (bf16_t)(w.z & 0xffffu); vp[5 * 72] = (bf16_t)(w.z >> 16); vp[6 * 72] = (bf16_t)(w.w & 0xffffu); vp[7 * 72] = (bf16_t)(w.w >> 16); }
        __syncthreads();
        f32x4 o[4][2];
        u32x4 gw[4];
        if (FULL) {
            {
                const int tt = wave >> 1;
#pragma unroll
                for (int u2 = 0; u2 < 2; ++u2) { const int st = (wave & 1) * 2 + u2; f32x4 a = (f32x4){0.f, 0.f, 0.f, 0.f};
                    if (st <= tt) {
#pragma unroll
                        for (int ks = 0; ks < 4; ++ks) { const bf16x8 ak = *(const LAS bf16x8*)(KD + (st * 16 + fr) * 136 + ks * 32 + fq * 8), bq = *(const LAS bf16x8*)(QD + (tt * 16 + fr) * 136 + ks * 32 + fq * 8);
                            a = MFMA16(ak, bq, a); }
                    }
                    const int t = tt * 16 + fr, s0 = st * 16 + 4 * fq;
                    const float p0 = (s0 + 0 <= t) ? a[0] : 0.f, p1 = (s0 + 1 <= t) ? a[1] : 0.f, p2 = (s0 + 2 <= t) ? a[2] : 0.f, p3 = (s0 + 3 <= t) ? a[3] : 0.f;
                    u32x2 w; w.x = pk2(p0, p1); w.y = pk2(p2, p3); *(LAS u32x2*)(PB + t * 72 + s0) = w; }
            }
#pragma unroll
            for (int a = 0; a < 4; ++a)
#pragma unroll
                for (int d = 0; d < 2; ++d) o[a][d] = (f32x4){0.f, 0.f, 0.f, 0.f};
#pragma unroll
            for (int ks = 0; ks < 4; ++ks) {
                bf16x8 bs[2];
#pragma unroll
                for (int dvt = 0; dvt < 2; ++dvt) { u32x4 w; w.x = pk2v(S[2 * ks][dvt][0], S[2 * ks][dvt][1]); w.y = pk2v(S[2 * ks][dvt][2], S[2 * ks][dvt][3]);
                    w.z = pk2v(S[2 * ks + 1][dvt][0], S[2 * ks + 1][dvt][1]); w.w = pk2v(S[2 * ks + 1][dvt][2], S[2 * ks + 1][dvt][3]); bs[dvt] = __builtin_bit_cast(bf16x8, w); }
#pragma unroll
                for (int tt = 0; tt < 4; ++tt) { const LAS bf16_t* qp = QD + (tt * 16 + fr) * 136 + 32 * ks + 4 * fq;
                    const u32x2 lo = *(const LAS u32x2*)(qp), hi = *(const LAS u32x2*)(qp + 16);
                    u32x4 w; w.x = lo.x; w.y = lo.y; w.z = hi.x; w.w = hi.y; const bf16x8 aq = __builtin_bit_cast(bf16x8, w);
#pragma unroll
                    for (int dvt = 0; dvt < 2; ++dvt) o[tt][dvt] = MFMA16(aq, bs[dvt], o[tt][dvt]); }
            }
        }
        bf16x8 bv[2][2];
#pragma unroll
        for (int dvt = 0; dvt < 2; ++dvt)
#pragma unroll
            for (int ks = 0; ks < 2; ++ks) { const int dv = wave * 32 + dvt * 16 + fr; bv[dvt][ks] = *(const LAS bf16x8*)(VT + dv * 72 + ((ks * 32 + fq * 8) ^ (((dv >> 3) & 7) << 3))); }
#pragma unroll
        for (int dkt = 0; dkt < 8; ++dkt) { const f32x4 dc = *(const LAS f32x4*)(DEC + dkt * 16 + 4 * fq);
#pragma unroll
            for (int dvt = 0; dvt < 2; ++dvt) S[dkt][dvt] = S[dkt][dvt] * dc;
#pragma unroll
            for (int ks = 0; ks < 2; ++ks) { const int dkr = dkt * 16 + fr; const bf16x8 ak = *(const LAS bf16x8*)(KT + dkr * 72 + ((ks * 32 + fq * 8) ^ (((dkr >> 3) & 7) << 3)));
#pragma unroll
                for (int dvt = 0; dvt < 2; ++dvt) S[dkt][dvt] = MFMA16(ak, bv[dvt][ks], S[dkt][dvt]); } }
        if (FULL) {
#pragma unroll
            for (int i = 0; i < 4; ++i) { const int oid = tid + 512 * i, t = oid >> 5, oc = oid & 31; gw[i] = *(const u32x4*)(GG + (tok0 + t) * 1024 + h * 256 + oc * 8); }
        }
        __syncthreads();
        if (FULL) {
#pragma unroll
            for (int ks = 0; ks < 2; ++ks)
#pragma unroll
                for (int tt = 0; tt < 4; ++tt) { if (ks == 1 && tt < 2) continue;
                    const bf16x8 ap = *(const LAS bf16x8*)(PB + (tt * 16 + fr) * 72 + ks * 32 + fq * 8);
#pragma unroll
                    for (int dvt = 0; dvt < 2; ++dvt) o[tt][dvt] = MFMA16(ap, bv[dvt][ks], o[tt][dvt]); }
#pragma unroll
            for (int tt = 0; tt < 4; ++tt)
#pragma unroll
                for (int i = 0; i < 4; ++i) { const int t = tt * 16 + 4 * fq + i; const float v0 = o[tt][0][i], v1 = o[tt][1][i];
                    const unsigned w = pk2(v0, v1);
                    OB[t * 272 + wave * 32 + fr] = (bf16_t)(w & 0xffffu); OB[t * 272 + wave * 32 + 16 + fr] = (bf16_t)(w >> 16);
                    const float q = sum16_dpp(v0 * v0 + v1 * v1);
                    if (fr == 0) SSQ[wave * 64 + t] = q; }
            __syncthreads();
#pragma unroll
            for (int i = 0; i < 4; ++i) { const int oid = tid + 512 * i, t = oid >> 5, oc = oid & 31;
                float ss = 0.f;
#pragma unroll
                for (int w = 0; w < 8; ++w) ss += SSQ[w * 64 + t];
                const float rs = __builtin_amdgcn_rsqf(ss * (1.0f / 256.0f) + 1e-6f);
                float ov[8], gv[8]; unpack8(*(const LAS u32x4*)(OB + t * 272 + oc * 8), ov); unpack8(gw[i], gv);
                const f32x4 n0 = *(const f32x4*)(gnorm + oc * 8), n1 = *(const f32x4*)(gnorm + oc * 8 + 4); const float gn[8] = {n0.x, n0.y, n0.z, n0.w, n1.x, n1.y, n1.z, n1.w};
#pragma unroll
                for (int e = 0; e < 8; ++e) ov[e] = ov[e] * rs * gn[e] * gv[e];
                *(u32x4*)(OG + (tok0 + t) * 1024 + h * 256 + oc * 8) = pack8(ov); }
        }
    }
    if (!FULL) {
        float* Lj = Lws + (size_t)(seq * GLA_NSEG + seg) * 32768 + (size_t)wave * 4096 + lane * 4;
#pragma unroll
        for (int dkt = 0; dkt < 8; ++dkt)
#pragma unroll
            for (int dvt = 0; dvt < 2; ++dvt) *(f32x4*)(Lj + (dkt * 2 + dvt) * 256) = S[dkt][dvt];
        if (fq == 0) Dws[(seq * GLA_NSEG + seg) * 128 + dkc] = __builtin_amdgcn_exp2f(1.4426950408889634f * segtot);
    }
#undef GLA_LOAD_QKV
}

#define XB_TMO      128
#define XB_XCNT(j)  (256  + 64 * (j))
#define XB_XSUB(j)  (1280 + 64 * (j))
#define XB_XGEN(j)  (2304 + 64 * (j))
#define XB_TOP      3328
#define XB_TOPGEN   3392
#define XCD_BAR_WORDS 3456
#define XB_SPIN_CAP (1u << 18)

__device__ __forceinline__ unsigned xb_ld(unsigned* p)              { return __hip_atomic_load(p, __ATOMIC_RELAXED, __HIP_MEMORY_SCOPE_AGENT); }
__device__ __forceinline__ unsigned xb_add(unsigned* p, unsigned v) { return __hip_atomic_fetch_add(p, v, __ATOMIC_RELAXED, __HIP_MEMORY_SCOPE_AGENT); }
__device__ __forceinline__ unsigned xb_xcc_id() { return (unsigned)__builtin_amdgcn_s_getreg((3 << 11) | 20) & 0xFu; }
#define XB_SPIN(cond, bar) do { unsigned _sp = 0; while (cond) { __builtin_amdgcn_s_sleep(1); \
    if ((++_sp & 255u) == 0u) { if (xb_ld(&(bar)[XB_TMO])) break; if (_sp > XB_SPIN_CAP) { atomicAdd(&(bar)[XB_TMO], 1u); break; } } } } while (0)

struct XcdBarrier {
    unsigned* bar; unsigned x;
    volatile LAS unsigned* st;
};

__device__ __forceinline__ XcdBarrier xcd_barrier_post(unsigned* bar, volatile LAS unsigned* st) {
    XcdBarrier b; b.bar = bar; b.x = xb_xcc_id(); b.st = st;
    if (threadIdx.x == 0) (void)xb_add(&bar[XB_XCNT(b.x)], 1u);
    return b;
}
__device__ __forceinline__ void xcd_barrier_complete(unsigned* bar, unsigned x, unsigned& nloc, unsigned& nx) {
    const unsigned G = gridDim.x * gridDim.y * gridDim.z;
    unsigned sum, cnt, mine, sp = 0u;
    for (;;) {
        sum = 0u; cnt = 0u; mine = 0u;
#pragma unroll
        for (unsigned j = 0; j < 16; ++j) { const unsigned c = xb_ld(&bar[XB_XCNT(j)]); sum += c; cnt += (c > 0u) ? 1u : 0u; mine = (j == x) ? c : mine; }
        if (sum == G) break;
        __builtin_amdgcn_s_sleep(1);
        if ((++sp & 255u) == 0u) { if (xb_ld(&bar[XB_TMO])) break; if (sp > XB_SPIN_CAP) { atomicAdd(&bar[XB_TMO], 1u); break; } }
    }
    nloc = mine > 0u ? mine : 1u; nx = cnt > 0u ? cnt : 1u;
}

__device__ __forceinline__ void xcd_barrier(const XcdBarrier& b) {
    asm volatile("s_waitcnt vmcnt(0)" ::: "memory");
    __syncthreads();
    if (threadIdx.x == 0) {
        unsigned* bar = b.bar;
        __builtin_amdgcn_s_waitcnt(0);
        unsigned nloc = b.st[0], nx = b.st[1];
        if (nloc == 0u) { xcd_barrier_complete(bar, b.x, nloc, nx); b.st[0] = nloc; b.st[1] = nx; }
        const unsigned old = xb_add(&bar[XB_XSUB(b.x)], 1u);
        const unsigned gen = old / nloc;
        if (old + 1u == (gen + 1u) * nloc) {
            __builtin_amdgcn_fence(__ATOMIC_RELEASE, "agent");
            asm volatile("s_waitcnt vmcnt(0)" ::: "memory");
            const unsigned og = xb_add(&bar[XB_TOP], 1u);
            const unsigned tg = og / nx;
            if (og + 1u == (tg + 1u) * nx) xb_add(&bar[XB_TOPGEN], 1u);
            else XB_SPIN(xb_ld(&bar[XB_TOPGEN]) == tg, bar);
            __builtin_amdgcn_fence(__ATOMIC_ACQUIRE, "agent");
            xb_add(&bar[XB_XGEN(b.x)], 1u);
            asm volatile("s_waitcnt vmcnt(0)" ::: "memory");
        } else {
            XB_SPIN(xb_ld(&bar[XB_XGEN(b.x)]) == gen, bar);
            __builtin_amdgcn_fence(__ATOMIC_ACQUIRE, "agent");
            asm volatile("s_waitcnt vmcnt(0)" ::: "memory");
        }
    }
    __syncthreads();
}


struct Args { const float* in[15]; float* out; unsigned char* ws; };
__global__ void __launch_bounds__(512) mk_fwd(Args a) {
    extern __shared__ __attribute__((aligned(16))) unsigned char lds_raw[];
    cg::grid_group grid = cg::this_grid();
    LAS unsigned char* lds = (LAS unsigned char*)lds_raw;
    const int tid = threadIdx.x, G = gridDim.x, blk = blockIdx.x;
    Ptrs P; P.x = a.in[0]; P.norm_mix = a.in[1]; P.w_in = a.in[2]; P.w_alpha2 = a.in[3]; P.b_alpha = a.in[4]; P.gla_norm = a.in[5]; P.swa_qn = a.in[6]; P.swa_kn = a.in[7]; P.sinks = a.in[8];
    P.w_bg = a.in[9]; P.w_bs = a.in[10]; P.w_out = a.in[11]; P.norm_mlp = a.in[12]; P.w_up = a.in[13]; P.w_down = a.in[14]; P.out = a.out; P.ws = a.ws;
    unsigned char* ws = a.ws;
    bf16_t* OGLA = (bf16_t*)a.out; bf16_t* OSWA = (bf16_t*)a.out + (size_t)M_TOK * 1024;
    float* SSQ = (float*)(ws + WS_SSQ); float* ALR = (float*)(ws + WS_ALR);

    volatile LAS unsigned* xst = (volatile LAS unsigned*)(lds + LDS_BYTES - 16);
    if (tid < 4) xst[tid] = 0u;
    __syncthreads();
    const XcdBarrier xbar = xcd_barrier_post((unsigned*)(ws + WS_BAR), xst);
    const bool use_cg = G > 1024;
#define GRID_BAR() xcd_barrier(xbar)
    if (PH_MASK & 1) for (int rep = 0; rep < REP_P0; ++rep) p0_prologue(P, lds, tid, G, blk);
    if (use_cg) grid.sync(); else xcd_barrier(xbar);
    if (PH_MASK & 2) {
        pg8::Gemm g{(const bf16_t*)a.out, (const bf16_t*)(ws + WS_WIN), M_TOK, NPROJ, 1024}; pg8::StaticOrder S; S.init(M_TOK, NPROJ, G, blk);
        pg8::EpiProj E{ws};
        for (int rep = 0; rep < REP_P1; ++rep)
        pg8::gemm_phase<pg8::EpiProj, pg8::StaticOrder, true, true>(lds, g, S, E);
    }
    GRID_BAR();
    {
        const bf16_t* QKp = (const bf16_t*)(ws + WS_QK); const bf16_t* GVp = (const bf16_t*)(ws + WS_GV); const bf16_t* GGp = (const bf16_t*)(ws + WS_GG);
        float* Lws = (float*)(ws + WS_GLAL); float* Dws = (float*)(ws + WS_GLAD);
        constexpr int NA = 32 * (GLA_NSEG - 1);
        for (int rep = 0; rep < REP_P2A; ++rep) {
        for (int rpa = 0; rpa < REP_PA; ++rpa)
        if (PH_MASK & 64) for (int it = blk; it < NA; it += G) { const int seq = it / (GLA_NSEG - 1), seg = it % (GLA_NSEG - 1);
            gla_seg<false>(seq >> 2, seq & 3, seg, QKp, GVp, GGp, ALR, P.w_alpha2, P.b_alpha, P.gla_norm, OGLA, Lws, Dws, lds, tid); }
        for (int rsw = 0; rsw < REP_SWA; ++rsw)
        if (PH_MASK & 128) {
            int u0, u1, ustep;
            if (G == 256) { if (blk >= NA) { u0 = (blk - NA) * 12; u1 = u0 + 12; } else if (blk < 96) { u0 = 384 + blk * 8; u1 = u0 + 8; } else { u0 = 1152 + (blk - 96) * 7; u1 = u0 + 7; } ustep = 1; }
            else { u0 = blk; u1 = 2048; ustep = G; }
            int tl = tid; asm volatile("" : "+v"(tl));
            const bf16_t* SQp = (const bf16_t*)(ws + WS_SQ); const bf16_t* SKVp = (const bf16_t*)(ws + WS_SKV);
            SwaRegs R;
            if (u0 < u1) swa_load(R, u0 >> 8, u0 & 63, (u0 >> 6) & 3, SQp, SKVp, tl);
#pragma unroll 1
            for (int u = u0; u < u1; u += ustep) { const int n = u & 63, kh = (u >> 6) & 3, b = u >> 8;
                const float M2 = swa_stage(R, P.swa_qn, P.swa_kn, lds, tl);
                __syncthreads();
                const int un = u + ustep;
                if (un < u1) swa_load(R, un >> 8, un & 63, (un >> 6) & 3, SQp, SKVp, tl);
                swa_compute(M2, b, n, kh, OSWA, P.sinks, lds, tl);
                __syncthreads();
                swa_store(b, n, kh, OSWA, lds, tl); }
            if (G == 256 && blk >= 96 && blk < NA && rsw == 0) {
                __syncthreads();
                const int wv = tl >> 6; LAS float* scr = (LAS float*)(lds + wv * 12288);
                for (int q = wv; q < 44; q += 8) transpose_rest_item(P, (blk - 96) * 44 + q, scr, tl & 63);
            }
        }
        }
        GRID_BAR();
        for (int rep = 0; rep < REP_P2B; ++rep)
        if (PH_MASK & 64) for (int it = blk; it < 32 * GLA_NSEG; it += G) { const int seq = it / GLA_NSEG, seg = it % GLA_NSEG;
            gla_seg<true>(seq >> 2, seq & 3, seg, QKp, GVp, GGp, ALR, P.w_alpha2, P.b_alpha, P.gla_norm, OGLA, Lws, Dws, lds, tid); }
    }
    GRID_BAR();
    if (PH_MASK & 8) {
        static_assert(WS_WBS == WS_WBG + (size_t)1024 * 1024 * 2, "Wbg^T and Wbs^T are one [2048][1024] matrix");
        pg8::PairOrder S; S.init(M_TOK, 1024, G, blk);
        pg8::Gemm g{OGLA, (const bf16_t*)(ws + WS_WBG), 2 * M_TOK, 2048, 1024};
        pg8::EpiGatePair E{{(const bf16_t*)(ws + WS_GA), (bf16_t*)(ws + WS_MERGED)}, {(const bf16_t*)(ws + WS_GB), (bf16_t*)(ws + WS_MERGED)}};
        pg8::gemm_phase<pg8::EpiGatePair, pg8::PairOrder, true, true>(lds, g, S, E);
    }
    GRID_BAR();
    if (PH_MASK & 16) {
        pg8::Gemm g{(const bf16_t*)(ws + WS_MERGED), (const bf16_t*)(ws + WS_WOUT), M_TOK, 1024, 1024}; pg8::StaticOrder S; S.init(M_TOK, 1024, G, blk);
        pg8::EpiRes E{P.x, (bf16_t*)(ws + WS_H1B), SSQ};
        pg8::gemm_phase<pg8::EpiRes, pg8::StaticOrder, true, true>(lds, g, S, E);
    }
    GRID_BAR();
    if (PH_MASK & 32) {
        pg8::Gemm g{(const bf16_t*)(ws + WS_H1B), (const bf16_t*)(ws + WS_WUP), M_TOK, DFF, 1024}; pg8::StaticOrder S; S.init(M_TOK, DFF, G, blk);
        pg8::EpiUp E{SSQ, (bf16_t*)(ws + WS_U)};
        pg8::gemm_phase<pg8::EpiUp, pg8::StaticOrder, true, true>(lds, g, S, E);
    }
    GRID_BAR();
    if (PH_MASK & 256) {
        pg8::Gemm g{(const bf16_t*)(ws + WS_U), (const bf16_t*)(ws + WS_WDN), M_TOK, 1024, DFF}; pg8::StaticOrder S; S.init(M_TOK, 1024, G, blk);
        pg8::EpiDown E{(const bf16_t*)(ws + WS_H1B), a.out};
        pg8::gemm_phase<pg8::EpiDown, pg8::StaticOrder, true, true>(lds, g, S, E);
    }
}

extern "C" void kernel_launch(void* const* d_in, const int* in_sizes, int n_in, void* d_out, int out_size, void* d_ws, size_t ws_size, hipStream_t stream) {
    static int grid = 0;
    if (grid == 0) {
        if (n_in != 15 || out_size != M_TOK * DM || ws_size < WS_END) { fprintf(stderr, "kernel_launch: unexpected shapes (n_in %d out %d ws %zu)\n", n_in, out_size, ws_size); grid = -1; return; }
        int dev = 0, cus = 0, per_cu = 0;
        hipGetDevice(&dev); hipDeviceGetAttribute(&cus, hipDeviceAttributeMultiprocessorCount, dev);
        if (hipFuncSetAttribute((const void*)mk_fwd, hipFuncAttributeMaxDynamicSharedMemorySize, LDS_BYTES) != hipSuccess) { fprintf(stderr, "kernel_launch: hipFuncSetAttribute failed\n"); grid = -1; return; }
        if (hipOccupancyMaxActiveBlocksPerMultiprocessor(&per_cu, (const void*)mk_fwd, 512, LDS_BYTES) != hipSuccess || per_cu < 1) { fprintf(stderr, "kernel_launch: occupancy query says %d\n", per_cu); per_cu = 1; }
        (void)hipGetLastError();
        grid = cus > 1024 ? 1024 : cus;
        if (grid < 64) { fprintf(stderr, "kernel_launch: only %d CUs\n", cus); grid = -1; return; }
    }
    if (grid < 0) return;
    if (hipMemsetAsync((char*)d_ws + WS_BAR, 0, BAR_BYTES, stream) != hipSuccess) { fprintf(stderr, "kernel_launch: hipMemsetAsync failed\n"); return; }
    Args a{};
    for (int i = 0; i < 15; ++i) a.in[i] = (const float*)d_in[i];
    a.out = (float*)d_out; a.ws = (unsigned char*)d_ws;
    void* args[] = {&a};
    hipError_t e = hipLaunchCooperativeKernel((const void*)mk_fwd, dim3(grid), dim3(512), args, LDS_BYTES, stream);
    if (e != hipSuccess) fprintf(stderr, "kernel_launch: cooperative launch failed: %s (grid %d)\n", hipGetErrorString(e), grid);
}
```

```cpp
#include <hip/hip_runtime.h>
#include <hip/hip_cooperative_groups.h>
#include <cstdio>
#include <cstdint>
namespace cg = cooperative_groups;

constexpr int M_TOK = 32768, DM = 1024, SEQ_T = 4096, NPROJ = 6656, DFF = 4096;
constexpr size_t MiB = 1u << 20;
constexpr size_t WS_SSQ = 0;
constexpr size_t WS_BAR = 1 * MiB, BAR_BYTES = 16384;
constexpr size_t WS_WIN = 2 * MiB, WS_WBG = 16 * MiB, WS_WBS = 18 * MiB, WS_WOUT = 20 * MiB, WS_WUP = 22 * MiB, WS_WDN = 30 * MiB;
constexpr size_t WS_ALR = 38 * MiB;
constexpr size_t WS_QK = 40 * MiB, WS_GV = 104 * MiB, WS_GG = 168 * MiB, WS_SQ = 232 * MiB;
constexpr size_t WS_SKV = 296 * MiB;
constexpr size_t WS_GA = 328 * MiB, WS_GB = 392 * MiB;
constexpr size_t WS_MERGED = 40 * MiB;
constexpr size_t WS_H1B = 104 * MiB;
constexpr size_t WS_U = 168 * MiB;
constexpr size_t WS_GLAL = 456 * MiB, WS_GLAD = 488 * MiB;
constexpr size_t WS_END = 489 * MiB;
constexpr int LDS_BYTES = 147456;
#ifndef REP_P0
#define REP_P0 1
#endif
#ifndef REP_P1
#define REP_P1 1
#endif
#ifndef REP_PA
#define REP_PA 1
#endif
#ifndef REP_SWA
#define REP_SWA 1
#endif
#ifndef REP_P2A
#define REP_P2A 1
#endif
#ifndef REP_P2B
#define REP_P2B 1
#endif
#ifndef PH_MASK
#define PH_MASK 0x1ff
#endif
#define LAS __attribute__((address_space(3)))
namespace pg8 {
#define PG8_LAS __attribute__((address_space(3)))
typedef unsigned short bf16_t;
typedef short bf16x8 __attribute__((ext_vector_type(8)));
typedef float f32x4 __attribute__((ext_vector_type(4)));
typedef unsigned u32x4 __attribute__((ext_vector_type(4)));
constexpr int BM = 256, BK = 64, HALF = 128, HTB = HALF * BK * 2  , STAGE_BYTES = 8 * HTB, NXCD = 8, WGM = 8;

__host__ __device__ __forceinline__ int lds_byte(int r, int c) { const int st = (r >> 4) * 2 + (c >> 5), rr = r & 15, cc = c & 31, ob = rr * 64 + cc * 2; return st * 1024 + (ob ^ (((ob >> 9) & 1) << 5)); }
__host__ __device__ __forceinline__ void stage_rc(int b, int& R, int& C) { const int st = b / 1024, sb = b % 1024, swz = sb ^ (((sb >> 9) & 1) << 5); R = (st >> 1) * 16 + swz / 64; C = (st & 1) * 32 + (swz % 64) / 2; }
__host__ __device__ __forceinline__ int perm32(int rho) { const int n = rho >> 4, i = rho & 15; return 8 * (i >> 2) + 4 * n + (i & 3); }

struct Unit { int pm, pn; };
struct Gemm { const bf16_t* A; const bf16_t* Bt; int M, N, K; };

struct StaticOrder {
    int nM, nN, nwg, G, c;
    __host__ __device__ void init(int M, int N, int G_, int c_) { nM = M / BM; nN = N / BM; nwg = nM * nN; G = G_; c = c_; }
    __host__ __device__ bool next(int i, Unit& u) const {
        const long L = (long)i * G + c; if (L >= nwg) return false;
        int wgid = (int)L; { const int q = nwg / NXCD, r = nwg % NXCD, xcd = wgid % NXCD, off = wgid / NXCD; wgid = (xcd < r ? xcd * (q + 1) : r * (q + 1) + (xcd - r) * q) + off; }
        const int nig = WGM * nN, gid = wgid / nig, fm = gid * WGM, gsz = (nM - fm) < WGM ? (nM - fm) : WGM;
        u.pm = fm + ((wgid % nig) % gsz); u.pn = (wgid % nig) / gsz; return true;
    }
    __device__ __forceinline__ void a_ready(const Unit&) const {}
    __device__ __forceinline__ void done(const Unit&) const {}
};
__device__ __forceinline__ unsigned cvt_pk_bf16(float lo, float hi) { unsigned r; asm volatile("v_cvt_pk_bf16_f32 %0, %1, %2" : "=v"(r) : "v"(lo), "v"(hi)); return r; }
typedef float f32x2c __attribute__((ext_vector_type(2))); typedef __bf16 bf16x2c __attribute__((ext_vector_type(2)));
__device__ __forceinline__ unsigned cvt_pk_bf16_v(float lo, float hi) { const f32x2c v = {lo, hi}; const bf16x2c b = __builtin_convertvector(v, bf16x2c); return __builtin_bit_cast(unsigned, b); }
__device__ __forceinline__ float bflo(unsigned w) { return __uint_as_float(w << 16); }
__device__ __forceinline__ float bfhi(unsigned w) { return __uint_as_float(w & 0xffff0000u); }
__device__ __forceinline__ void unpack8(const u32x4 w, float (&f)[8]) { f[0] = bflo(w.x); f[1] = bfhi(w.x); f[2] = bflo(w.y); f[3] = bfhi(w.y); f[4] = bflo(w.z); f[5] = bfhi(w.z); f[6] = bflo(w.w); f[7] = bfhi(w.w); }
__device__ __forceinline__ u32x4 pack8(const float (&f)[8]) { u32x4 w; w.x = cvt_pk_bf16(f[0], f[1]); w.y = cvt_pk_bf16(f[2], f[3]); w.z = cvt_pk_bf16(f[4], f[5]); w.w = cvt_pk_bf16(f[6], f[7]); return w; }
__device__ __forceinline__ float sigm(float x) { return __builtin_amdgcn_rcpf(1.f + __builtin_amdgcn_exp2f(-1.4426950408889634f * x)); }

struct EpiProj {
    static constexpr bool PERM = true, AFTER_DRAIN = false;
    unsigned char* ws;
    __device__ __forceinline__ void operator()(const f32x4 (&acc)[2][2][4][2], const Unit& u, int wr, int wc, int fr, int fq) const {
        const int pn = u.pn; const int row0 = u.pm * BM + wr * 64 + fr;
        size_t off; int ldc = 1024, colt, act = 0;
        if (pn < 16) { off = WS_QK + (size_t)(pn >> 2) * (64 * MiB); colt = (pn & 3) * 256; if ((pn >> 2) == 2) act = 2; }
        else if (pn < 18) { off = WS_SKV; ldc = 512; colt = (pn - 16) * 256; }
        else if (pn < 22) { off = WS_GA; colt = (pn - 18) * 256; act = 1; }
        else { off = WS_GB; colt = (pn - 22) * 256; act = 1; }
        bf16_t* base = (bf16_t*)(ws + off);
        const int col0 = colt + wc * 32 + 8 * fq;
#pragma unroll
        for (int ai = 0; ai < 2; ++ai)
#pragma unroll
            for (int m = 0; m < 4; ++m) { bf16_t* rowp = base + (size_t)(row0 + ai * HALF + m * 16) * ldc + col0;
#pragma unroll
                for (int bj = 0; bj < 2; ++bj) { const f32x4 v0 = acc[ai][bj][m][0], v1 = acc[ai][bj][m][1];
                    float f[8] = {v0[0], v0[1], v0[2], v0[3], v1[0], v1[1], v1[2], v1[3]};
                    if (act == 1) {
#pragma unroll
                        for (int e = 0; e < 8; ++e) f[e] = sigm(f[e]);
                    } else if (act == 2) {
#pragma unroll
                        for (int e = 0; e < 8; ++e) f[e] = f[e] * sigm(f[e]);
                    }
                    __builtin_nontemporal_store(pack8(f), (u32x4*)(rowp + bj * HALF)); } }
    }
};
template <bool FIRST> struct EpiGate {
    static constexpr bool PERM = true, AFTER_DRAIN = false;
    const bf16_t* gate; bf16_t* merged;
    __device__ __forceinline__ void operator()(const f32x4 (&acc)[2][2][4][2], const Unit& u, int wr, int wc, int fr, int fq) const {
        const int row0 = u.pm * BM + wr * 64 + fr, col0 = u.pn * BM + wc * 32 + 8 * fq;
#pragma unroll
        for (int ai = 0; ai < 2; ++ai)
#pragma unroll
            for (int m = 0; m < 4; ++m) { const size_t idx = (size_t)(row0 + ai * HALF + m * 16) * 1024 + col0;
#pragma unroll
                for (int bj = 0; bj < 2; ++bj) { const f32x4 v0 = acc[ai][bj][m][0], v1 = acc[ai][bj][m][1];
                    float f[8] = {v0[0], v0[1], v0[2], v0[3], v1[0], v1[1], v1[2], v1[3]}; float g[8];
                    unpack8(__builtin_nontemporal_load((const u32x4*)(gate + idx + bj * HALF)), g);
#pragma unroll
                    for (int e = 0; e < 8; ++e) f[e] *= g[e];
                    if (!FIRST) { float p[8]; unpack8(*(const u32x4*)(merged + idx + bj * HALF), p);
#pragma unroll
                        for (int e = 0; e < 8; ++e) f[e] += p[e]; }
                    *(u32x4*)(merged + idx + bj * HALF) = pack8(f); } }
    }
};
struct PairOrder {
    StaticOrder base;
    __host__ __device__ void init(int M, int N, int G_, int c_) { base.init(M, N, G_, c_); }
    __host__ __device__ bool next(int i, Unit& u) const { Unit v; if (!base.next(i >> 1, v)) return false; u.pm = v.pm + ((i & 1) ? 128 : 0); u.pn = v.pn + ((i & 1) ? 4 : 0); return true; }
    __device__ __forceinline__ void a_ready(const Unit&) const {}
    __device__ __forceinline__ void done(const Unit&) const {}
};
struct EpiGatePair {
    static constexpr bool PERM = true, AFTER_DRAIN = false;
    EpiGate<true> e0; EpiGate<false> e1;
    __device__ __forceinline__ void operator()(const f32x4 (&acc)[2][2][4][2], const Unit& u, int wr, int wc, int fr, int fq) const {
        if (u.pm < 128) e0(acc, u, wr, wc, fr, fq); else { const Unit v{u.pm - 128, u.pn - 4}; e1(acc, v, wr, wc, fr, fq); }
    }
};
struct EpiRes {
    static constexpr bool PERM = true, AFTER_DRAIN = false;
    const float* x; bf16_t* h1b; float* ssq;
    __device__ __forceinline__ void operator()(const f32x4 (&acc)[2][2][4][2], const Unit& u, int wr, int wc, int fr, int fq) const {
        const int row0 = u.pm * BM + wr * 64 + fr, col0 = u.pn * BM + wc * 32 + 8 * fq;
#pragma unroll
        for (int ai = 0; ai < 2; ++ai)
#pragma unroll
            for (int m = 0; m < 4; ++m) { const int row = row0 + ai * HALF + m * 16; const size_t idx = (size_t)row * 1024 + col0; float ss = 0.f;
#pragma unroll
                for (int bj = 0; bj < 2; ++bj) { const f32x4 x0 = __builtin_nontemporal_load((const f32x4*)(x + idx + bj * HALF)), x1 = __builtin_nontemporal_load((const f32x4*)(x + idx + bj * HALF + 4));
                    const f32x4 h0 = x0 + acc[ai][bj][m][0], h1v = x1 + acc[ai][bj][m][1];
                    float f[8] = {h0[0], h0[1], h0[2], h0[3], h1v[0], h1v[1], h1v[2], h1v[3]};
#pragma unroll
                    for (int e = 0; e < 8; ++e) ss += f[e] * f[e];
                    *(u32x4*)(h1b + idx + bj * HALF) = pack8(f); }
                ss += __shfl_xor(ss, 16); ss += __shfl_xor(ss, 32);
                if (fq == 0) atomicAdd(ssq + row, ss); }
    }
};
struct EpiUp {
    static constexpr bool PERM = true, AFTER_DRAIN = false;
    const float* ssq; bf16_t* U;
    __device__ __forceinline__ void operator()(const f32x4 (&acc)[2][2][4][2], const Unit& u, int wr, int wc, int fr, int fq) const {
        const int row0 = u.pm * BM + wr * 64 + fr, col0 = u.pn * BM + wc * 32 + 8 * fq;
#pragma unroll
        for (int ai = 0; ai < 2; ++ai)
#pragma unroll
            for (int m = 0; m < 4; ++m) { const int row = row0 + ai * HALF + m * 16; const float rs = __builtin_amdgcn_rsqf(ssq[row] * (1.0f / 1024.0f) + 1e-6f); bf16_t* rowp = U + (size_t)row * 4096 + col0;
#pragma unroll
                for (int bj = 0; bj < 2; ++bj) { const f32x4 v0 = acc[ai][bj][m][0], v1 = acc[ai][bj][m][1];
                    float f[8] = {v0[0], v0[1], v0[2], v0[3], v1[0], v1[1], v1[2], v1[3]};
#pragma unroll
                    for (int e = 0; e < 8; ++e) { const float r = fmaxf(f[e] * rs, 0.f); f[e] = r * r; }
                    *(u32x4*)(rowp + bj * HALF) = pack8(f); } }
    }
};
struct EpiDown {
    static constexpr bool PERM = true, AFTER_DRAIN = false;
    const bf16_t* h1b; float* out;
    __device__ __forceinline__ void operator()(const f32x4 (&acc)[2][2][4][2], const Unit& u, int wr, int wc, int fr, int fq) const {
        const int row0 = u.pm * BM + wr * 64 + fr, col0 = u.pn * BM + wc * 32 + 8 * fq;
#pragma unroll
        for (int ai = 0; ai < 2; ++ai)
#pragma unroll
            for (int m = 0; m < 4; ++m) { const size_t idx = (size_t)(row0 + ai * HALF + m * 16) * 1024 + col0;
#pragma unroll
                for (int bj = 0; bj < 2; ++bj) { float h[8]; unpack8(__builtin_nontemporal_load((const u32x4*)(h1b + idx + bj * HALF)), h);
                    const f32x4 a0 = acc[ai][bj][m][0], a1 = acc[ai][bj][m][1];
                    __builtin_nontemporal_store(((f32x4){h[0] + a0[0], h[1] + a0[1], h[2] + a0[2], h[3] + a0[3]}), (f32x4*)(out + idx + bj * HALF));
                    __builtin_nontemporal_store(((f32x4){h[4] + a1[0], h[5] + a1[1], h[6] + a1[2], h[7] + a1[3]}), (f32x4*)(out + idx + bj * HALF + 4)); } }
    }
};
template <class Epi, class Sched, bool ALIGN_EPI = false, bool SP2 = false>
__device__ __forceinline__ void gemm_phase(PG8_LAS unsigned char* lds, const Gemm g, const Sched& S, const Epi& E) {
    int tid_ = threadIdx.x; asm volatile("" : "+v"(tid_));
    const int tid = tid_, wid = __builtin_amdgcn_readfirstlane(tid >> 6), lane = tid & 63, wr = wid >> 2, wc = wid & 3, fr = lane & 15, fq = lane >> 4;
    const int K = g.K, nt = K / BK;
    unsigned voffA[2], voffB[2];
#pragma unroll
    for (int i = 0; i < 2; ++i) { int R, C; stage_rc(tid * 16 + i * 8192, R, C); const int Rb = Epi::PERM ? ((R & ~31) + perm32(R & 31)) : R;
        voffA[i] = (unsigned)(R * K + C) * 2u; voffB[i] = (unsigned)(Rb * K + C) * 2u; }
    const size_t kstep = (size_t)(BK * 2);
    const size_t hstep = (size_t)HALF * K * 2;
    const size_t tstep = 2 * hstep;
    const unsigned ldsw = (unsigned)wid * 1024u;
    const int aoff = lds_byte(wr * 64 + fr, fq * 8), boff = lds_byte(wc * 32 + fr, fq * 8);
#define PG8_SA(b, h) (((b) * 2 + (h)) * HTB)
#define PG8_SB(b, h) ((4 + (b) * 2 + (h)) * HTB)
#define PG8_STAGE(bufoff, gbase, voff) do { _Pragma("unroll") for (int _i = 0; _i < 2; ++_i) \
        __builtin_amdgcn_global_load_lds((const unsigned*)((const char*)(gbase) + (voff)[_i]), (PG8_LAS unsigned*)(lds + (bufoff) + ldsw + _i * 8192), 16, 0, 0); } while (0)
#define PG8_LDA(dst, b, h) do { _Pragma("unroll") for (int m = 0; m < 4; ++m) _Pragma("unroll") for (int k = 0; k < 2; ++k) dst[m][k] = *(const PG8_LAS bf16x8*)(lds + PG8_SA(b, h) + aoff + m * 2048 + k * 1024); } while (0)
#define PG8_LDB(dst, b, h) do { _Pragma("unroll") for (int n = 0; n < 2; ++n) _Pragma("unroll") for (int k = 0; k < 2; ++k) dst[n][k] = *(const PG8_LAS bf16x8*)(lds + PG8_SB(b, h) + boff + n * 2048 + k * 1024); } while (0)
#define PG8_MMA(ai, bj, At, Bt) do { __builtin_amdgcn_s_setprio(1); _Pragma("unroll") for (int m = 0; m < 4; ++m) _Pragma("unroll") for (int n = 0; n < 2; ++n) _Pragma("unroll") for (int k = 0; k < 2; ++k) \
        acc[ai][bj][m][n] = __builtin_amdgcn_mfma_f32_16x16x32_bf16(Bt[n][k], At[m][k], acc[ai][bj][m][n], 0, 0, 0); __builtin_amdgcn_s_setprio(0); } while (0)
#define PG8_WAIT_V(n) asm volatile("s_waitcnt vmcnt(" #n ")" ::: "memory")
#define PG8_WAIT_L(n) asm volatile("s_waitcnt lgkmcnt(" #n ")" ::: "memory")
#define PG8_BAR __builtin_amdgcn_s_barrier()
#define PG8_SCHED __builtin_amdgcn_sched_barrier(0)
    Unit cur, nxt; int ui = 0;
    if (!S.next(0, cur)) return;
    f32x4 acc[2][2][4][2];
#pragma unroll
    for (int a = 0; a < 2; ++a)
#pragma unroll
        for (int b = 0; b < 2; ++b)
#pragma unroll
            for (int m = 0; m < 4; ++m)
#pragma unroll
                for (int n = 0; n < 2; ++n) acc[a][b][m][n] = (f32x4){0.f, 0.f, 0.f, 0.f};
    bf16x8 At[4][2], B0[2][2], B1[2][2];
    const char* cA = (const char*)g.A + (size_t)cur.pm * tstep; const char* cB = (const char*)g.Bt + (size_t)cur.pn * tstep;
    S.a_ready(cur);
    if constexpr (SP2) {
        PG8_STAGE(PG8_SB(0, 0), cB, voffB); PG8_STAGE(PG8_SB(0, 1), cB + hstep, voffB); PG8_STAGE(PG8_SA(0, 0), cA, voffA); PG8_STAGE(PG8_SA(0, 1), cA + hstep, voffA);
        if (wr == 1) PG8_BAR;
        PG8_WAIT_V(2); PG8_BAR;
        PG8_STAGE(PG8_SB(1, 0), cB + kstep, voffB); PG8_STAGE(PG8_SA(1, 0), cA + kstep, voffA); PG8_STAGE(PG8_SB(1, 1), cB + hstep + kstep, voffB);
        PG8_WAIT_V(6); PG8_BAR;
    } else {
        PG8_STAGE(PG8_SB(0, 0), cB, voffB); PG8_STAGE(PG8_SA(0, 0), cA, voffA); PG8_STAGE(PG8_SB(0, 1), cB + hstep, voffB); PG8_STAGE(PG8_SA(0, 1), cA + hstep, voffA);
        if (wr == 1) PG8_BAR;
        PG8_WAIT_V(4); PG8_BAR;
        PG8_STAGE(PG8_SB(1, 0), cB + kstep, voffB); PG8_STAGE(PG8_SA(1, 0), cA + kstep, voffA); PG8_STAGE(PG8_SB(1, 1), cB + hstep + kstep, voffB);
        PG8_WAIT_V(6); PG8_BAR;
    }
    for (;;) {
        const bool has_next = S.next(ui + 1, nxt);
        const char* nA = has_next ? (const char*)g.A + (size_t)nxt.pm * tstep : cA; const char* nB = has_next ? (const char*)g.Bt + (size_t)nxt.pn * tstep : cB;
        for (int t = 0; t < nt; t += 2) {
            const bool last = (t == nt - 2);
            const char* a1 = cA + (size_t)(t + 1) * kstep;
            const char* a2 = last ? nA : cA + (size_t)(t + 2) * kstep; const char* b2 = last ? nB : cB + (size_t)(t + 2) * kstep;
            const char* a3 = a2 + kstep; const char* b3 = b2 + kstep;
            if (last && has_next) S.a_ready(nxt);
            if constexpr (SP2) {
            PG8_LDB(B0, 0, 0); PG8_LDB(B1, 0, 1); PG8_SCHED; PG8_LDA(At, 0, 0); PG8_STAGE(PG8_SA(1, 1), a1 + hstep, voffA);
            PG8_WAIT_V(8); PG8_WAIT_L(0); PG8_BAR; PG8_MMA(0, 0, At, B0); PG8_MMA(0, 1, At, B1); PG8_BAR; PG8_SCHED;
            PG8_LDA(At, 0, 1); PG8_STAGE(PG8_SB(0, 0), b2, voffB); PG8_STAGE(PG8_SB(0, 1), b2 + hstep, voffB); PG8_STAGE(PG8_SA(0, 0), a2, voffA);
            PG8_WAIT_V(8); PG8_WAIT_L(0); PG8_BAR; PG8_MMA(1, 0, At, B0); PG8_MMA(1, 1, At, B1); PG8_BAR; PG8_SCHED;
            PG8_LDB(B0, 1, 0); PG8_LDB(B1, 1, 1); PG8_SCHED; PG8_LDA(At, 1, 0); PG8_STAGE(PG8_SA(0, 1), a2 + hstep, voffA);
            PG8_WAIT_V(8); PG8_WAIT_L(0); PG8_BAR; PG8_MMA(0, 0, At, B0); PG8_MMA(0, 1, At, B1); PG8_BAR; PG8_SCHED;
            PG8_LDA(At, 1, 1); PG8_STAGE(PG8_SB(1, 0), b3, voffB); PG8_STAGE(PG8_SB(1, 1), b3 + hstep, voffB); PG8_STAGE(PG8_SA(1, 0), a3, voffA);
            PG8_WAIT_V(8); PG8_WAIT_L(0); PG8_BAR; PG8_MMA(1, 0, At, B0); PG8_MMA(1, 1, At, B1); PG8_BAR; PG8_SCHED;
            } else {
            PG8_LDB(B0, 0, 0); PG8_SCHED; PG8_LDA(At, 0, 0); PG8_STAGE(PG8_SA(1, 1), a1 + hstep, voffA);
            PG8_WAIT_L(8); PG8_BAR; PG8_WAIT_L(0); PG8_MMA(0, 0, At, B0); PG8_BAR; PG8_SCHED;
            PG8_LDB(B1, 0, 1); PG8_STAGE(PG8_SB(0, 0), b2, voffB);
            PG8_BAR; PG8_WAIT_L(0); PG8_MMA(0, 1, At, B1); PG8_BAR;
            PG8_LDA(At, 0, 1); PG8_STAGE(PG8_SA(0, 0), a2, voffA);
            PG8_BAR; PG8_WAIT_L(0); PG8_MMA(1, 0, At, B0); PG8_BAR; PG8_SCHED;
            PG8_STAGE(PG8_SB(0, 1), b2 + hstep, voffB);
            PG8_WAIT_V(6); PG8_BAR; PG8_MMA(1, 1, At, B1); PG8_BAR;
            PG8_LDB(B0, 1, 0); PG8_SCHED; PG8_LDA(At, 1, 0); PG8_STAGE(PG8_SA(0, 1), a2 + hstep, voffA);
            PG8_WAIT_L(8); PG8_BAR; PG8_WAIT_L(0); PG8_MMA(0, 0, At, B0); PG8_BAR; PG8_SCHED;
            PG8_LDB(B1, 1, 1); PG8_STAGE(PG8_SB(1, 0), b3, voffB);
            PG8_BAR; PG8_WAIT_L(0); PG8_MMA(0, 1, At, B1); PG8_BAR;
            PG8_LDA(At, 1, 1); PG8_STAGE(PG8_SA(1, 0), a3, voffA);
            PG8_BAR; PG8_WAIT_L(0); PG8_MMA(1, 0, At, B0); PG8_BAR; PG8_SCHED;
            PG8_STAGE(PG8_SB(1, 1), b3 + hstep, voffB);
            PG8_WAIT_V(6); PG8_BAR; PG8_MMA(1, 1, At, B1); PG8_BAR;
            }
        }
        if constexpr (ALIGN_EPI) { if (wr == 0) PG8_BAR; }
        if constexpr (!Epi::AFTER_DRAIN) { E(acc, cur, wr, wc, fr, fq); S.done(cur); }
        if (!has_next) break;
#pragma unroll
        for (int a = 0; a < 2; ++a)
#pragma unroll
            for (int b = 0; b < 2; ++b)
#pragma unroll
                for (int m = 0; m < 4; ++m)
#pragma unroll
                    for (int n = 0; n < 2; ++n) acc[a][b][m][n] = (f32x4){0.f, 0.f, 0.f, 0.f};
        cur = nxt; cA = nA; cB = nB; ++ui;
        if constexpr (ALIGN_EPI) { if (wr == 1) PG8_BAR; }
    }
    PG8_WAIT_V(0);
    if constexpr (!ALIGN_EPI) { if (wr == 0) PG8_BAR; }
    PG8_BAR;
    if constexpr (Epi::AFTER_DRAIN) { E.fused(acc, cur, wr, wc, fr, fq, lds, wid, lane); S.done(cur); }
#undef PG8_SA
#undef PG8_SB
#undef PG8_STAGE
#undef PG8_LDA
#undef PG8_LDB
#undef PG8_MMA
#undef PG8_WAIT_V
#undef PG8_WAIT_L
#undef PG8_BAR
#undef PG8_SCHED
}
}

using pg8::bf16_t; using pg8::bf16x8; using pg8::f32x4; using pg8::u32x4; using pg8::unpack8; using pg8::pack8;
typedef unsigned u32x2 __attribute__((ext_vector_type(2)));
#define MFMA16(a, b, c) __builtin_amdgcn_mfma_f32_16x16x32_bf16((a), (b), (c), 0, 0, 0)
__device__ __forceinline__ unsigned pk2(float lo, float hi) { return pg8::cvt_pk_bf16(lo, hi); }
__device__ __forceinline__ unsigned pk2v(float lo, float hi) { return pg8::cvt_pk_bf16_v(lo, hi); }
__device__ __forceinline__ u32x4 pack8v(const float (&f)[8]) { u32x4 w; w.x = pk2v(f[0], f[1]); w.y = pk2v(f[2], f[3]); w.z = pk2v(f[4], f[5]); w.w = pk2v(f[6], f[7]); return w; }
__device__ __forceinline__ float wave_sum(float v) {
#pragma unroll
    for (int o = 1; o < 64; o <<= 1) v += __shfl_xor(v, o);
    return v;
}
#define LDS_WAIT() asm volatile("s_waitcnt lgkmcnt(0)" ::: "memory")
template <int CTRL> __device__ __forceinline__ float dpp_mov(float v) { return __builtin_bit_cast(float, __builtin_amdgcn_update_dpp(0, __builtin_bit_cast(int, v), CTRL, 0xf, 0xf, true)); }
__device__ __forceinline__ float sum8_dpp(float v) { v += dpp_mov<0xB1>(v); v += dpp_mov<0x4E>(v); v += dpp_mov<0x141>(v); return v; }
__device__ __forceinline__ float max8_dpp(float v) { v = fmaxf(v, dpp_mov<0xB1>(v)); v = fmaxf(v, dpp_mov<0x4E>(v)); v = fmaxf(v, dpp_mov<0x141>(v)); return v; }
__device__ __forceinline__ float sum16_dpp(float v) { v = sum8_dpp(v); v += dpp_mov<0x140>(v); return v; }

__device__ __forceinline__ void transpose_item(const float* __restrict__ W, int ldw, int K, bf16_t* WT, int dst_row0, int src_col0, int nvalid, const float* __restrict__ kscale, int k0, LAS float* scr, int lane) {
    const int c4 = lane & 7, kr = lane >> 3;
    f32x4 v[8];
#pragma unroll
    for (int i = 0; i < 8; ++i) { v[i] = (f32x4){0.f, 0.f, 0.f, 0.f};
        if (4 * c4 < nvalid) v[i] = __builtin_nontemporal_load((const f32x4*)(W + (size_t)(k0 + kr + 8 * i) * ldw + src_col0 + 4 * c4)); }
    if (kscale) {
#pragma unroll
        for (int i = 0; i < 8; ++i) v[i] = v[i] * kscale[k0 + kr + 8 * i];
    }
#pragma unroll
    for (int i = 0; i < 8; ++i) { LAS float* d = scr + (kr + 8 * i) * 33 + 4 * c4; d[0] = v[i].x; d[1] = v[i].y; d[2] = v[i].z; d[3] = v[i].w; }
    LDS_WAIT(); asm volatile("" ::: "memory");
    const int ch = lane & 7;
#pragma unroll
    for (int j = 0; j < 4; ++j) { const int n = (lane >> 3) + 8 * j; const LAS float* s = scr + (8 * ch) * 33 + n;
        u32x4 o; o.x = pk2(s[0 * 33], s[1 * 33]); o.y = pk2(s[2 * 33], s[3 * 33]); o.z = pk2(s[4 * 33], s[5 * 33]); o.w = pk2(s[6 * 33], s[7 * 33]);
        *(u32x4*)(WT + (size_t)(dst_row0 + n) * K + k0 + 8 * ch) = o; }
    LDS_WAIT(); asm volatile("" ::: "memory");
}
struct Ptrs {
    const float *x, *norm_mix, *w_in, *w_alpha2, *b_alpha, *gla_norm, *swa_qn, *swa_kn, *sinks, *w_bg, *w_bs, *w_out, *norm_mlp, *w_up, *w_down;
    float* out; unsigned char* ws;
};
constexpr int P0_I_SQ = 16 * 32, P0_I_UP = 16 * 128, P0_I_DN = 64 * 32, P0_REST_ITEMS = 3 * P0_I_SQ + P0_I_UP + P0_I_DN;
__device__ __forceinline__ void transpose_rest_item(const Ptrs& P, int r, LAS float* scr, int lane) {
    if (r < P0_I_SQ) { transpose_item(P.w_bg, 1024, 1024, (bf16_t*)(P.ws + WS_WBG), 32 * (r % 32), 32 * (r % 32), 32, nullptr, 64 * (r / 32), scr, lane); return; } r -= P0_I_SQ;
    if (r < P0_I_SQ) { transpose_item(P.w_bs, 1024, 1024, (bf16_t*)(P.ws + WS_WBS), 32 * (r % 32), 32 * (r % 32), 32, nullptr, 64 * (r / 32), scr, lane); return; } r -= P0_I_SQ;
    if (r < P0_I_SQ) { transpose_item(P.w_out, 1024, 1024, (bf16_t*)(P.ws + WS_WOUT), 32 * (r % 32), 32 * (r % 32), 32, nullptr, 64 * (r / 32), scr, lane); return; } r -= P0_I_SQ;
    if (r < P0_I_UP) { transpose_item(P.w_up, 4096, 1024, (bf16_t*)(P.ws + WS_WUP), 32 * (r % 128), 32 * (r % 128), 32, P.norm_mlp, 64 * (r / 128), scr, lane); return; } r -= P0_I_UP;
    transpose_item(P.w_down, 1024, 4096, (bf16_t*)(P.ws + WS_WDN), 32 * (r % 32), 32 * (r % 32), 32, nullptr, 64 * (r / 32), scr, lane);
}
__device__ __forceinline__ void p0_prologue(const Ptrs& P, LAS unsigned char* lds, int tid, int G, int blk) {
    const int lane = tid & 63, wave = tid >> 6;
    LAS float* scr = (LAS float*)(lds + wave * 12288);
    const int gw = blk * 8 + wave, NGW = G * 8;
    LAS bf16_t* WA = (LAS bf16_t*)(lds + 98304);
    for (int idx = tid; idx < 4096; idx += 512) { const int k = idx >> 2, c = (idx & 3) * 4; const f32x4 w = *(const f32x4*)(P.w_in + (size_t)k * 6672 + 3072 + c); const unsigned p0 = pk2(w.x, w.y), p1 = pk2(w.z, w.w);
        WA[(c + 0) * 1032 + k] = (bf16_t)(p0 & 0xffffu); WA[(c + 1) * 1032 + k] = (bf16_t)(p0 >> 16); WA[(c + 2) * 1032 + k] = (bf16_t)(p1 & 0xffffu); WA[(c + 3) * 1032 + k] = (bf16_t)(p1 >> 16); }
    __syncthreads();
    constexpr int I_IN = 16 * (NPROJ / 32);
    const int nitems = (G == 256) ? I_IN : I_IN + P0_REST_ITEMS;
    for (int it = gw; it < nitems; it += NGW) {
        if (it < I_IN) { const int nblk = NPROJ / 32, kb = it / nblk, nb = it % nblk, d = 32 * nb; int src, nv;
            if (d < 3072) { src = d; nv = 32; } else { src = d + 16; nv = 32; }
            transpose_item(P.w_in, 6672, 1024, (bf16_t*)(P.ws + WS_WIN), d, src, nv, nullptr, 64 * kb, scr, lane); continue; }
        transpose_rest_item(P, it - I_IN, scr, lane);
    }
    bf16_t* hn = (bf16_t*)P.out; float* alr = (float*)(P.ws + WS_ALR);
    LAS bf16_t* SR = (LAS bf16_t*)scr;
    const int fr = lane & 15, fq = lane >> 4;
    f32x4 gm[4];
#pragma unroll
    for (int j = 0; j < 4; ++j) gm[j] = *(const f32x4*)(P.norm_mix + 4 * lane + 256 * j);
    for (int m0 = gw * 4; m0 < M_TOK; m0 += NGW * 4) {
        f32x4 v[4][4];
#pragma unroll
        for (int r = 0; r < 4; ++r) { const f32x4* xr = (const f32x4*)(P.x + (size_t)(m0 + r) * DM) + lane;
#pragma unroll
            for (int j = 0; j < 4; ++j) v[r][j] = __builtin_nontemporal_load(xr + 64 * j); }
#pragma unroll
        for (int r = 0; r < 4; ++r) { float s = 0.f;
#pragma unroll
            for (int j = 0; j < 4; ++j) s += (v[r][j].x * v[r][j].x + v[r][j].y * v[r][j].y) + (v[r][j].z * v[r][j].z + v[r][j].w * v[r][j].w);
            const float rs = __builtin_amdgcn_rsqf(wave_sum(s) * (1.0f / DM) + 1e-6f);
            unsigned long long* o8 = (unsigned long long*)(hn + (size_t)(m0 + r) * DM) + lane;
#pragma unroll
            for (int j = 0; j < 4; ++j) { const f32x4 y = v[r][j] * rs * gm[j]; const unsigned long long pk = (unsigned long long)pk2(y.x, y.y) | ((unsigned long long)pk2(y.z, y.w) << 32);
                o8[64 * j] = pk; *(LAS unsigned long long*)(SR + r * 1032 + 4 * lane + 256 * j) = pk; } }
        LDS_WAIT(); asm volatile("" ::: "memory");
        f32x4 ac0 = (f32x4){0.f, 0.f, 0.f, 0.f}, ac1 = ac0;
#pragma unroll 8
        for (int ks = 0; ks < 32; ks += 2) {
            const bf16x8 a0 = *(const LAS bf16x8*)(SR + (fr & 3) * 1032 + ks * 32 + fq * 8), b0 = *(const LAS bf16x8*)(WA + fr * 1032 + ks * 32 + fq * 8);
            const bf16x8 a1 = *(const LAS bf16x8*)(SR + (fr & 3) * 1032 + ks * 32 + 32 + fq * 8), b1 = *(const LAS bf16x8*)(WA + fr * 1032 + ks * 32 + 32 + fq * 8);
            ac0 = MFMA16(a0, b0, ac0); ac1 = MFMA16(a1, b1, ac1); }
        ac0 = ac0 + ac1;
        if (fq == 0) {
#pragma unroll
            for (int i = 0; i < 4; ++i) alr[(size_t)(m0 + i) * 16 + fr] = ac0[i]; }
        LDS_WAIT(); asm volatile("" ::: "memory");
    }
    float* ssq = (float*)(P.ws + WS_SSQ);
    for (int i = blk * 512 + tid; i < M_TOK; i += G * 512) ssq[i] = 0.f;
}

constexpr int SW_QN = 0, SW_KN = 36864, SW_VT = 64512, SW_OT = 90112;
struct SwaRegs { u32x4 q[4], k[3], v[3]; };
__device__ __forceinline__ void swa_load(SwaRegs& R, int b, int n, int kh, const bf16_t* __restrict__ SQ, const bf16_t* __restrict__ SKV, int tid) {
    asm volatile("" : "+v"(tid));
    const int lane = tid & 63, wave = tid >> 6, dq = tid & 7;
    const bf16_t* qb = SQ + ((size_t)b * SEQ_T + (size_t)n * 64) * 1024 + kh * 256;
    const bf16_t* kb = SKV + (size_t)b * SEQ_T * 512 + kh * 64;
    const int p0 = n * 64 - 128;
#pragma unroll
    for (int i = 0; i < 4; ++i) { const unsigned o = (unsigned)tid + 512u * i; R.q[i] = *(const u32x4*)(qb + ((o >> 5) * 1024u + (o & 31u) * 8u)); }
#pragma unroll
    for (int i = 0; i < 3; ++i) { const int j = (int)(((unsigned)tid + 512u * i) >> 3); const int pos = p0 + j;
        R.k[i] = (u32x4){0u, 0u, 0u, 0u};
        if (pos >= 0) R.k[i] = *(const u32x4*)(kb + ((unsigned)pos * 512u + (unsigned)dq * 8u)); }
#pragma unroll
    for (int i = 0; i < 3; ++i) { const int j = (lane >> 3) + 8 * wave + 64 * i; const int pos = p0 + j;
        R.v[i] = (u32x4){0u, 0u, 0u, 0u};
        if (pos >= 0) R.v[i] = *(const u32x4*)(kb + ((unsigned)pos * 512u + 256u + (unsigned)dq * 8u)); }
}
__device__ __forceinline__ float swa_stage(const SwaRegs& R, const float* __restrict__ qn, const float* __restrict__ kn, LAS unsigned char* lds, int tid) {
    asm volatile("" : "+v"(tid));
    const int lane = tid & 63, wave = tid >> 6, dq = tid & 7;
    LAS bf16_t* Qn = (LAS bf16_t*)(lds + SW_QN); LAS bf16_t* Kn = (LAS bf16_t*)(lds + SW_KN); LAS bf16_t* Vt = (LAS bf16_t*)(lds + SW_VT);
    float gqmax, gkmax;
    {
        float g8[8]; { const f32x4 a = *(const f32x4*)(qn + dq * 8), c = *(const f32x4*)(qn + dq * 8 + 4); g8[0] = a.x; g8[1] = a.y; g8[2] = a.z; g8[3] = a.w; g8[4] = c.x; g8[5] = c.y; g8[6] = c.z; g8[7] = c.w; }
#pragma unroll
        for (int i = 0; i < 4; ++i) { const int o = tid + 512 * i, t = o >> 5, oc = o & 31, g = oc >> 3;
            float f[8]; unpack8(R.q[i], f);
            float ss = 0.f;
#pragma unroll
            for (int e = 0; e < 8; ++e) ss += f[e] * f[e];
            ss = sum8_dpp(ss);
            const float rs = __builtin_amdgcn_rsqf(ss * (1.0f / 64.0f) + 1e-6f) * (0.125f * 1.4426950408889634f);
#pragma unroll
            for (int e = 0; e < 8; ++e) f[e] = f[e] * rs * g8[e];
            *(LAS u32x4*)(Qn + (g * 64 + t) * 72 + dq * 8) = pack8(f); __builtin_amdgcn_sched_barrier(0); }
        float m = 0.f;
#pragma unroll
        for (int e = 0; e < 8; ++e) m = fmaxf(m, fabsf(g8[e]));
        gqmax = max8_dpp(m);
    }
    {
        float g8[8]; { const f32x4 a = *(const f32x4*)(kn + dq * 8), c = *(const f32x4*)(kn + dq * 8 + 4); g8[0] = a.x; g8[1] = a.y; g8[2] = a.z; g8[3] = a.w; g8[4] = c.x; g8[5] = c.y; g8[6] = c.z; g8[7] = c.w; }
#pragma unroll
        for (int i = 0; i < 3; ++i) { const int o = tid + 512 * i, j = o >> 3;
            float f[8]; unpack8(R.k[i], f);
            float ss = 0.f;
#pragma unroll
            for (int e = 0; e < 8; ++e) ss += f[e] * f[e];
            ss = sum8_dpp(ss);
            const float rs = __builtin_amdgcn_rsqf(ss * (1.0f / 64.0f) + 1e-6f);
#pragma unroll
            for (int e = 0; e < 8; ++e) f[e] = f[e] * rs * g8[e];
            *(LAS u32x4*)(Kn + j * 72 + dq * 8) = pack8(f); __builtin_amdgcn_sched_barrier(0); }
        float m = 0.f;
#pragma unroll
        for (int e = 0; e < 8; ++e) m = fmaxf(m, fabsf(g8[e]));
        gkmax = max8_dpp(m);
    }
#pragma unroll
    for (int i = 0; i < 3; ++i) { const int j = (lane >> 3) + 8 * wave + 64 * i; const u32x4 w = R.v[i];
        LAS bf16_t* vp = Vt + (dq * 8) * 200 + (j ^ (dq << 3));
        vp[0 * 200] = (bf16_t)(w.x & 0xffffu); vp[1 * 200] = (bf16_t)(w.x >> 16); vp[2 * 200] = (bf16_t)(w.y & 0xffffu); vp[3 * 200] = (bf16_t)(w.y >> 16);
        vp[4 * 200] = (bf16_t)(w.z & 0xffffu); vp[5 * 200] = (bf16_t)(w.z >> 16); vp[6 * 200] = (bf16_t)(w.w & 0xffffu); vp[7 * 200] = (bf16_t)(w.w >> 16); }
    return 8.0f * 1.4426950408889634f * gqmax * gkmax;
}
__device__ __forceinline__ void swa_compute(float M2, int b, int n, int kh, bf16_t* __restrict__ OS, const float* __restrict__ sinks, LAS unsigned char* lds, int tid) {
    asm volatile("" : "+v"(tid));
    const int lane = tid & 63, wave = tid >> 6, fr = lane & 15, fq = lane >> 4;
    LAS bf16_t* Qn = (LAS bf16_t*)(lds + SW_QN); LAS bf16_t* Kn = (LAS bf16_t*)(lds + SW_KN); LAS bf16_t* Vt = (LAS bf16_t*)(lds + SW_VT);
    const int g = wave >> 1, qh = wave & 1;
    const int hh = kh * 4 + g; const float slope = exp2f(-0.5f * (float)(hh + 1)) * 1.4426950408889634f; const float sink = sinks[hh] * 1.4426950408889634f;
    bf16x8 bq[2][2]; float fb[2];
#pragma unroll
    for (int qt = 0; qt < 2; ++qt) { const int qrow = qh * 32 + qt * 16 + fr; fb[qt] = (float)(128 + qrow - 4 * fq);
#pragma unroll
        for (int ks = 0; ks < 2; ++ks) bq[qt][ks] = *(const LAS bf16x8*)(Qn + (g * 64 + qrow) * 72 + ks * 32 + fq * 8); }
    float l[2] = {0.f, 0.f};
    f32x4 oa[4][2];
#pragma unroll
    for (int dt = 0; dt < 4; ++dt)
#pragma unroll
        for (int qt = 0; qt < 2; ++qt) oa[dt][qt] = (f32x4){0.f, 0.f, 0.f, 0.f};
    const int kg0 = n >= 2 ? 0 : 2 - n;
#pragma unroll 1
    for (int kg = kg0; kg < 3; ++kg) {
        float ini[2];
#pragma unroll
        for (int qt = 0; qt < 2; ++qt) ini[qt] = kg < 2 ? -M2 - slope * (fb[qt] - (float)(kg * 64)) : -M2;
        f32x4 sc[4][2];
#pragma unroll
        for (int k4 = 0; k4 < 4; ++k4) { const LAS bf16_t* kr = Kn + (kg * 64 + k4 * 16 + fr) * 72 + fq * 8;
            const bf16x8 ak0 = *(const LAS bf16x8*)(kr), ak1 = *(const LAS bf16x8*)(kr + 32);
#pragma unroll
            for (int qt = 0; qt < 2; ++qt) { f32x4 a = (f32x4){ini[qt], ini[qt], ini[qt], ini[qt]}; a = MFMA16(ak0, bq[qt][0], a); a = MFMA16(ak1, bq[qt][1], a); sc[k4][qt] = a; } }
        if (kg < 2) {
#pragma unroll
            for (int k4 = 0; k4 < 4; ++k4)
#pragma unroll
                for (int qt = 0; qt < 2; ++qt)
#pragma unroll
                    for (int i = 0; i < 4; ++i) sc[k4][qt][i] = fmaf(slope, (float)(k4 * 16 + i), sc[k4][qt][i]);
        } else {
#pragma unroll
            for (int k4 = 0; k4 < 4; ++k4)
#pragma unroll
                for (int qt = 0; qt < 2; ++qt)
#pragma unroll
                    for (int i = 0; i < 4; ++i) sc[k4][qt][i] = sc[k4][qt][i] - slope * fabsf((fb[qt] - 128.0f) - (float)(k4 * 16 + i));
        }
#pragma unroll
        for (int k4 = 0; k4 < 4; ++k4)
#pragma unroll
            for (int qt = 0; qt < 2; ++qt)
#pragma unroll
                for (int i = 0; i < 4; ++i) { const float p = __builtin_amdgcn_exp2f(sc[k4][qt][i]); sc[k4][qt][i] = p; l[qt] += p; }
#pragma unroll
        for (int s2 = 0; s2 < 2; ++s2) {
            bf16x8 bp[2];
#pragma unroll
            for (int qt = 0; qt < 2; ++qt) { u32x4 pw; pw.x = pk2v(sc[2 * s2][qt][0], sc[2 * s2][qt][1]); pw.y = pk2v(sc[2 * s2][qt][2], sc[2 * s2][qt][3]);
                pw.z = pk2v(sc[2 * s2 + 1][qt][0], sc[2 * s2 + 1][qt][1]); pw.w = pk2v(sc[2 * s2 + 1][qt][2], sc[2 * s2 + 1][qt][3]); bp[qt] = __builtin_bit_cast(bf16x8, pw); }
#pragma unroll
            for (int dt = 0; dt < 4; ++dt) { const int d = dt * 16 + fr, swz = ((d >> 3) & 7) << 3; const LAS bf16_t* vr = Vt + d * 200; const int j0 = kg * 64 + 32 * s2 + 4 * fq;
                const u32x2 lo = *(const LAS u32x2*)(vr + (j0 ^ swz)), hi = *(const LAS u32x2*)(vr + ((j0 + 16) ^ swz));
                u32x4 w; w.x = lo.x; w.y = lo.y; w.z = hi.x; w.w = hi.y; const bf16x8 av = __builtin_bit_cast(bf16x8, w);
#pragma unroll
                for (int qt = 0; qt < 2; ++qt) oa[dt][qt] = MFMA16(av, bp[qt], oa[dt][qt]); }
        }
    }
    const float esink = __builtin_amdgcn_exp2f(sink - M2);
#pragma unroll
    for (int qt = 0; qt < 2; ++qt) { float ls = l[qt]; ls += __shfl_xor(ls, 16); ls += __shfl_xor(ls, 32); const float inv = __builtin_amdgcn_rcpf(ls + esink);
        LAS bf16_t* op = (LAS bf16_t*)(lds + SW_OT) + (qh * 32 + qt * 16 + fr) * 264 + g * 64 + 4 * fq;
#pragma unroll
        for (int dt = 0; dt < 4; ++dt) { const f32x4 v = oa[dt][qt] * inv; u32x2 w; w.x = pk2(v[0], v[1]); w.y = pk2(v[2], v[3]); *(LAS u32x2*)(op + dt * 16) = w; } }
}
__device__ __forceinline__ void swa_store(int b, int n, int kh, bf16_t* __restrict__ OS, LAS unsigned char* lds, int tid) {
    asm volatile("" : "+v"(tid));
    const LAS bf16_t* OT = (const LAS bf16_t*)(lds + SW_OT);
    bf16_t* ob = OS + ((size_t)b * SEQ_T + (size_t)n * 64) * 1024 + kh * 256;
#pragma unroll
    for (int i = 0; i < 4; ++i) { const unsigned o = (unsigned)tid + 512u * i, t = o >> 5, oc = o & 31u; __builtin_nontemporal_store(*(const LAS u32x4*)(OT + t * 264u + oc * 8u), (u32x4*)(ob + (t * 1024u + oc * 8u))); }
}

constexpr int GL_CUM = 0, GL_QD = 34816, GL_KD = 52224, GL_KT = 69632, GL_VT = 88064, GL_P = 124928, GL_SSQ = 134144, GL_DEC = 136192, GL_QT = 137216, GL_ALR = 139264, GL_END = 143360;
static_assert(GL_END <= LDS_BYTES, "GLA LDS map");
constexpr int GLA_NSEG = 8, GLA_SEGC = 64 / GLA_NSEG;
template <bool FULL>
__device__ __forceinline__ void gla_seg(int b, int h, int seg, const bf16_t* __restrict__ QK, const bf16_t* __restrict__ GV, const bf16_t* __restrict__ GG, const float* __restrict__ ALR,
                                        const float* __restrict__ w2, const float* __restrict__ balpha, const float* __restrict__ gnorm, bf16_t* __restrict__ OG,
                                        float* __restrict__ Lws, float* __restrict__ Dws, LAS unsigned char* lds, int tid) {
    asm volatile("" : "+v"(tid));
    const int lane = tid & 63, wave = tid >> 6, fr = lane & 15, fq = lane >> 4;
    LAS float* CUM = (LAS float*)(lds + GL_CUM); LAS bf16_t* OB = (LAS bf16_t*)(lds + GL_QD);
    LAS bf16_t* QD = (LAS bf16_t*)(lds + GL_QD); LAS bf16_t* KD = (LAS bf16_t*)(lds + GL_KD); LAS bf16_t* KT = (LAS bf16_t*)(lds + GL_KT); LAS bf16_t* VT = (LAS bf16_t*)(lds + GL_VT);
    LAS bf16_t* PB = (LAS bf16_t*)(lds + GL_P); LAS float* SSQ = (LAS float*)(lds + GL_SSQ); LAS float* DEC = (LAS float*)(lds + GL_DEC); LAS float* QT = (LAS float*)(lds + GL_QT);
    LAS float* ALRS = (LAS float*)(lds + GL_ALR);
    const int lt = (lane >> 3) + 8 * wave, lo = lane & 7, lsw = lt ^ (lo << 3);
    const int seq = b * 4 + h;
    f32x4 S[8][2];
#pragma unroll
    for (int a = 0; a < 8; ++a)
#pragma unroll
        for (int c = 0; c < 2; ++c) S[a][c] = (f32x4){0.f, 0.f, 0.f, 0.f};
    if (FULL) {
        const float* Lb0 = Lws + (size_t)(seq * GLA_NSEG) * 32768 + (size_t)wave * 4096 + lane * 4; const float* Db0 = Dws + (seq * GLA_NSEG) * 128;
        f32x4 La[16], Lb[16];
#define GLA_LOADL(DST, J) do { _Pragma("unroll") for (int q_ = 0; q_ < 16; ++q_) DST[q_] = *(const f32x4*)(Lb0 + (size_t)(J) * 32768 + q_ * 256); } while (0)
#define GLA_FOLD(SRC, J) do { _Pragma("unroll") for (int dkt = 0; dkt < 8; ++dkt) { const f32x4 dc = *(const f32x4*)(Db0 + (J) * 128 + dkt * 16 + 4 * fq); \
            _Pragma("unroll") for (int dvt = 0; dvt < 2; ++dvt) S[dkt][dvt] = S[dkt][dvt] * dc + SRC[dkt * 2 + dvt]; } } while (0)
        if (seg > 0) GLA_LOADL(La, 0);
#pragma unroll 1
        for (int j = 0; j < seg; j += 2) {
            if (j + 1 < seg) GLA_LOADL(Lb, j + 1);
            GLA_FOLD(La, j);
            if (j + 1 < seg) { if (j + 2 < seg) GLA_LOADL(La, j + 2); GLA_FOLD(Lb, j + 1); }
        }
#undef GLA_LOADL
#undef GLA_FOLD
    }
    const int dkc = wave * 16 + fr;
    bf16x8 w2f; { float w[8];
#pragma unroll
        for (int j = 0; j < 8; ++j) w[j] = w2[((fq & 1) * 8 + j) * 512 + h * 128 + dkc];
        w2f = __builtin_bit_cast(bf16x8, pack8v(w)); }
    const float bz = balpha[h * 128 + dkc];
    const size_t tokb = (size_t)b * SEQ_T + (size_t)seg * (GLA_SEGC * 64);
    if (tid < 256) *(LAS f32x4*)(ALRS + tid * 4) = *(const f32x4*)(ALR + tokb * 16 + tid * 4);
    float segtot = 0.f;
    u32x4 qw[2], kw[2], vw[4];
#define GLA_LOAD_QKV(T0) do { _Pragma("unroll") for (int i_ = 0; i_ < 2; ++i_) { const int oc_ = lo + 8 * i_; \
            kw[i_] = *(const u32x4*)(QK + ((T0) + lt) * 1024 + 512 + h * 128 + oc_ * 8); } \
        _Pragma("unroll") for (int i_ = 0; i_ < 4; ++i_) { const int oc_ = lo + 8 * i_; vw[i_] = *(const u32x4*)(GV + ((T0) + lt) * 1024 + h * 256 + oc_ * 8); } } while (0)
    __syncthreads();
#pragma unroll 1
    for (int c = 0; c < GLA_SEGC; ++c) {
        const size_t tok0 = tokb + (size_t)c * 64;
        GLA_LOAD_QKV(tok0);
        if (FULL) {
#pragma unroll
            for (int i = 0; i < 2; ++i) qw[i] = *(const u32x4*)(QK + (tok0 + lt) * 1024 + h * 128 + (lo + 8 * i) * 8); }
        {
            float carry = 0.f;
#pragma unroll
            for (int tt = 0; tt < 4; ++tt) {
                const LAS f32x4* ar = (const LAS f32x4*)(ALRS + (tt * 16 + fr) * 16 + (fq & 1) * 8); const f32x4 x0 = ar[0], x1 = ar[1];
                float x[8] = {x0.x, x0.y, x0.z, x0.w, x1.x, x1.y, x1.z, x1.w}, xh[8];
                unpack8(pack8v(x), xh);
                if (fq >= 2) {
#pragma unroll
                    for (int e = 0; e < 8; ++e) x[e] -= xh[e];
                }
                const bf16x8 af = __builtin_bit_cast(bf16x8, pack8v(x));
                const f32x4 z4 = MFMA16(af, w2f, ((f32x4){0.f, 0.f, 0.f, 0.f}));
                float v[4];
#pragma unroll
                for (int i = 0; i < 4; ++i) { const float z = z4[i] + bz;
                    v[i] = (fminf(z, 0.f) - 0.6931471805599453f * __builtin_amdgcn_logf(1.0f + __builtin_amdgcn_exp2f(-1.4426950408889634f * fabsf(z)))) * (1.0f / 16.0f); }
                v[1] += v[0]; v[2] += v[1]; v[3] += v[2];
                const float tot4 = v[3];
                const float p1 = __shfl_up(tot4, 16); float sc = tot4 + (fq >= 1 ? p1 : 0.f);
                const float p2 = __shfl_up(sc, 32); sc += (fq >= 2 ? p2 : 0.f);
                const float base = carry + (sc - tot4);
#pragma unroll
                for (int i = 0; i < 4; ++i) CUM[(tt * 16 + 4 * fq + i) * 132 + dkc] = v[i] + base;
                carry += __shfl(sc, 48 + fr);
            }
            if (fq == 0) DEC[dkc] = __builtin_amdgcn_exp2f(1.4426950408889634f * carry);
            segtot += carry;
        }
        __syncthreads();
        if (c + 1 < GLA_SEGC && tid < 256) *(LAS f32x4*)(ALRS + tid * 4) = *(const f32x4*)(ALR + (tok0 + 64) * 16 + tid * 4);
#pragma unroll
        for (int i = 0; i < 2; ++i) { const int oc = lo + 8 * i, t = lt;
            float k8[8]; unpack8(kw[i], k8);
            const f32x4 c0 = *(const LAS f32x4*)(CUM + t * 132 + oc * 8), c1 = *(const LAS f32x4*)(CUM + t * 132 + oc * 8 + 4);
            const f32x4 d0 = *(const LAS f32x4*)(DEC + oc * 8), d1 = *(const LAS f32x4*)(DEC + oc * 8 + 4);
            const float cm[8] = {c0.x, c0.y, c0.z, c0.w, c1.x, c1.y, c1.z, c1.w}; const float dc[8] = {d0.x, d0.y, d0.z, d0.w, d1.x, d1.y, d1.z, d1.w};
            float kd[8], ke[8];
#pragma unroll
            for (int e = 0; e < 8; ++e) { const float em = __builtin_amdgcn_exp2f(-1.4426950408889634f * cm[e]); kd[e] = k8[e] * em; ke[e] = kd[e] * dc[e]; }
            if (FULL) { float q8[8], qd[8]; unpack8(qw[i], q8);
#pragma unroll
                for (int e = 0; e < 8; ++e) qd[e] = q8[e] * __builtin_amdgcn_exp2f(1.4426950408889634f * cm[e]) * 0.08838834764831845f;
                *(LAS u32x4*)(QD + t * 136 + oc * 8) = pack8(qd); *(LAS u32x4*)(KD + t * 136 + oc * 8) = pack8(kd); }
            const u32x4 kp8 = pack8(ke); LAS bf16_t* kp = KT + (oc * 8) * 72 + lsw;
            kp[0 * 72] = (bf16_t)(kp8.x & 0xffffu); kp[1 * 72] = (bf16_t)(kp8.x >> 16); kp[2 * 72] = (bf16_t)(kp8.y & 0xffffu); kp[3 * 72] = (bf16_t)(kp8.y >> 16);
            kp[4 * 72] = (bf16_t)(kp8.z & 0xffffu); kp[5 * 72] = (bf16_t)(kp8.z >> 16); kp[6 * 72] = (bf16_t)(kp8.w & 0xffffu); kp[7 * 72] = (bf16_t)(kp8.w >> 16); }
#pragma unroll
        for (int i = 0; i < 4; ++i) { const int oc = lo + 8 * i; const u32x4 w = vw[i]; LAS bf16_t* vp = VT + (oc * 8) * 72 + lsw;
            vp[0 * 72] = (bf16_t)(w.x & 0xffffu); vp[1 * 72] = (bf16_t)(w.x >> 16); vp[2 * 72] = (bf16_t)(w.y & 0xffffu); vp[3 * 72] = (bf16_t)(w.y >> 16);
            vp[4 * 72] = (bf16_t)(w.z & 0xffffu); vp[5 * 72] = (bf16_t)(w.z >> 16); vp[6 * 72] = (bf16_t)(w.w & 0xffffu); vp[7 * 72] = (bf16_t)(w.w >> 16); }
        __syncthreads();
        f32x4 o[4][2];
        u32x4 gw[4];
        if (FULL) {
            {
                const int tt = wave >> 1;
#pragma unroll
                for (int u2 = 0; u2 < 2; ++u2) { const int st = (wave & 1) * 2 + u2; f32x4 a = (f32x4){0.f, 0.f, 0.f, 0.f};
                    if (st <= tt) {
#pragma unroll
                        for (int ks = 0; ks < 4; ++ks) { const bf16x8 ak = *(const LAS bf16x8*)(KD + (st * 16 + fr) * 136 + ks * 32 + fq * 8), bq = *(const LAS bf16x8*)(QD + (tt * 16 + fr) * 136 + ks * 32 + fq * 8);
                            a = MFMA16(ak, bq, a); }
                    }
                    const int t = tt * 16 + fr, s0 = st * 16 + 4 * fq;
                    const float p0 = (s0 + 0 <= t) ? a[0] : 0.f, p1 = (s0 + 1 <= t) ? a[1] : 0.f, p2 = (s0 + 2 <= t) ? a[2] : 0.f, p3 = (s0 + 3 <= t) ? a[3] : 0.f;
                    u32x2 w; w.x = pk2(p0, p1); w.y = pk2(p2, p3); *(LAS u32x2*)(PB + t * 72 + s0) = w; }
            }
#pragma unroll
            for (int a = 0; a < 4; ++a)
#pragma unroll
                for (int d = 0; d < 2; ++d) o[a][d] = (f32x4){0.f, 0.f, 0.f, 0.f};
#pragma unroll
            for (int ks = 0; ks < 4; ++ks) {
                bf16x8 bs[2];
#pragma unroll
                for (int dvt = 0; dvt < 2; ++dvt) { u32x4 w; w.x = pk2v(S[2 * ks][dvt][0], S[2 * ks][dvt][1]); w.y = pk2v(S[2 * ks][dvt][2], S[2 * ks][dvt][3]);
                    w.z = pk2v(S[2 * ks + 1][dvt][0], S[2 * ks + 1][dvt][1]); w.w = pk2v(S[2 * ks + 1][dvt][2], S[2 * ks + 1][dvt][3]); bs[dvt] = __builtin_bit_cast(bf16x8, w); }
#pragma unroll
                for (int tt = 0; tt < 4; ++tt) { const LAS bf16_t* qp = QD + (tt * 16 + fr) * 136 + 32 * ks + 4 * fq;
                    const u32x2 lo = *(const LAS u32x2*)(qp), hi = *(const LAS u32x2*)(qp + 16);
                    u32x4 w; w.x = lo.x; w.y = lo.y; w.z = hi.x; w.w = hi.y; const bf16x8 aq = __builtin_bit_cast(bf16x8, w);
#pragma unroll
                    for (int dvt = 0; dvt < 2; ++dvt) o[tt][dvt] = MFMA16(aq, bs[dvt], o[tt][dvt]); }
            }
        }
        bf16x8 bv[2][2];
#pragma unroll
        for (int dvt = 0; dvt < 2; ++dvt)
#pragma unroll
            for (int ks = 0; ks < 2; ++ks) { const int dv = wave * 32 + dvt * 16 + fr; bv[dvt][ks] = *(const LAS bf16x8*)(VT + dv * 72 + ((ks * 32 + fq * 8) ^ (((dv >> 3) & 7) << 3))); }
#pragma unroll
        for (int dkt = 0; dkt < 8; ++dkt) { const f32x4 dc = *(const LAS f32x4*)(DEC + dkt * 16 + 4 * fq);
#pragma unroll
            for (int dvt = 0; dvt < 2; ++dvt) S[dkt][dvt] = S[dkt][dvt] * dc;
#pragma unroll
            for (int ks = 0; ks < 2; ++ks) { const int dkr = dkt * 16 + fr; const bf16x8 ak = *(const LAS bf16x8*)(KT + dkr * 72 + ((ks * 32 + fq * 8) ^ (((dkr >> 3) & 7) << 3)));
#pragma unroll
                for (int dvt = 0; dvt < 2; ++dvt) S[dkt][dvt] = MFMA16(ak, bv[dvt][ks], S[dkt][dvt]); } }
        if (FULL) {
#pragma unroll
            for (int i = 0; i < 4; ++i) { const int oid = tid + 512 * i, t = oid >> 5, oc = oid & 31; gw[i] = *(const u32x4*)(GG + (tok0 + t) * 1024 + h * 256 + oc * 8); }
        }
        __syncthreads();
        if (FULL) {
#pragma unroll
            for (int ks = 0; ks < 2; ++ks)
#pragma unroll
                for (int tt = 0; tt < 4; ++tt) { if (ks == 1 && tt < 2) continue;
                    const bf16x8 ap = *(const LAS bf16x8*)(PB + (tt * 16 + fr) * 72 + ks * 32 + fq * 8);
#pragma unroll
                    for (int dvt = 0; dvt < 2; ++dvt) o[tt][dvt] = MFMA16(ap, bv[dvt][ks], o[tt][dvt]); }
#pragma unroll
            for (int tt = 0; tt < 4; ++tt)
#pragma unroll
                for (int i = 0; i < 4; ++i) { const int t = tt * 16 + 4 * fq + i; const float v0 = o[tt][0][i], v1 = o[tt][1][i];
                    const unsigned w = pk2(v0, v1);
                    OB[t * 272 + wave * 32 + fr] = (bf16_t)(w & 0xffffu); OB[t * 272 + wave * 32 + 16 + fr] = (bf16_t)(w >> 16);
                    const float q = sum16_dpp(v0 * v0 + v1 * v1);
                    if (fr == 0) SSQ[wave * 64 + t] = q; }
            __syncthreads();
#pragma unroll
            for (int i = 0; i < 4; ++i) { const int oid = tid + 512 * i, t = oid >> 5, oc = oid & 31;
                float ss = 0.f;
#pragma unroll
                for (int w = 0; w < 8; ++w) ss += SSQ[w * 64 + t];
                const float rs = __builtin_amdgcn_rsqf(ss * (1.0f / 256.0f) + 1e-6f);
                float ov[8], gv[8]; unpack8(*(const LAS u32x4*)(OB + t * 272 + oc * 8), ov); unpack8(gw[i], gv);
                const f32x4 n0 = *(const f32x4*)(gnorm + oc * 8), n1 = *(const f32x4*)(gnorm + oc * 8 + 4); const float gn[8] = {n0.x, n0.y, n0.z, n0.w, n1.x, n1.y, n1.z, n1.w};
#pragma unroll
                for (int e = 0; e < 8; ++e) ov[e] = ov[e] * rs * gn[e] * gv[e];
                __builtin_nontemporal_store(pack8(ov), (u32x4*)(OG + (tok0 + t) * 1024 + h * 256 + oc * 8)); }
        }
    }
    if (!FULL) {
        float* Lj = Lws + (size_t)(seq * GLA_NSEG + seg) * 32768 + (size_t)wave * 4096 + lane * 4;
#pragma unroll
        for (int dkt = 0; dkt < 8; ++dkt)
#pragma unroll
            for (int dvt = 0; dvt < 2; ++dvt) *(f32x4*)(Lj + (dkt * 2 + dvt) * 256) = S[dkt][dvt];
        if (fq == 0) Dws[(seq * GLA_NSEG + seg) * 128 + dkc] = __builtin_amdgcn_exp2f(1.4426950408889634f * segtot);
    }
#undef GLA_LOAD_QKV
}

#define XB_TMO      128
#define XB_XCNT(j)  (256  + 64 * (j))
#define XB_XSUB(j)  (1280 + 64 * (j))
#define XB_XGEN(j)  (2304 + 64 * (j))
#define XB_TOP      3328
#define XB_TOPGEN   3392
#define XCD_BAR_WORDS 3456
#define XB_SPIN_CAP (1u << 18)

__device__ __forceinline__ unsigned xb_ld(unsigned* p)              { return __hip_atomic_load(p, __ATOMIC_RELAXED, __HIP_MEMORY_SCOPE_AGENT); }
__device__ __forceinline__ unsigned xb_add(unsigned* p, unsigned v) { return __hip_atomic_fetch_add(p, v, __ATOMIC_RELAXED, __HIP_MEMORY_SCOPE_AGENT); }
__device__ __forceinline__ unsigned xb_xcc_id() { return (unsigned)__builtin_amdgcn_s_getreg((3 << 11) | 20) & 0xFu; }
#define XB_SPIN(cond, bar) do { unsigned _sp = 0; while (cond) { __builtin_amdgcn_s_sleep(1); \
    if ((++_sp & 255u) == 0u) { if (xb_ld(&(bar)[XB_TMO])) break; if (_sp > XB_SPIN_CAP) { atomicAdd(&(bar)[XB_TMO], 1u); break; } } } } while (0)

struct XcdBarrier {
    unsigned* bar; unsigned x;
    volatile LAS unsigned* st;
};

__device__ __forceinline__ XcdBarrier xcd_barrier_post(unsigned* bar, volatile LAS unsigned* st) {
    XcdBarrier b; b.bar = bar; b.x = xb_xcc_id(); b.st = st;
    if (threadIdx.x == 0) (void)xb_add(&bar[XB_XCNT(b.x)], 1u);
    return b;
}
__device__ __forceinline__ void xcd_barrier_complete(unsigned* bar, unsigned x, unsigned& nloc, unsigned& nx) {
    const unsigned G = gridDim.x * gridDim.y * gridDim.z;
    unsigned sum, cnt, mine, sp = 0u;
    for (;;) {
        sum = 0u; cnt = 0u; mine = 0u;
#pragma unroll
        for (unsigned j = 0; j < 16; ++j) { const unsigned c = xb_ld(&bar[XB_XCNT(j)]); sum += c; cnt += (c > 0u) ? 1u : 0u; mine = (j == x) ? c : mine; }
        if (sum == G) break;
        __builtin_amdgcn_s_sleep(1);
        if ((++sp & 255u) == 0u) { if (xb_ld(&bar[XB_TMO])) break; if (sp > XB_SPIN_CAP) { atomicAdd(&bar[XB_TMO], 1u); break; } }
    }
    nloc = mine > 0u ? mine : 1u; nx = cnt > 0u ? cnt : 1u;
}

__device__ __forceinline__ void xcd_barrier(const XcdBarrier& b) {
    asm volatile("s_waitcnt vmcnt(0)" ::: "memory");
    __syncthreads();
    if (threadIdx.x == 0) {
        unsigned* bar = b.bar;
        __builtin_amdgcn_s_waitcnt(0);
        unsigned nloc = b.st[0], nx = b.st[1];
        if (nloc == 0u) { xcd_barrier_complete(bar, b.x, nloc, nx); b.st[0] = nloc; b.st[1] = nx; }
        const unsigned old = xb_add(&bar[XB_XSUB(b.x)], 1u);
        const unsigned gen = old / nloc;
        if (old + 1u == (gen + 1u) * nloc) {
            __builtin_amdgcn_fence(__ATOMIC_RELEASE, "agent");
            asm volatile("s_waitcnt vmcnt(0)" ::: "memory");
            const unsigned og = xb_add(&bar[XB_TOP], 1u);
            const unsigned tg = og / nx;
            if (og + 1u == (tg + 1u) * nx) xb_add(&bar[XB_TOPGEN], 1u);
            else XB_SPIN(xb_ld(&bar[XB_TOPGEN]) == tg, bar);
            __builtin_amdgcn_fence(__ATOMIC_ACQUIRE, "agent");
            xb_add(&bar[XB_XGEN(b.x)], 1u);
            asm volatile("s_waitcnt vmcnt(0)" ::: "memory");
        } else {
            XB_SPIN(xb_ld(&bar[XB_XGEN(b.x)]) == gen, bar);
            __builtin_amdgcn_fence(__ATOMIC_ACQUIRE, "agent");
            asm volatile("s_waitcnt vmcnt(0)" ::: "memory");
        }
    }
    __syncthreads();
}


struct Args { const float* in[15]; float* out; unsigned char* ws; };
__global__ void __launch_bounds__(512) mk_fwd(Args a) {
    extern __shared__ __attribute__((aligned(16))) unsigned char lds_raw[];
    cg::grid_group grid = cg::this_grid();
    LAS unsigned char* lds = (LAS unsigned char*)lds_raw;
    const int tid = threadIdx.x, G = gridDim.x, blk = blockIdx.x;
    Ptrs P; P.x = a.in[0]; P.norm_mix = a.in[1]; P.w_in = a.in[2]; P.w_alpha2 = a.in[3]; P.b_alpha = a.in[4]; P.gla_norm = a.in[5]; P.swa_qn = a.in[6]; P.swa_kn = a.in[7]; P.sinks = a.in[8];
    P.w_bg = a.in[9]; P.w_bs = a.in[10]; P.w_out = a.in[11]; P.norm_mlp = a.in[12]; P.w_up = a.in[13]; P.w_down = a.in[14]; P.out = a.out; P.ws = a.ws;
    unsigned char* ws = a.ws;
    bf16_t* OGLA = (bf16_t*)a.out; bf16_t* OSWA = (bf16_t*)a.out + (size_t)M_TOK * 1024;
    float* SSQ = (float*)(ws + WS_SSQ); float* ALR = (float*)(ws + WS_ALR);

    volatile LAS unsigned* xst = (volatile LAS unsigned*)(lds + LDS_BYTES - 16);
    if (tid < 4) xst[tid] = 0u;
    __syncthreads();
    const XcdBarrier xbar = xcd_barrier_post((unsigned*)(ws + WS_BAR), xst);
    const bool use_cg = G > 1024;
#define GRID_BAR() xcd_barrier(xbar)
    if (PH_MASK & 1) for (int rep = 0; rep < REP_P0; ++rep) p0_prologue(P, lds, tid, G, blk);
    if (use_cg) grid.sync(); else xcd_barrier(xbar);
    if (PH_MASK & 2) {
        pg8::Gemm g{(const bf16_t*)a.out, (const bf16_t*)(ws + WS_WIN), M_TOK, NPROJ, 1024}; pg8::StaticOrder S; S.init(M_TOK, NPROJ, G, blk);
        pg8::EpiProj E{ws};
        for (int rep = 0; rep < REP_P1; ++rep)
        pg8::gemm_phase<pg8::EpiProj, pg8::StaticOrder, true, true>(lds, g, S, E);
    }
    GRID_BAR();
    {
        const bf16_t* QKp = (const bf16_t*)(ws + WS_QK); const bf16_t* GVp = (const bf16_t*)(ws + WS_GV); const bf16_t* GGp = (const bf16_t*)(ws + WS_GG);
        float* Lws = (float*)(ws + WS_GLAL); float* Dws = (float*)(ws + WS_GLAD);
        constexpr int NA = 32 * (GLA_NSEG - 1);
        for (int rep = 0; rep < REP_P2A; ++rep) {
        for (int rpa = 0; rpa < REP_PA; ++rpa)
        if (PH_MASK & 64) for (int it = blk; it < NA; it += G) { const int seq = it / (GLA_NSEG - 1), seg = it % (GLA_NSEG - 1);
            gla_seg<false>(seq >> 2, seq & 3, seg, QKp, GVp, GGp, ALR, P.w_alpha2, P.b_alpha, P.gla_norm, OGLA, Lws, Dws, lds, tid); }
        for (int rsw = 0; rsw < REP_SWA; ++rsw)
        if (PH_MASK & 128) {
            int u0, u1, ustep;
            if (G == 256) { if (blk >= NA) { u0 = (blk - NA) * 12; u1 = u0 + 12; } else if (blk < 96) { u0 = 384 + blk * 8; u1 = u0 + 8; } else { u0 = 1152 + (blk - 96) * 7; u1 = u0 + 7; } ustep = 1; }
            else { u0 = blk; u1 = 2048; ustep = G; }
            int tl = tid; asm volatile("" : "+v"(tl));
            const bf16_t* SQp = (const bf16_t*)(ws + WS_SQ); const bf16_t* SKVp = (const bf16_t*)(ws + WS_SKV);
            SwaRegs R;
            if (u0 < u1) swa_load(R, u0 >> 8, u0 & 63, (u0 >> 6) & 3, SQp, SKVp, tl);
#pragma unroll 1
            for (int u = u0; u < u1; u += ustep) { const int n = u & 63, kh = (u >> 6) & 3, b = u >> 8;
                const float M2 = swa_stage(R, P.swa_qn, P.swa_kn, lds, tl);
                __syncthreads();
                const int un = u + ustep;
                if (un < u1) swa_load(R, un >> 8, un & 63, (un >> 6) & 3, SQp, SKVp, tl);
                swa_compute(M2, b, n, kh, OSWA, P.sinks, lds, tl);
                __syncthreads();
                swa_store(b, n, kh, OSWA, lds, tl); }
            if (G == 256 && blk >= 96 && blk < NA && rsw == 0) {
                __syncthreads();
                const int wv = tl >> 6; LAS float* scr = (LAS float*)(lds + wv * 12288);
                for (int q = wv; q < 44; q += 8) transpose_rest_item(P, (blk - 96) * 44 + q, scr, tl & 63);
            }
        }
        }
        GRID_BAR();
        for (int rep = 0; rep < REP_P2B; ++rep)
        if (PH_MASK & 64) for (int it = blk; it < 32 * GLA_NSEG; it += G) { const int seq = it / GLA_NSEG, seg = it % GLA_NSEG;
            gla_seg<true>(seq >> 2, seq & 3, seg, QKp, GVp, GGp, ALR, P.w_alpha2, P.b_alpha, P.gla_norm, OGLA, Lws, Dws, lds, tid); }
    }
    GRID_BAR();
    if (PH_MASK & 8) {
        static_assert(WS_WBS == WS_WBG + (size_t)1024 * 1024 * 2, "Wbg^T and Wbs^T are one [2048][1024] matrix");
        pg8::PairOrder S; S.init(M_TOK, 1024, G, blk);
        pg8::Gemm g{OGLA, (const bf16_t*)(ws + WS_WBG), 2 * M_TOK, 2048, 1024};
        pg8::EpiGatePair E{{(const bf16_t*)(ws + WS_GA), (bf16_t*)(ws + WS_MERGED)}, {(const bf16_t*)(ws + WS_GB), (bf16_t*)(ws + WS_MERGED)}};
        pg8::gemm_phase<pg8::EpiGatePair, pg8::PairOrder, true, true>(lds, g, S, E);
    }
    GRID_BAR();
    if (PH_MASK & 16) {
        pg8::Gemm g{(const bf16_t*)(ws + WS_MERGED), (const bf16_t*)(ws + WS_WOUT), M_TOK, 1024, 1024}; pg8::StaticOrder S; S.init(M_TOK, 1024, G, blk);
        pg8::EpiRes E{P.x, (bf16_t*)(ws + WS_H1B), SSQ};
        pg8::gemm_phase<pg8::EpiRes, pg8::StaticOrder, true, true>(lds, g, S, E);
    }
    GRID_BAR();
    if (PH_MASK & 32) {
        pg8::Gemm g{(const bf16_t*)(ws + WS_H1B), (const bf16_t*)(ws + WS_WUP), M_TOK, DFF, 1024}; pg8::StaticOrder S; S.init(M_TOK, DFF, G, blk);
        pg8::EpiUp E{SSQ, (bf16_t*)(ws + WS_U)};
        pg8::gemm_phase<pg8::EpiUp, pg8::StaticOrder, true, true>(lds, g, S, E);
    }
    GRID_BAR();
    if (PH_MASK & 256) {
        pg8::Gemm g{(const bf16_t*)(ws + WS_U), (const bf16_t*)(ws + WS_WDN), M_TOK, 1024, DFF}; pg8::StaticOrder S; S.init(M_TOK, 1024, G, blk);
        pg8::EpiDown E{(const bf16_t*)(ws + WS_H1B), a.out};
        pg8::gemm_phase<pg8::EpiDown, pg8::StaticOrder, true, true>(lds, g, S, E);
    }
}

extern "C" void kernel_launch(void* const* d_in, const int* in_sizes, int n_in, void* d_out, int out_size, void* d_ws, size_t ws_size, hipStream_t stream) {
    static int grid = 0;
    if (grid == 0) {
        if (n_in != 15 || out_size != M_TOK * DM || ws_size < WS_END) { fprintf(stderr, "kernel_launch: unexpected shapes (n_in %d out %d ws %zu)\n", n_in, out_size, ws_size); grid = -1; return; }
        int dev = 0, cus = 0, per_cu = 0;
        hipGetDevice(&dev); hipDeviceGetAttribute(&cus, hipDeviceAttributeMultiprocessorCount, dev);
        if (hipFuncSetAttribute((const void*)mk_fwd, hipFuncAttributeMaxDynamicSharedMemorySize, LDS_BYTES) != hipSuccess) { fprintf(stderr, "kernel_launch: hipFuncSetAttribute failed\n"); grid = -1; return; }
        if (hipOccupancyMaxActiveBlocksPerMultiprocessor(&per_cu, (const void*)mk_fwd, 512, LDS_BYTES) != hipSuccess || per_cu < 1) { fprintf(stderr, "kernel_launch: occupancy query says %d\n", per_cu); per_cu = 1; }
        (void)hipGetLastError();
        grid = cus > 1024 ? 1024 : cus;
        if (grid < 64) { fprintf(stderr, "kernel_launch: only %d CUs\n", cus); grid = -1; return; }
    }
    if (grid < 0) return;
    if (hipMemsetAsync((char*)d_ws + WS_BAR, 0, BAR_BYTES, stream) != hipSuccess) { fprintf(stderr, "kernel_launch: hipMemsetAsync failed\n"); return; }
    Args a{};
    for (int i = 0; i < 15; ++i) a.in[i] = (const float*)d_in[i];
    a.out = (float*)d_out; a.ws = (unsigned char*)d_ws;
    void* args[] = {&a};
    hipError_t e = hipLaunchCooperativeKernel((const void*)mk_fwd, dim3(grid), dim3(512), args, LDS_BYTES, stream);
    if (e != hipSuccess) fprintf(stderr, "kernel_launch: cooperative launch failed: %s (grid %d)\n", hipGetErrorString(e), grid);
}
```
